# Optimizing an MI355X kernel written in HIP

```python
import math
import jax, jax.numpy as jnp
from jax import lax
import numpy as np

D_MODEL = 1024
BATCH = 4
SEQ = 8192
DEPTH = 2

HEAD_DIM = 64
ROPE_THETA = 10000.0
Q_BLOCK = 128
LN_EPS = 1e-5

A_HEADS = 4
A_KV_RANK = 128
A_IDX_HEADS = 4
A_IDX_DIM = 64
A_TOPK_MAX = 256

B_HEADS = 4
B_BLOCK = 256
B_TOPK_BLOCKS = 3

C_HEADS = 8
C_KV_HEADS = 2
C_WINDOW = 128

N_BRANCH = 3
A_W = A_HEADS * HEAD_DIM
B_W = B_HEADS * HEAD_DIM
C_W = C_HEADS * HEAD_DIM
MIX_W = A_W + B_W + C_W

IN_SIZES = (A_W, A_KV_RANK, A_IDX_HEADS * A_IDX_DIM, A_IDX_DIM, A_IDX_HEADS,
            B_W, B_W, B_W,
            C_W, C_KV_HEADS * HEAD_DIM, C_KV_HEADS * HEAD_DIM,
            N_BRANCH * D_MODEL)
N_IN = sum(IN_SIZES)

N_EXPERTS = 16
N_GROUPS = 4
EXPERTS_PER_GROUP = N_EXPERTS // N_GROUPS
TOP_K = 2
D_EXPERT = 512

DN_ALPHA = (2 * DEPTH) ** 0.25
DN_BETA = (8 * DEPTH) ** -0.25

kernel_name = "hybrid_dsa_moba_swa_groupmoe_deepnorm"


def _split_points(sizes):
    pts, acc = [], 0
    for s in sizes[:-1]:
        acc += s
        pts.append(acc)
    return pts


def layer_norm(x, g, b):
    xf = x.astype(jnp.float32)
    mu = jnp.mean(xf, -1, keepdims=True)
    var = jnp.mean(jnp.square(xf - mu), -1, keepdims=True)
    return ((xf - mu) * lax.rsqrt(var + LN_EPS) * g + b).astype(x.dtype)


def rope_tables(seq_len, dim):
    inv = 1.0 / (ROPE_THETA ** (jnp.arange(0, dim, 2, dtype=jnp.float32) / dim))
    ang = jnp.arange(seq_len, dtype=jnp.float32)[:, None] * inv[None, :]
    return jnp.cos(ang), jnp.sin(ang)


def apply_rope(t, cos, sin):
    t1, t2 = jnp.split(t, 2, axis=-1)
    c = cos[None, :, None, :].astype(t.dtype)
    s = sin[None, :, None, :].astype(t.dtype)
    return jnp.concatenate([t1 * c - t2 * s, t2 * c + t1 * s], axis=-1)


def dsa_attention(q, k, v, iq, ik, iw):
    Bn, S, HA, dh = q.shape
    topk = min(A_TOPK_MAX, S // 4)
    nqb = S // Q_BLOCK
    scale = dh ** -0.5
    key_pos = jnp.arange(S)
    gather = jax.vmap(lambda arr, idx: arr[idx])

    def block(i):
        t0 = i * Q_BLOCK
        qb = lax.dynamic_slice_in_dim(q, t0, Q_BLOCK, 1)
        iqb = lax.dynamic_slice_in_dim(iq, t0, Q_BLOCK, 1)
        iwb = lax.dynamic_slice_in_dim(iw, t0, Q_BLOCK, 1)
        qpos = t0 + jnp.arange(Q_BLOCK)
        dots = jnp.einsum('bqhd,bsd->bqhs', iqb, ik)
        score = jnp.einsum('bqh,bqhs->bqs', iwb, jax.nn.relu(dots)).astype(jnp.float32)
        causal = key_pos[None, :] <= qpos[:, None]
        score = jnp.where(causal[None], score, -jnp.inf)
        _, idx = lax.top_k(score, topk)
        valid = idx <= qpos[None, :, None]
        kg = gather(k, idx)
        vg = gather(v, idx)
        s = jnp.einsum('bqhd,bqkd->bhqk', qb, kg).astype(jnp.float32) * scale
        s = jnp.where(valid[:, None], s, -jnp.inf)
        p = jax.nn.softmax(s, axis=-1).astype(v.dtype)
        return jnp.einsum('bhqk,bqkd->bqhd', p, vg)

    out = lax.map(block, jnp.arange(nqb))
    return out.transpose(1, 0, 2, 3, 4).reshape(Bn, S, HA * dh)


def moba_attention(q, k, v):
    Bn, S, H, dh = q.shape
    nkb = -(-S // B_BLOCK)
    pad = nkb * B_BLOCK - S
    kp = jnp.pad(k, ((0, 0), (0, pad), (0, 0), (0, 0)))
    vp = jnp.pad(v, ((0, 0), (0, pad), (0, 0), (0, 0)))
    kblk = kp.reshape(Bn, nkb, B_BLOCK, H, dh)
    vblk = vp.reshape(Bn, nkb, B_BLOCK, H, dh)
    kmean = jnp.mean(kblk, axis=2)
    kbt = kblk.transpose(0, 3, 1, 2, 4)
    vbt = vblk.transpose(0, 3, 1, 2, 4)
    nsel = min(B_TOPK_BLOCKS, nkb)
    nqb = S // Q_BLOCK
    scale = dh ** -0.5
    gather_bh = jax.vmap(jax.vmap(lambda arr, idx: arr[idx]))
    blk_ids = jnp.arange(nkb)

    def block(i):
        t0 = i * Q_BLOCK
        cur = t0 // B_BLOCK
        qb = lax.dynamic_slice_in_dim(q, t0, Q_BLOCK, 1)
        qpos = t0 + jnp.arange(Q_BLOCK)
        gate = jnp.einsum('bqhd,bnhd->bhqn', qb, kmean).astype(jnp.float32)
        gate = jnp.where(blk_ids < cur, gate, -jnp.inf)
        _, sel = lax.top_k(gate, nsel)
        sel_valid = sel < cur
        kg = gather_bh(kbt, sel)
        vg = gather_bh(vbt, sel)
        s_sel = jnp.einsum('bqhd,bhqnkd->bhqnk', qb, kg).astype(jnp.float32) * scale
        s_sel = jnp.where(sel_valid[..., None], s_sel, -jnp.inf)
        s_sel = s_sel.reshape(Bn, H, Q_BLOCK, nsel * B_BLOCK)
        k_own = lax.dynamic_slice_in_dim(kp, cur * B_BLOCK, B_BLOCK, 1)
        v_own = lax.dynamic_slice_in_dim(vp, cur * B_BLOCK, B_BLOCK, 1)
        own_pos = cur * B_BLOCK + jnp.arange(B_BLOCK)
        s_own = jnp.einsum('bqhd,bkhd->bhqk', qb, k_own).astype(jnp.float32) * scale
        s_own = jnp.where((own_pos[None, :] <= qpos[:, None])[None, None], s_own, -jnp.inf)
        p = jax.nn.softmax(jnp.concatenate([s_own, s_sel], axis=-1), axis=-1).astype(v.dtype)
        p_own = p[..., :B_BLOCK]
        p_sel = p[..., B_BLOCK:].reshape(Bn, H, Q_BLOCK, nsel, B_BLOCK)
        return (jnp.einsum('bhqk,bkhd->bqhd', p_own, v_own)
                + jnp.einsum('bhqnk,bhqnkd->bqhd', p_sel, vg))

    out = lax.map(block, jnp.arange(nqb))
    return out.transpose(1, 0, 2, 3, 4).reshape(Bn, S, H * dh)


def swa_sink_attention(q, k, v, sinks):
    Bn, S, HC, dh = q.shape
    KV = k.shape[2]
    G = HC // KV
    W = C_WINDOW
    nb = S // W
    scale = dh ** -0.5
    qb = q.reshape(Bn, nb, W, KV, G, dh)
    kb = k.reshape(Bn, nb, W, KV, dh)
    vb = v.reshape(Bn, nb, W, KV, dh)
    kband = jnp.concatenate([jnp.pad(kb, ((0, 0), (1, 0), (0, 0), (0, 0), (0, 0)))[:, :-1], kb], axis=2)
    vband = jnp.concatenate([jnp.pad(vb, ((0, 0), (1, 0), (0, 0), (0, 0), (0, 0)))[:, :-1], vb], axis=2)
    s = jnp.einsum('bnqkgd,bnskd->bnkgqs', qb, kband).astype(jnp.float32) * scale
    qrel = jnp.arange(W)[:, None] + W
    krel = jnp.arange(2 * W)[None, :]
    diff = qrel - krel
    kabs = jnp.arange(nb)[:, None, None] * W - W + krel[None]
    mask = (diff >= 0)[None] & (diff < W)[None] & (kabs >= 0)
    s = jnp.where(mask[None, :, None, None], s, -jnp.inf)
    sink = jnp.broadcast_to(sinks.astype(jnp.float32).reshape(1, 1, KV, G, 1, 1), s.shape[:-1] + (1,))
    p = jax.nn.softmax(jnp.concatenate([s, sink], axis=-1), axis=-1)[..., :-1].astype(v.dtype)
    out = jnp.einsum('bnkgqs,bnskd->bnqkgd', p, vband)
    return out.reshape(Bn, S, HC * dh)


def mixer(x, w_in, a_w_uk, a_w_uv, c_sinks, w_branch, w_o, cos, sin):
    Bn, S, _ = x.shape
    h = x @ w_in
    (a_q, a_c, a_iq, a_ik, a_iw, b_q, b_k, b_v, c_q, c_k, c_v, gates) = jnp.split(
        h, _split_points(IN_SIZES), axis=-1)
    heads = lambda t, n: t.reshape(Bn, S, n, -1)
    qa = apply_rope(heads(a_q, A_HEADS), cos, sin)
    ka = apply_rope((a_c @ a_w_uk)[:, :, None, :], cos, sin)[:, :, 0]
    va = a_c @ a_w_uv
    iq = apply_rope(heads(a_iq, A_IDX_HEADS), cos, sin)
    ik = apply_rope(a_ik[:, :, None, :], cos, sin)[:, :, 0]
    o_a = dsa_attention(qa, ka, va, iq, ik, a_iw)
    o_b = moba_attention(apply_rope(heads(b_q, B_HEADS), cos, sin),
                         apply_rope(heads(b_k, B_HEADS), cos, sin),
                         heads(b_v, B_HEADS))
    o_c = swa_sink_attention(apply_rope(heads(c_q, C_HEADS), cos, sin),
                             apply_rope(heads(c_k, C_KV_HEADS), cos, sin),
                             heads(c_v, C_KV_HEADS), c_sinks)
    wa, wb, wc = jnp.split(w_branch, [A_W, A_W + B_W], axis=0)
    ga, gb, gc = jnp.split(jax.nn.sigmoid(gates), N_BRANCH, axis=-1)
    merged = ga * (o_a @ wa) + gb * (o_b @ wb) + gc * (o_c @ wc)
    return merged @ w_o


def moe(x, router_w, router_b, w_gate, w_up, w_down):
    Bn, S, D = x.shape
    xt = x.reshape(-1, D)
    aff = jax.nn.sigmoid((xt @ router_w).astype(jnp.float32))
    sel_score = aff + router_b.astype(jnp.float32)
    grp_score = lax.top_k(sel_score.reshape(-1, N_GROUPS, EXPERTS_PER_GROUP), TOP_K)[0].sum(-1)
    g_star = jnp.argmax(grp_score, axis=-1)
    in_group = (jnp.arange(N_EXPERTS) // EXPERTS_PER_GROUP)[None, :] == g_star[:, None]
    _, top_idx = lax.top_k(jnp.where(in_group, sel_score, -jnp.inf), TOP_K)
    top_aff = jnp.take_along_axis(aff, top_idx, axis=-1)
    wts = top_aff / jnp.sum(top_aff, -1, keepdims=True)
    combine = jnp.sum(jax.nn.one_hot(top_idx, N_EXPERTS, dtype=jnp.float32) * wts[..., None], axis=1)
    combine = combine.astype(x.dtype)
    y = jnp.zeros_like(xt)
    for e in range(N_EXPERTS):
        he = jax.nn.silu(xt @ w_gate[e]) * (xt @ w_up[e])
        y = y + combine[:, e:e + 1] * (he @ w_down[e])
    return y.reshape(Bn, S, D)


def setup_inputs(seed: int = 0) -> dict:
    key = jax.random.key(seed)
    ks = jax.random.split(key, 20)
    nrm = lambda k, shape, scale: jax.random.normal(k, shape, jnp.float32) * scale
    w_branch = jnp.concatenate([
        nrm(ks[5], (DEPTH, A_W, D_MODEL), A_W ** -0.5),
        nrm(ks[6], (DEPTH, B_W, D_MODEL), B_W ** -0.5),
        nrm(ks[7], (DEPTH, C_W, D_MODEL), C_W ** -0.5)], axis=1)
    return {
        "x": nrm(ks[0], (BATCH, SEQ, D_MODEL), 1.0),
        "w_in": nrm(ks[1], (DEPTH, D_MODEL, N_IN), D_MODEL ** -0.5),
        "a_w_uk": nrm(ks[2], (DEPTH, A_KV_RANK, HEAD_DIM), A_KV_RANK ** -0.5),
        "a_w_uv": nrm(ks[3], (DEPTH, A_KV_RANK, HEAD_DIM), A_KV_RANK ** -0.5),
        "c_sinks": nrm(ks[4], (DEPTH, C_HEADS), 1.0),
        "w_branch": w_branch,
        "w_o": nrm(ks[8], (DEPTH, D_MODEL, D_MODEL), D_MODEL ** -0.5 * DN_BETA),
        "ln1_g": 1.0 + nrm(ks[9], (DEPTH, D_MODEL), 0.01),
        "ln1_b": nrm(ks[10], (DEPTH, D_MODEL), 0.01),
        "router_w": nrm(ks[11], (D_MODEL, N_EXPERTS), D_MODEL ** -0.5),
        "router_b": nrm(ks[12], (N_EXPERTS,), 0.01),
        "moe_w_gate": nrm(ks[13], (DEPTH, N_EXPERTS, D_MODEL, D_EXPERT), D_MODEL ** -0.5),
        "moe_w_up": nrm(ks[14], (DEPTH, N_EXPERTS, D_MODEL, D_EXPERT), D_MODEL ** -0.5),
        "moe_w_down": nrm(ks[15], (DEPTH, N_EXPERTS, D_EXPERT, D_MODEL), D_EXPERT ** -0.5 * DN_BETA),
        "ln2_g": 1.0 + nrm(ks[16], (DEPTH, D_MODEL), 0.01),
        "ln2_b": nrm(ks[17], (DEPTH, D_MODEL), 0.01),
    }


def reference(x, w_in, a_w_uk, a_w_uv, c_sinks, w_branch, w_o, ln1_g, ln1_b,
              router_w, router_b, moe_w_gate, moe_w_up, moe_w_down, ln2_g, ln2_b):
    S = x.shape[1]
    cos, sin = rope_tables(S, HEAD_DIM)
    for l in range(DEPTH):
        y = mixer(x, w_in[l], a_w_uk[l], a_w_uv[l], c_sinks[l], w_branch[l], w_o[l], cos, sin)
        x = layer_norm(DN_ALPHA * x + y, ln1_g[l], ln1_b[l])
        y = moe(x, router_w, router_b, moe_w_gate[l], moe_w_up[l], moe_w_down[l])
        x = layer_norm(DN_ALPHA * x + y, ln2_g[l], ln2_b[l])
    return x
```

```cpp
#include <hip/hip_runtime.h>
#include <cstdio>
#include <cstdint>

#define GAS __attribute__((address_space(1)))
#define LAS __attribute__((address_space(3)))
typedef unsigned short bf16;
typedef unsigned short u16;
typedef unsigned v4u __attribute__((ext_vector_type(4)));
typedef unsigned v2u __attribute__((ext_vector_type(2)));
typedef float f32x4 __attribute__((ext_vector_type(4)));
typedef float f32x2 __attribute__((ext_vector_type(2)));
typedef float f32x16 __attribute__((ext_vector_type(16)));
typedef short bf16x8 __attribute__((ext_vector_type(8)));
typedef _Float16 f16x8 __attribute__((ext_vector_type(8)));
typedef _Float16 f16x2 __attribute__((ext_vector_type(2)));
typedef short s16x4 __attribute__((ext_vector_type(4)));
typedef GAS unsigned gu32;
#define RLX_AGENT __ATOMIC_RELAXED, __HIP_MEMORY_SCOPE_AGENT
#define LDS_WAIT() asm volatile("s_waitcnt lgkmcnt(0)" ::: "memory")
#define VM_WAIT() asm volatile("s_waitcnt vmcnt(0)" ::: "memory")

constexpr int T = 32768, SEQ = 8192, NB = 4, D = 1024, DEPTH = 2;
constexpr int N_IN = 5316, N_INP = 5376;
constexpr int C_AQ = 0, C_AC = 256, C_IQ = 384, C_IK = 640, C_IW = 704, C_BQ = 708, C_BK = 964, C_BV = 1220, C_CQ = 1476, C_CK = 1988, C_CV = 2116, C_G = 2244;
constexpr int NEXP = 16, DE = 512, NPAIR = 24;
constexpr float LN_EPS = 1e-5f;
constexpr float DN_ALPHA = 1.41421356237309515f;
constexpr float LOG2E = 1.4426950408889634f;
constexpr float SM_C = 0.125f * LOG2E;
constexpr int NWAVES = 8, NTHR = 512;

constexpr size_t MiB = 1u << 20;
constexpr size_t WS_CTL = 0, CTL_ZERO_BYTES = 1 * MiB;
constexpr size_t WS_ROPE = 1 * MiB;
constexpr size_t WS_WIN = 3 * MiB;
constexpr size_t WS_WBR = 24 * MiB;
constexpr size_t WS_WO = 28 * MiB;
constexpr size_t WS_XB = 32 * MiB;
constexpr size_t WS_ATT = 96 * MiB;
constexpr size_t WS_AQ = WS_ATT, WS_BQ = WS_AQ + 16 * MiB, WS_CQ = WS_BQ + 16 * MiB;
constexpr size_t WS_IQ = WS_CQ + 32 * MiB;
constexpr size_t WS_KAVA = WS_IQ + 16 * MiB;
constexpr size_t WS_IK = WS_KAVA + 8 * MiB;
constexpr size_t WS_BK = WS_IK + 4 * MiB, WS_BV = WS_BK + 16 * MiB;
constexpr size_t WS_CKV = WS_BV + 16 * MiB;
constexpr size_t WS_MERGED = WS_IQ;
constexpr size_t WS_H = WS_ATT;
constexpr size_t WS_GATES = 236 * MiB;
constexpr size_t WS_Y = WS_GATES;
constexpr size_t WS_MISC = 428 * MiB;
constexpr size_t WS_IW = WS_MISC;
constexpr size_t WS_KMP = WS_MISC + 1 * MiB;
constexpr size_t WS_LIST = WS_MISC + 2 * MiB;
constexpr size_t WS_CW = WS_MISC + 5 * MiB;
constexpr size_t WS_WF = WS_MISC + 11 * MiB;
constexpr size_t WS_WGU = 440 * MiB;
constexpr size_t WS_WD = 472 * MiB;
constexpr size_t WS_END = 488 * MiB;
static_assert(WS_CKV + 16 * MiB == WS_GATES && WS_MERGED + 64 * MiB <= WS_CKV + 16 * MiB && WS_CW + 6 * MiB <= WS_WGU, "ws map");
constexpr int CW_TMO = 0;
constexpr int CW_BAR = 4096;
constexpr int CW_CNT = 16384;

constexpr int RING_BYTES = 131072;
constexpr int LDS_MISC_OFF = 155648 - 512;
constexpr int LDS_BYTES = 155648;

__device__ __forceinline__ unsigned f2bf(float f) { unsigned u = __builtin_bit_cast(unsigned, f); return (u + 0x7fffu + ((u >> 16) & 1u)) >> 16; }
__device__ __forceinline__ unsigned pk2(float lo, float hi) { return f2bf(lo) | (f2bf(hi) << 16); }
typedef __bf16 bf16x2_t __attribute__((ext_vector_type(2)));
__device__ __forceinline__ unsigned cvt_pk_bf16(float lo, float hi) { f32x2 v = {lo, hi}; bf16x2_t b = __builtin_convertvector(v, bf16x2_t); return __builtin_bit_cast(unsigned, b); }
__device__ __forceinline__ unsigned pk2h(float lo, float hi) { f16x2 v; v.x = (_Float16)lo; v.y = (_Float16)hi; return __builtin_bit_cast(unsigned, v); }
__device__ __forceinline__ float bf2f(unsigned short b) { return __builtin_bit_cast(float, (unsigned)b << 16); }
__device__ __forceinline__ float bflo(unsigned w) { return __builtin_bit_cast(float, w << 16); }
__device__ __forceinline__ float bfhi(unsigned w) { return __builtin_bit_cast(float, w & 0xffff0000u); }
template <int M> __device__ __forceinline__ float xor_f(float v) { return __builtin_bit_cast(float, __builtin_amdgcn_ds_swizzle(__builtin_bit_cast(int, v), (M << 10) | 0x1f)); }
template <int M> __device__ __forceinline__ unsigned xor_u(unsigned v) { return (unsigned)__builtin_amdgcn_ds_swizzle((int)v, (M << 10) | 0x1f); }
__device__ __forceinline__ void half_swap(unsigned& a, unsigned& b) { asm volatile("v_nop\n\tv_nop\n\tv_permlane32_swap_b32 %0, %1\n\tv_nop" : "+v"(a), "+v"(b)); }
__device__ __forceinline__ float half_sum(float v) { unsigned a = __builtin_bit_cast(unsigned, v), b = a; half_swap(a, b); return __builtin_bit_cast(float, a) + __builtin_bit_cast(float, b); }
__device__ __forceinline__ float half_max(float v) { unsigned a = __builtin_bit_cast(unsigned, v), b = a; half_swap(a, b); return fmaxf(__builtin_bit_cast(float, a), __builtin_bit_cast(float, b)); }
template <int CTRL> __device__ __forceinline__ float dpp_f(float v) { return __builtin_bit_cast(float, __builtin_amdgcn_update_dpp(0, __builtin_bit_cast(int, v), CTRL, 0xf, 0xf, false)); }
__device__ __forceinline__ float row_sum(float v) { v += dpp_f<0xB1>(v); v += dpp_f<0x4E>(v); v += dpp_f<0x141>(v); v += dpp_f<0x140>(v); return v; }
__device__ __forceinline__ float row_max(float v) { v = fmaxf(v, dpp_f<0xB1>(v)); v = fmaxf(v, dpp_f<0x4E>(v)); v = fmaxf(v, dpp_f<0x141>(v)); v = fmaxf(v, dpp_f<0x140>(v)); return v; }
__device__ __forceinline__ float wave_sum(float v) { v = row_sum(v); v += xor_f<16>(v); return half_sum(v); }
__device__ __forceinline__ float wave_max(float v) { v = row_max(v); v = fmaxf(v, xor_f<16>(v)); return half_max(v); }
__device__ __forceinline__ long ik_off(int key, int piece) { return ((long)(key >> 5) * 8 + piece) * 256 + (key & 31) * 8; }
__device__ __forceinline__ long bk_off(int h, long row, int piece) { return (((long)h * (T / 32) + (row >> 5)) * 8 + piece) * 256 + (row & 31) * 8; }
__device__ __forceinline__ int lane_id() { int r; asm volatile("v_mbcnt_lo_u32_b32 %0, -1, 0\n\tv_mbcnt_hi_u32_b32 %0, -1, %0" : "=v"(r)); return r; }
__device__ __forceinline__ float sigmoidf_(float x) { return __builtin_amdgcn_rcpf(1.0f + __builtin_amdgcn_exp2f(-LOG2E * x)); }

namespace pg8 {
constexpr int BM = 256, BK = 64, HALF = 128, HTB = HALF * BK * 2, STAGE_BYTES = 8 * HTB;
__host__ __device__ __forceinline__ int lds_byte(int r, int c) { const int st = (r >> 4) * 2 + (c >> 5), rr = r & 15, cc = c & 31, ob = rr * 64 + cc * 2; return st * 1024 + (ob ^ (((ob >> 9) & 1) << 5)); }
__host__ __device__ __forceinline__ void stage_rc(int b, int& R, int& C) { const int st = b / 1024, sb = b % 1024, swz = sb ^ (((sb >> 9) & 1) << 5); R = (st >> 1) * 16 + swz / 64; C = (st & 1) * 32 + (swz % 64) / 2; }
__host__ __device__ __forceinline__ int perm32(int rho) { const int n = rho >> 4, i = rho & 15; return 8 * (i >> 2) + 4 * n + (i & 3); }

struct Unit { const char* A; const char* B; const int* rowlist; int nvalid; int lda; int nt; int ksplit; long bdelta; int p0, p1, p2, p3; };

template <class Epi, class Sched, bool ALIGN_EPI>
__device__ __forceinline__ void gemm_phase(LAS unsigned char* lds, int tid, int ldb, const Sched& S, const Epi& E) {
    const int wid = __builtin_amdgcn_readfirstlane(tid >> 6), lane = tid & 63, wr = wid >> 2, wc = wid & 3, fr = lane & 15, fq = lane >> 4;
    int R0, C0; stage_rc(tid * 16, R0, C0);
    const int Rb0 = Epi::PERM ? ((R0 & ~31) + perm32(R0 & 31)) : R0;
    unsigned voffB[2];
    voffB[0] = (unsigned)(Rb0 * ldb + C0) * 2u; voffB[1] = (unsigned)((Rb0 + 64) * ldb + C0) * 2u;
    const size_t kstep = (size_t)(BK * 2);
    const size_t hstepB = (size_t)HALF * ldb * 2;
    const unsigned ldsw = (unsigned)wid * 1024u;
    const int aoff = lds_byte(wr * 64 + fr, fq * 8), boff = lds_byte(wc * 32 + fr, fq * 8);
#define PG8_SA(b, h) (((b) * 2 + (h)) * HTB)
#define PG8_SB(b, h) ((4 + (b) * 2 + (h)) * HTB)
#define PG8_STAGEB(bufoff, gbase) do { _Pragma("unroll") for (int _i = 0; _i < 2; ++_i) \
        __builtin_amdgcn_global_load_lds((const unsigned*)((const char*)(gbase) + voffB[_i]), (LAS unsigned*)(lds + (bufoff) + ldsw + _i * 8192), 16, 0, 0); } while (0)
#define PG8_STAGEA(bufoff, gbase, vo, h) do { \
        __builtin_amdgcn_global_load_lds((const unsigned*)((const char*)(gbase) + vo##h##0), (LAS unsigned*)(lds + (bufoff) + ldsw), 16, 0, 0); \
        __builtin_amdgcn_global_load_lds((const unsigned*)((const char*)(gbase) + vo##h##1), (LAS unsigned*)(lds + (bufoff) + ldsw + 8192), 16, 0, 0); } while (0)
#define PG8_LDA(dst, b, h) do { _Pragma("unroll") for (int m = 0; m < 4; ++m) _Pragma("unroll") for (int k = 0; k < 2; ++k) dst[m][k] = *(const LAS bf16x8*)(lds + PG8_SA(b, h) + aoff + m * 2048 + k * 1024); } while (0)
#define PG8_LDB(dst, b, h) do { _Pragma("unroll") for (int n = 0; n < 2; ++n) _Pragma("unroll") for (int k = 0; k < 2; ++k) dst[n][k] = *(const LAS bf16x8*)(lds + PG8_SB(b, h) + boff + n * 2048 + k * 1024); } while (0)
#define PG8_MMA(ai, bj, At, Bt) do { __builtin_amdgcn_s_setprio(1); _Pragma("unroll") for (int m = 0; m < 4; ++m) _Pragma("unroll") for (int n = 0; n < 2; ++n) _Pragma("unroll") for (int k = 0; k < 2; ++k) \
        acc[ai][bj][m][n] = __builtin_amdgcn_mfma_f32_16x16x32_bf16(Bt[n][k], At[m][k], acc[ai][bj][m][n], 0, 0, 0); __builtin_amdgcn_s_setprio(0); } while (0)
#define PG8_WAIT_V(n) asm volatile("s_waitcnt vmcnt(" #n ")" ::: "memory")
#define PG8_WAIT_L(n) asm volatile("s_waitcnt lgkmcnt(" #n ")" ::: "memory")
#define PG8_BAR __builtin_amdgcn_s_barrier()
#define PG8_SCHED __builtin_amdgcn_sched_barrier(0)
#define PG8_BK(u, tt) ((u).B + (size_t)(tt) * kstep + (((tt) >= (u).ksplit) ? (u).bdelta : 0))
#define PG8_VOFF1(u, dst, rr) do { const int _r = (rr) + R0; int _g = _r; if ((u).rowlist) { _g = (u).rowlist[(_r < (u).nvalid) ? _r : 0]; } dst = (unsigned)(_g * (u).lda + C0) * 2u; } while (0)
#define PG8_VOFFA(u, vo) do { PG8_VOFF1(u, vo##00, 0); PG8_VOFF1(u, vo##01, 64); PG8_VOFF1(u, vo##10, 128); PG8_VOFF1(u, vo##11, 192); } while (0)
    Unit cur, nxt; int ui = 0;
    if (!S.next(0, cur)) return;
    f32x4 acc[2][2][4][2];
#pragma unroll
    for (int a = 0; a < 2; ++a)
#pragma unroll
        for (int b = 0; b < 2; ++b)
#pragma unroll
            for (int m = 0; m < 4; ++m)
#pragma unroll
                for (int n = 0; n < 2; ++n) acc[a][b][m][n] = (f32x4){0.f, 0.f, 0.f, 0.f};
    bf16x8 At[4][2], B0[2][2], B1[2][2];
    unsigned cvo00, cvo01, cvo10, cvo11;
    LAS v4u* park = (LAS v4u*)(lds + STAGE_BYTES) + tid;
    PG8_VOFFA(cur, cvo);
    {
        const char* cA = cur.A; const char* b0 = PG8_BK(cur, 0); const char* b1 = PG8_BK(cur, 1);
        PG8_STAGEB(PG8_SB(0, 0), b0); PG8_STAGEB(PG8_SB(0, 1), b0 + hstepB); PG8_STAGEA(PG8_SA(0, 0), cA, cvo, 0); PG8_STAGEA(PG8_SA(0, 1), cA, cvo, 1);
        if (wr == 1) PG8_BAR;
        PG8_WAIT_V(2); PG8_BAR;
        PG8_STAGEB(PG8_SB(1, 0), b1); PG8_STAGEA(PG8_SA(1, 0), cA + kstep, cvo, 0); PG8_STAGEB(PG8_SB(1, 1), b1 + hstepB);
        PG8_WAIT_V(6); PG8_BAR;
    }
    for (;;) {
        const bool has_next = S.next(ui + 1, nxt);
        if (!has_next) nxt = cur;
        { unsigned nvo00, nvo01, nvo10, nvo11; PG8_VOFFA(nxt, nvo); *park = (v4u){nvo00, nvo01, nvo10, nvo11}; }
        const int nt = cur.nt;
        const char* cA = cur.A;
        for (int t = 0; t < nt; t += 2) {
            const bool last = (t == nt - 2);
            const char* a1 = cA + (size_t)(t + 1) * kstep;
            const char* a2 = last ? nxt.A : cA + (size_t)(t + 2) * kstep;
            const char* a3 = a2 + kstep;
            const char* b2 = last ? PG8_BK(nxt, 0) : PG8_BK(cur, t + 2);
            const char* b3 = last ? PG8_BK(nxt, 1) : PG8_BK(cur, t + 3);
            unsigned vo200 = cvo00, vo201 = cvo01, vo210 = cvo10, vo211 = cvo11;
            if (last) { const v4u nv = *park; vo200 = nv.x; vo201 = nv.y; vo210 = nv.z; vo211 = nv.w; }
            PG8_LDB(B0, 0, 0); PG8_LDB(B1, 0, 1); PG8_SCHED; PG8_LDA(At, 0, 0); PG8_STAGEA(PG8_SA(1, 1), a1, cvo, 1);
            PG8_WAIT_V(8); PG8_WAIT_L(0); PG8_BAR; PG8_MMA(0, 0, At, B0); PG8_MMA(0, 1, At, B1); PG8_BAR; PG8_SCHED;
            PG8_LDA(At, 0, 1); PG8_STAGEB(PG8_SB(0, 0), b2); PG8_STAGEB(PG8_SB(0, 1), b2 + hstepB); PG8_STAGEA(PG8_SA(0, 0), a2, vo2, 0);
            PG8_WAIT_V(8); PG8_WAIT_L(0); PG8_BAR; PG8_MMA(1, 0, At, B0); PG8_MMA(1, 1, At, B1); PG8_BAR; PG8_SCHED;
            PG8_LDB(B0, 1, 0); PG8_LDB(B1, 1, 1); PG8_SCHED; PG8_LDA(At, 1, 0); PG8_STAGEA(PG8_SA(0, 1), a2, vo2, 1);
            PG8_WAIT_V(8); PG8_WAIT_L(0); PG8_BAR; PG8_MMA(0, 0, At, B0); PG8_MMA(0, 1, At, B1); PG8_BAR; PG8_SCHED;
            PG8_LDA(At, 1, 1); PG8_STAGEB(PG8_SB(1, 0), b3); PG8_STAGEB(PG8_SB(1, 1), b3 + hstepB); PG8_STAGEA(PG8_SA(1, 0), a3, vo2, 0);
            PG8_WAIT_V(8); PG8_WAIT_L(0); PG8_BAR; PG8_MMA(1, 0, At, B0); PG8_MMA(1, 1, At, B1); PG8_BAR; PG8_SCHED;
        }
        if constexpr (ALIGN_EPI) { if (wr == 0) PG8_BAR; }
        E(acc, cur, wr, wc, fr, fq);
        if (!has_next) break;
        if (!Epi::keep_acc(cur))
#pragma unroll
        for (int a = 0; a < 2; ++a)
#pragma unroll
            for (int b = 0; b < 2; ++b)
#pragma unroll
                for (int m = 0; m < 4; ++m)
#pragma unroll
                    for (int n = 0; n < 2; ++n) acc[a][b][m][n] = (f32x4){0.f, 0.f, 0.f, 0.f};
        cur = nxt; ++ui;
        { const v4u nv = *park; cvo00 = nv.x; cvo01 = nv.y; cvo10 = nv.z; cvo11 = nv.w; }
        if constexpr (ALIGN_EPI) { if (wr == 1) PG8_BAR; }
    }
    PG8_WAIT_V(0);
    if constexpr (!ALIGN_EPI) { if (wr == 0) PG8_BAR; }
    PG8_BAR;
#undef PG8_SA
#undef PG8_SB
#undef PG8_STAGEA
#undef PG8_STAGEB
#undef PG8_LDA
#undef PG8_LDB
#undef PG8_MMA
#undef PG8_WAIT_V
#undef PG8_WAIT_L
#undef PG8_BAR
#undef PG8_SCHED
#undef PG8_BK
#undef PG8_VOFFA
}
}

#define XB_TMO      128
#define XB_XCNT(j)  (256  + 64 * (j))
#define XB_XSUB(j)  (1280 + 64 * (j))
#define XB_XGEN(j)  (2304 + 64 * (j))
#define XB_TOP      3328
#define XB_TOPGEN   3392
#define XCD_BAR_WORDS 3456
#define XB_SPIN_CAP (1u << 20)
__device__ __forceinline__ unsigned xb_ld(gu32* p)              { return __hip_atomic_load(p, __ATOMIC_RELAXED, __HIP_MEMORY_SCOPE_AGENT); }
__device__ __forceinline__ unsigned xb_add(gu32* p, unsigned v) { return __hip_atomic_fetch_add(p, v, __ATOMIC_RELAXED, __HIP_MEMORY_SCOPE_AGENT); }
__device__ __forceinline__ unsigned xb_xcc_id() { return (unsigned)__builtin_amdgcn_s_getreg((3 << 11) | 20) & 0xFu; }
#define XB_SPIN(cond, bar) do { unsigned _sp = 0; while (cond) { __builtin_amdgcn_s_sleep(1); \
    if ((++_sp & 255u) == 0u) { if (xb_ld(&(bar)[XB_TMO])) break; if (_sp > XB_SPIN_CAP) { (void)xb_add(&(bar)[XB_TMO], 1u); break; } } } } while (0)
struct XcdBarrier { gu32* bar; unsigned x; volatile LAS unsigned* st; };
__device__ __forceinline__ XcdBarrier xcd_barrier_post(gu32* bar, volatile LAS unsigned* st, bool leader) {
    XcdBarrier b; b.bar = bar; b.x = xb_xcc_id(); b.st = st;
    if (leader) (void)xb_add(&bar[XB_XCNT(b.x)], 1u);
    return b;
}
__device__ __forceinline__ void xcd_barrier_complete(gu32* bar, unsigned x, unsigned& nloc, unsigned& nx) {
    const unsigned G = gridDim.x * gridDim.y * gridDim.z;
    unsigned sum, cnt, mine, sp = 0u;
    for (;;) {
        sum = 0u; cnt = 0u; mine = 0u;
#pragma unroll
        for (unsigned j = 0; j < 16; ++j) { const unsigned c = xb_ld(&bar[XB_XCNT(j)]); sum += c; cnt += (c > 0u) ? 1u : 0u; mine = (j == x) ? c : mine; }
        if (sum == G) break;
        __builtin_amdgcn_s_sleep(1);
        if ((++sp & 255u) == 0u) { if (xb_ld(&bar[XB_TMO])) break; if (sp > XB_SPIN_CAP) { (void)xb_add(&bar[XB_TMO], 1u); break; } }
    }
    nloc = mine > 0u ? mine : 1u; nx = cnt > 0u ? cnt : 1u;
}
__device__ __forceinline__ void xcd_barrier(const XcdBarrier& b, bool leader) {
    asm volatile("s_waitcnt vmcnt(0)" ::: "memory");
    __syncthreads();
    if (leader) {
        gu32* bar = b.bar; asm volatile("" : "+s"(bar));
        __builtin_amdgcn_s_waitcnt(0);
        unsigned nloc = b.st[0], nx = b.st[1];
        if (nloc == 0u) { xcd_barrier_complete(bar, b.x, nloc, nx); b.st[0] = nloc; b.st[1] = nx; }
        const unsigned old = xb_add(&bar[XB_XSUB(b.x)], 1u);
        const unsigned gen = old / nloc;
        if (old + 1u == (gen + 1u) * nloc) {
            __builtin_amdgcn_fence(__ATOMIC_RELEASE, "agent");
            asm volatile("s_waitcnt vmcnt(0)" ::: "memory");
            const unsigned og = xb_add(&bar[XB_TOP], 1u);
            const unsigned tg = og / nx;
            if (og + 1u == (tg + 1u) * nx) xb_add(&bar[XB_TOPGEN], 1u);
            else XB_SPIN(xb_ld(&bar[XB_TOPGEN]) == tg, bar);
            __builtin_amdgcn_fence(__ATOMIC_ACQUIRE, "agent");
            xb_add(&bar[XB_XGEN(b.x)], 1u);
            asm volatile("s_waitcnt vmcnt(0)" ::: "memory");
        } else {
            XB_SPIN(xb_ld(&bar[XB_XGEN(b.x)]) == gen, bar);
            __builtin_amdgcn_fence(__ATOMIC_ACQUIRE, "agent");
            asm volatile("s_waitcnt vmcnt(0)" ::: "memory");
        }
    }
    __syncthreads();
}

struct Args { const float* in[16]; float* out; unsigned char* ws; int ph_lo, ph_hi; };
enum { I_X = 0, I_WIN, I_UK, I_UV, I_SINK, I_WBR, I_WO, I_LN1G, I_LN1B, I_RW, I_RB, I_MG, I_MU, I_MD, I_LN2G, I_LN2B };

typedef GAS unsigned char gbyte;
struct Frame {
    LAS unsigned char* lds;
    gbyte* wsg;
    GAS const float* ing[16];
    GAS float* outg;
    int tid, lane, wave, vcu, G;
};
#define F_WS ((unsigned char*)F.wsg)
#define F_IN(i) ((const float*)F.ing[i])
#define F_OUT ((float*)F.outg)

template <class F>
__device__ __forceinline__ void transpose_item(bf16* WT, int ldk, int row0, int k0, LAS float* scr, int lane, const F& val) {
#pragma unroll 4
    for (int i = 0; i < 32; ++i) { const int kk = 2 * i + (lane >> 5); scr[kk * 33 + (lane & 31)] = val(k0 + kk, row0 + (lane & 31)); }
    LDS_WAIT(); asm volatile("" ::: "memory");
    const int c = lane & 7;
#pragma unroll
    for (int j = 0; j < 4; ++j) { const int n = (lane >> 3) + 8 * j; const LAS float* s = scr + (8 * c) * 33 + n;
        v4u o; o.x = pk2(s[0 * 33], s[1 * 33]); o.y = pk2(s[2 * 33], s[3 * 33]); o.z = pk2(s[4 * 33], s[5 * 33]); o.w = pk2(s[6 * 33], s[7 * 33]);
        *(GAS v4u*)(WT + (size_t)(row0 + n) * ldk + k0 + 8 * c) = o; }
    LDS_WAIT(); asm volatile("" ::: "memory");
}
__device__ __forceinline__ int rope_dim(int p) { return (p >> 1) + 32 * (p & 1); }

__device__ __forceinline__ int win_src(int s) {
    const int tile = s >> 8, u = s & 255;
    switch (tile) {
        case 0: return C_AQ + (u & ~63) + rope_dim(u & 63);
        case 1: return C_IQ + (u & ~63) + rope_dim(u & 63);
        case 2: if (u < 64) return -2 - rope_dim(u); if (u < 128) return -100 - (u - 64); if (u < 192) return C_IK + rope_dim(u - 128); if (u < 196) return C_IW + (u - 192); return -1;
        case 3: return C_BQ + (u & ~63) + rope_dim(u & 63);
        case 4: return C_BK + (u & ~63) + rope_dim(u & 63);
        case 5: return C_BV + u;
        case 6: return C_CQ + (u & ~63) + rope_dim(u & 63);
        case 7: return C_CQ + 256 + (u & ~63) + rope_dim(u & 63);
        case 8: if (u < 128) return C_CK + (u & ~63) + rope_dim(u & 63); return C_CV + (u - 128);
        default: return C_G + (s - 2304);
    }
}

__device__ __forceinline__ void phase_prologue_a(Frame& F) {
    const int gw = F.vcu * NWAVES + F.wave, NGW = F.G * NWAVES;
    {
        float* WFp = (float*)(F_WS + WS_WF);
        for (int i = gw * 64 + F.lane; i < DEPTH * 1024 * 128; i += NGW * 64) {
            const int l = i >> 17, k = (i >> 7) & 1023, c = i & 127;
            const float* W = F_IN(I_WIN) + (size_t)l * D * N_IN + (size_t)k * N_IN + C_AC;
            const float* U = (c < 64 ? F_IN(I_UK) : F_IN(I_UV)) + (size_t)l * 128 * 64 + (c & 63);
            float a = 0.f;
#pragma unroll 8
            for (int r = 0; r < 128; ++r) a = fmaf(W[r], U[r * 64], a);
            WFp[i] = a;
        }
    }
    {
        float* COS = (float*)(F_WS + WS_ROPE); float* SIN = COS + SEQ * 32;
        for (int i = gw * 64 + F.lane; i < SEQ * 32; i += NGW * 64) {
            const int pos = i >> 5, j = i & 31;
            const float inv = 1.0f / (float)pow(10000.0, (double)(2 * j) / 64.0);
            const float ang = (float)pos * inv;
            COS[i] = (float)cos((double)ang); SIN[i] = (float)sin((double)ang);
        }
    }
    {
        const f32x4* x4 = (const f32x4*)F_IN(I_X); v2u* xb = (v2u*)(F_WS + WS_XB);
        for (size_t i = (size_t)gw * 64 + F.lane; i < (size_t)T * D / 4; i += (size_t)NGW * 64) { const f32x4 v = x4[i]; v2u o; o.x = pk2(v.x, v.y); o.y = pk2(v.z, v.w); xb[i] = o; }
    }
}
__device__ __forceinline__ void phase_prologue(Frame& F) {
    LAS float* scr = (LAS float*)(F.lds + F.wave * 16384);
    const int gw = F.vcu * NWAVES + F.wave, NGW = F.G * NWAVES;
    constexpr int I_WINL = (N_INP / 32) * (D / 64);
    constexpr int I_BRL = (1024 / 32) * (1024 / 64);
    constexpr int I_WOL = (1024 / 32) * (1024 / 64);
    constexpr int NITEMS = DEPTH * (I_WINL + I_BRL + I_WOL);
    for (int it = gw; it < NITEMS; it += NGW) {
        int r = it; const int l = r / (I_WINL + I_BRL + I_WOL); r -= l * (I_WINL + I_BRL + I_WOL);
        if (r < I_WINL) {
            const float* W = F_IN(I_WIN) + (size_t)l * D * N_IN; const float* WFp = (const float*)(F_WS + WS_WF);
            bf16* WT = (bf16*)(F_WS + WS_WIN) + (size_t)l * N_INP * D;
            const int rg = r / 16, kc = r % 16;
            transpose_item(WT, D, rg * 32, kc * 64, scr, F.lane, [&](int k, int row) -> float {
                const int c = win_src(row);
                if (c >= 0) return W[(size_t)k * N_IN + c];
                if (c == -1) return 0.f;
                const int cc = (c > -100) ? (-2 - c) : (64 + (-100 - c));
                const float a = WFp[((size_t)l * 1024 + k) * 128 + cc];
                return a; });
            continue; }
        r -= I_WINL;
        if (r < I_BRL) {
            const float* W = F_IN(I_WBR) + (size_t)l * 1024 * 1024; bf16* WT = (bf16*)(F_WS + WS_WBR) + (size_t)l * 1024 * 1024;
            const int rg = r / 16, kc = r % 16;
            transpose_item(WT, 1024, rg * 32, kc * 64, scr, F.lane, [&](int k, int row) -> float { return W[(size_t)k * 1024 + row]; });
            continue; }
        r -= I_BRL;
        {
            const float* W = F_IN(I_WO) + (size_t)l * 1024 * 1024; bf16* WT = (bf16*)(F_WS + WS_WO) + (size_t)l * 1024 * 1024;
            const int rg = r / 16, kc = r % 16;
            transpose_item(WT, 1024, rg * 32, kc * 64, scr, F.lane, [&](int k, int row) -> float { return W[(size_t)k * 1024 + row]; });
        }
    }
}

__device__ __forceinline__ void convert_moe_weights(Frame& F, int l) {
    LAS float* scr = (LAS float*)(F.lds + F.wave * 16384);
    const int gw = F.vcu * NWAVES + F.wave, NGW = F.G * NWAVES;
    constexpr int I_GU = NEXP * (1024 / 32) * (1024 / 64);
    constexpr int I_D = NEXP * (1024 / 32) * (512 / 64);
    const float* WG = F_IN(I_MG) + (size_t)l * NEXP * D * DE; const float* WU = F_IN(I_MU) + (size_t)l * NEXP * D * DE; const float* WD = F_IN(I_MD) + (size_t)l * NEXP * DE * D;
    for (int it = gw; it < I_GU + I_D; it += NGW) {
        if (it < I_GU) {
            const int e = it / 512, r = it % 512, rg = r / 16, kc = r % 16;
            bf16* WT = (bf16*)(F_WS + WS_WGU) + (size_t)e * 1024 * 1024;
            const float* g = WG + (size_t)e * D * DE; const float* u = WU + (size_t)e * D * DE;
            transpose_item(WT, 1024, rg * 32, kc * 64, scr, F.lane, [&](int k, int row) -> float { const int j = 4 * (row >> 3) + (row & 3); return (row & 4) ? u[(size_t)k * DE + j] : g[(size_t)k * DE + j]; });
        } else {
            const int r0 = it - I_GU, e = r0 / 256, r = r0 % 256, rg = r / 8, kc = r % 8;
            bf16* WT = (bf16*)(F_WS + WS_WD) + (size_t)e * DE;
            const float* w = WD + (size_t)e * DE * D;
            transpose_item(WT, NEXP * DE, rg * 32, kc * 64, scr, F.lane, [&](int k, int row) -> float { return w[(size_t)k * D + row]; });
        }
    }
}

struct SchedDense {
    const char* A; const char* B; int lda, lda_b, ldb_b, nN, nt, G, vcu, ntiles;
    __device__ __forceinline__ bool next(int i, pg8::Unit& u) const {
        const int L = i * G + vcu; if (L >= ntiles) return false;
        const int per_grp = 8 * nN, grp = L / per_grp, w = L % per_grp, pn = w / 8, pm = grp * 8 + (w % 8);
        u.A = A + (size_t)pm * lda_b; u.B = B + (size_t)pn * ldb_b; u.rowlist = nullptr; u.nvalid = 256; u.lda = lda; u.nt = nt; u.ksplit = 1 << 30; u.bdelta = 0; u.p0 = pm; u.p1 = pn; u.p2 = 0; u.p3 = 0; return true;
    }
};

template <int EMODE = 0> struct EpiInProjT {
    static constexpr bool PERM = true;
    static __device__ __forceinline__ bool keep_acc(const pg8::Unit&) { return false; }
    unsigned char* ws;
    __device__ __forceinline__ void operator()(const f32x4 (&acc)[2][2][4][2], const pg8::Unit& u, int wr, int wc, int fr, int fq) const {
        const int pm = u.p0, pn = u.p1;
        const float* COS = (const float*)(ws + WS_ROPE); const float* SIN = COS + SEQ * 32;
        const int row0 = pm * 256 + wr * 64 + fr;
        float ksum[2][8];
#pragma unroll
        for (int bj = 0; bj < 2; ++bj)
#pragma unroll
            for (int e = 0; e < 8; ++e) ksum[bj][e] = 0.f;
        f32x4 rcs[2][4], rsn[2][4];
        if (pn <= 8) {
            const int j0 = ((wc * 32 + 8 * fq) & 63) >> 1;
#pragma unroll
            for (int ai = 0; ai < 2; ++ai)
#pragma unroll
                for (int m = 0; m < 4; ++m) { const int pos = (row0 + ai * 128 + m * 16) & (SEQ - 1); rcs[ai][m] = *(const f32x4*)(COS + pos * 32 + j0); rsn[ai][m] = *(const f32x4*)(SIN + pos * 32 + j0); }
        }
#pragma unroll
        for (int ai = 0; ai < 2; ++ai)
#pragma unroll
            for (int m = 0; m < 4; ++m) {
                const int row = row0 + ai * 128 + m * 16; const int pos = row & (SEQ - 1);
#pragma unroll
                for (int bj = 0; bj < 2; ++bj) {
                    const int cl = bj * 128 + wc * 32 + 8 * fq;
                    float v[8];
#pragma unroll
                    for (int e = 0; e < 4; ++e) { v[e] = acc[ai][bj][m][0][e]; v[4 + e] = acc[ai][bj][m][1][e]; }
                    int kind;
                    unsigned char* obase; int pitch, ocol;
                    if (pn == 0) { kind = 1; obase = ws + WS_AQ; pitch = 256; ocol = cl; }
                    else if (pn == 1) { kind = 2; obase = ws + WS_IQ; pitch = 256; ocol = cl; }
                    else if (pn == 2) {
                        if (cl < 64) { kind = 1; obase = ws + WS_KAVA; pitch = 128; ocol = cl; }
                        else if (cl < 128) { kind = 0; obase = ws + WS_KAVA; pitch = 128; ocol = cl; }
                        else if (cl < 192) { kind = 2; obase = ws + WS_IK; pitch = 64; ocol = cl - 128; }
                        else if (cl == 192) { kind = 4; obase = ws + WS_IW; pitch = 4; ocol = 0; }
                        else { kind = 5; obase = ws; pitch = 0; ocol = 0; }
                    }
                    else if (pn == 3) { kind = 1; obase = ws + WS_BQ; pitch = 256; ocol = cl; }
                    else if (pn == 4) { kind = 1; obase = ws + WS_BK; pitch = 256; ocol = cl; }
                    else if (pn == 5) { kind = 0; obase = ws + WS_BV; pitch = 256; ocol = cl; }
                    else if (pn == 6) { kind = 1; obase = ws + WS_CQ; pitch = 512; ocol = cl; }
                    else if (pn == 7) { kind = 1; obase = ws + WS_CQ; pitch = 512; ocol = 256 + cl; }
                    else if (pn == 8) { kind = (cl < 128) ? 1 : 0; obase = ws + WS_CKV; pitch = 256; ocol = cl; }
                    else { kind = 3; obase = ws + WS_GATES; pitch = 3072; ocol = (pn - 9) * 256 + cl; }
                    if ((kind == 1 || kind == 2) && !(EMODE & 1)) {
                        const f32x4 cs = rcs[ai][m], sn = rsn[ai][m];
#pragma unroll
                        for (int e = 0; e < 4; ++e) { const float t1 = v[2 * e], t2 = v[2 * e + 1]; v[2 * e] = t1 * cs[e] - t2 * sn[e]; v[2 * e + 1] = t2 * cs[e] + t1 * sn[e]; }
                    }
                    if (kind == 3) {
                        unsigned q0 = 0u, q1 = 0u;
#pragma unroll
                        for (int e = 0; e < 4; ++e) {
                            q0 = __builtin_amdgcn_cvt_pk_u8_f32(__builtin_amdgcn_fmed3f(sigmoidf_(v[e]) * 255.0f, 1.0f, 255.0f), e, q0);
                            q1 = __builtin_amdgcn_cvt_pk_u8_f32(__builtin_amdgcn_fmed3f(sigmoidf_(v[4 + e]) * 255.0f, 1.0f, 255.0f), e, q1); }
                        *(v2u*)(obase + (size_t)row * pitch + ocol) = (v2u){q0, q1};
                    }
                    if (pn == 4) {
#pragma unroll
                        for (int e = 0; e < 8; ++e) ksum[bj][e] += v[e];
                    }
                    if (kind == 0 || kind == 1) {
                        v4u w; w.x = cvt_pk_bf16(v[0], v[1]); w.y = cvt_pk_bf16(v[2], v[3]); w.z = cvt_pk_bf16(v[4], v[5]); w.w = cvt_pk_bf16(v[6], v[7]);
                        if (pn == 4) *(v4u*)((bf16*)obase + bk_off(cl >> 6, row, (cl & 63) >> 3)) = w;
                        else *(v4u*)((bf16*)obase + (size_t)row * pitch + ocol) = w;
                    } else if (kind == 2) {
                        v4u w; w.x = pk2h(v[0], v[1]); w.y = pk2h(v[2], v[3]); w.z = pk2h(v[4], v[5]); w.w = pk2h(v[6], v[7]);
                        if (pn == 2) *(v4u*)((u16*)obase + ik_off(row, ocol >> 3)) = w;
                        else *(v4u*)((u16*)obase + (size_t)row * pitch + ocol) = w;
                    } else if (kind == 4) {
                        *(f32x4*)((float*)obase + (size_t)row * 4) = (f32x4){v[0], v[1], v[2], v[3]};
                    }
                }
            }
        if (pn == 4) {
            float* KMP = (float*)(ws + WS_KMP) + (size_t)(pm * 2 + wr) * 256;
#pragma unroll
            for (int bj = 0; bj < 2; ++bj)
#pragma unroll
                for (int e = 0; e < 8; ++e) { float s = ksum[bj][e]; s += xor_f<1>(s); s += xor_f<2>(s); s += xor_f<4>(s); s += xor_f<8>(s); ksum[bj][e] = s; }
            if (fr == 0) {
#pragma unroll
                for (int bj = 0; bj < 2; ++bj) { float* o = KMP + bj * 128 + wc * 32 + 8 * fq;
                    *(f32x4*)o = (f32x4){ksum[bj][0], ksum[bj][1], ksum[bj][2], ksum[bj][3]}; *(f32x4*)(o + 4) = (f32x4){ksum[bj][4], ksum[bj][5], ksum[bj][6], ksum[bj][7]}; }
            }
        }
    }
};

typedef EpiInProjT<0> EpiInProj;
struct EpiNone { static constexpr bool PERM = true; static __device__ __forceinline__ bool keep_acc(const pg8::Unit&) { return false; }
    float* sink; __device__ __forceinline__ void operator()(const f32x4 (&acc)[2][2][4][2], const pg8::Unit& u, int wr, int wc, int fr, int fq) const { float s = 0.f;
#pragma unroll
        for (int a = 0; a < 2; ++a)
#pragma unroll
            for (int b = 0; b < 2; ++b)
#pragma unroll
                for (int m = 0; m < 4; ++m)
#pragma unroll
                    for (int n = 0; n < 2; ++n) s += (acc[a][b][m][n][0] + acc[a][b][m][n][1]) + (acc[a][b][m][n][2] + acc[a][b][m][n][3]);
        if (s == 1.2345e-30f) sink[0] = 1.f; } };
__device__ __forceinline__ void phase_inproj_probe(Frame& F, int l) {
    SchedDense S; S.A = (const char*)(F_WS + WS_XB); S.B = (const char*)(F_WS + WS_WIN) + (size_t)l * N_INP * D * 2; S.lda = D; S.lda_b = 256 * D * 2; S.ldb_b = 256 * D * 2; S.nN = N_INP / 256; S.nt = D / 64; S.G = F.G; S.vcu = F.vcu; S.ntiles = (T / 256) * (N_INP / 256);
    EpiNone E{(float*)(F_WS + WS_CTL) + 8};
    pg8::gemm_phase<EpiNone, SchedDense, true>(F.lds, F.tid, D, S, E);
}
template <int EMODE> __device__ __forceinline__ void phase_inproj_mode(Frame& F, int l) {
    SchedDense S; S.A = (const char*)(F_WS + WS_XB); S.B = (const char*)(F_WS + WS_WIN) + (size_t)l * N_INP * D * 2; S.lda = D; S.lda_b = 256 * D * 2; S.ldb_b = 256 * D * 2; S.nN = N_INP / 256; S.nt = D / 64; S.G = F.G; S.vcu = F.vcu; S.ntiles = (T / 256) * (N_INP / 256);
    EpiInProjT<EMODE> E{F_WS};
    pg8::gemm_phase<EpiInProjT<EMODE>, SchedDense, true>(F.lds, F.tid, D, S, E);
}
__device__ __forceinline__ void phase_inproj(Frame& F, int l) {
    SchedDense S; S.A = (const char*)(F_WS + WS_XB); S.B = (const char*)(F_WS + WS_WIN) + (size_t)l * N_INP * D * 2; S.lda = D; S.lda_b = 256 * D * 2; S.ldb_b = 256 * D * 2; S.nN = N_INP / 256; S.nt = D / 64; S.G = F.G; S.vcu = F.vcu; S.ntiles = (T / 256) * (N_INP / 256);
    EpiInProj E{F_WS};
    pg8::gemm_phase<EpiInProj, SchedDense, true>(F.lds, F.tid, D, S, E);
}

constexpr int KROW = 144;
struct FlashState { float m, l; f32x16 o0, o1; };
__device__ __forceinline__ s16x4 tr_read(unsigned addr) { s16x4 r; asm volatile("ds_read_b64_tr_b16 %0, %1" : "=v"(r) : "v"(addr) : "memory"); return r; }
__device__ __forceinline__ void flash_core(FlashState& st, const bf16x8 (&qf)[4], const bf16x8 (&kfr)[4], unsigned Vt, unsigned vmask, int lane);
__device__ __forceinline__ void flash_tile(FlashState& st, const bf16x8 (&qf)[4], unsigned Kt, unsigned Vt, unsigned vmask, int lane) {
    const int r32 = lane & 31, half = lane >> 5;
    bf16x8 kfr[4];
#pragma unroll
    for (int ks = 0; ks < 4; ++ks) kfr[ks] = *(const LAS bf16x8*)(uintptr_t)(Kt + r32 * KROW + (16 * ks + 8 * half) * 2);
    flash_core(st, qf, kfr, Vt, vmask, lane);
}
__device__ __forceinline__ void flash_core(FlashState& st, const bf16x8 (&qf)[4], const bf16x8 (&kfr)[4], unsigned Vt, unsigned vmask, int lane) {
    const int half = lane >> 5;
    f32x16 s = {};
#pragma unroll
    for (int ks = 0; ks < 4; ++ks) s = __builtin_amdgcn_mfma_f32_32x32x16_bf16(kfr[ks], qf[ks], s, 0, 0, 0);
    const bool full = __ballot(vmask != 0xffffu) == 0ull;
    float mx = -1e30f;
    if (full) {
#pragma unroll
        for (int i = 0; i < 16; ++i) mx = fmaxf(mx, s[i]);
        mx *= SM_C;
    } else {
#pragma unroll
        for (int i = 0; i < 16; ++i) { const float v = ((vmask >> i) & 1u) ? s[i] : -1e30f; mx = fmaxf(mx, v); }
        mx = fmaxf(mx * SM_C, -1e30f);
    }
    mx = half_max(mx);
    const float mn = fmaxf(st.m, mx), alpha = __builtin_amdgcn_exp2f(st.m - mn);
    float ls = 0.f; float p[16];
    if (full) {
#pragma unroll
        for (int i = 0; i < 16; ++i) { p[i] = __builtin_amdgcn_exp2f(fmaf(s[i], SM_C, -mn)); ls += p[i]; }
    } else {
#pragma unroll
        for (int i = 0; i < 16; ++i) { p[i] = ((vmask >> i) & 1u) ? __builtin_amdgcn_exp2f(fmaf(s[i], SM_C, -mn)) : 0.f; ls += p[i]; }
    }
    st.l = st.l * alpha + ls; st.m = mn;
    if (__ballot(alpha != 1.0f) != 0ull) {
#pragma unroll
        for (int i = 0; i < 16; ++i) { st.o0[i] *= alpha; st.o1[i] *= alpha; }
    }
#pragma unroll
    for (int sx = 0; sx < 2; ++sx) {
        v4u pw; pw.x = cvt_pk_bf16(p[8 * sx + 0], p[8 * sx + 1]); pw.y = cvt_pk_bf16(p[8 * sx + 2], p[8 * sx + 3]); pw.z = cvt_pk_bf16(p[8 * sx + 4], p[8 * sx + 5]); pw.w = cvt_pk_bf16(p[8 * sx + 6], p[8 * sx + 7]);
        const bf16x8 pf = __builtin_bit_cast(bf16x8, pw);
        const int g = lane >> 4, i16 = lane & 15, q_ = i16 >> 2, pp = i16 & 3;
#pragma unroll
        for (int dt = 0; dt < 2; ++dt) {
            const unsigned a0 = Vt + (16 * sx + 4 * (g >> 1) + q_) * KROW + (32 * dt + 16 * (g & 1) + 4 * pp) * 2;
            s16x4 lo = tr_read(a0), hi = tr_read(a0 + 8 * KROW);
            asm volatile("s_waitcnt lgkmcnt(0)" : "+v"(lo), "+v"(hi) :: "memory");
            const bf16x8 vf = (bf16x8){lo[0], lo[1], lo[2], lo[3], hi[0], hi[1], hi[2], hi[3]};
            if (dt == 0) st.o0 = __builtin_amdgcn_mfma_f32_32x32x16_bf16(vf, pf, st.o0, 0, 0, 0);
            else st.o1 = __builtin_amdgcn_mfma_f32_32x32x16_bf16(vf, pf, st.o1, 0, 0, 0);
        }
    }
}
__device__ __forceinline__ void flash_store(const FlashState& st, float scale, bf16* orow, int lane) {
    const int half = lane >> 5;
#pragma unroll
    for (int dt = 0; dt < 2; ++dt)
#pragma unroll
        for (int g = 0; g < 4; ++g) {
            const f32x16& o = dt ? st.o1 : st.o0;
            v2u w; w.x = cvt_pk_bf16(o[4 * g] * scale, o[4 * g + 1] * scale); w.y = cvt_pk_bf16(o[4 * g + 2] * scale, o[4 * g + 3] * scale);
            *(v2u*)(orow + 32 * dt + 8 * g + 4 * half) = w;
        }
}
__device__ __forceinline__ void stage_rows(LAS unsigned char* dst, const bf16* src, long pitch, int first_valid, int tid) {
#pragma unroll
    for (int i = 0; i < 4; ++i) { const int pid = tid + 512 * i, r = pid >> 3, pc = pid & 7;
        v4u v = (v4u){0u, 0u, 0u, 0u};
        if (r >= first_valid) v = *(const v4u*)(src + (long)r * pitch + pc * 8);
        *(LAS v4u*)(dst + r * KROW + pc * 16) = v; }
}
__device__ __forceinline__ void stage_rows2(LAS unsigned char* dstk, const bf16* srck, LAS unsigned char* dstv, const bf16* srcv, long pitch, int first_valid, int tid) {
    v4u vk[4], vv[4];
#pragma unroll
    for (int i = 0; i < 4; ++i) { const int pid = tid + 512 * i, r = max(pid >> 3, first_valid), pc = pid & 7;
        vk[i] = *(const v4u*)(srck + (long)r * pitch + pc * 8); vv[i] = *(const v4u*)(srcv + (long)r * pitch + pc * 8); }
#pragma unroll
    for (int i = 0; i < 4; ++i) { const int pid = tid + 512 * i, r = pid >> 3, pc = pid & 7; const bool z = r < first_valid;
        *(LAS v4u*)(dstk + r * KROW + pc * 16) = z ? (v4u){0u, 0u, 0u, 0u} : vk[i]; *(LAS v4u*)(dstv + r * KROW + pc * 16) = z ? (v4u){0u, 0u, 0u, 0u} : vv[i]; }
}

__device__ __forceinline__ void moba_unit(Frame& F, int b, int h, int c) {
    LAS unsigned char* KS = F.lds; LAS unsigned char* VS = F.lds + 256 * KROW; LAS float* KM = (LAS float*)(F.lds + 2 * 256 * KROW);
    const int lane = F.lane, w = F.wave, r32 = lane & 31, half = lane >> 5;
    const long rowbase = (long)b * SEQ;
    bf16* BQ = (bf16*)(F_WS + WS_BQ); const bf16* BKp = (const bf16*)(F_WS + WS_BK); const bf16* BVp = (const bf16*)(F_WS + WS_BV);
    const float* KMP = (const float*)(F_WS + WS_KMP);
    __syncthreads();
    for (int i = F.tid; i < c * 64; i += NTHR) { const int n = i >> 6, d = i & 63; const float* p0 = KMP + (size_t)((b * 32 + n) * 2) * 256 + h * 64 + d; KM[i] = (p0[0] + p0[256]) * (1.0f / 256.0f); }
    const int tq = 256 * c + 32 * w + r32;
    const bf16* qrow = BQ + (rowbase + tq) * 256 + h * 64;
    bf16x8 qf[4];
#pragma unroll
    for (int ks = 0; ks < 4; ++ks) qf[ks] = *(const bf16x8*)(qrow + 16 * ks + 8 * half);
    __syncthreads();
    unsigned selmask = 0u;
    {
        v4u qp[8];
#pragma unroll
        for (int i = 0; i < 8; ++i) qp[i] = *(const v4u*)(qrow + 8 * i);
        float v1 = -INFINITY, v2 = -INFINITY, v3 = -INFINITY; int i1 = -1, i2 = -1, i3 = -1;
        for (int n = 0; n < c; ++n) {
            float a = 0.f;
#pragma unroll
            for (int i = 0; i < 8; ++i) {
                const f32x4 k0 = *(const LAS f32x4*)(KM + n * 64 + 8 * i), k1 = *(const LAS f32x4*)(KM + n * 64 + 8 * i + 4);
                a = fmaf(bflo(qp[i].x), k0[0], a); a = fmaf(bfhi(qp[i].x), k0[1], a); a = fmaf(bflo(qp[i].y), k0[2], a); a = fmaf(bfhi(qp[i].y), k0[3], a);
                a = fmaf(bflo(qp[i].z), k1[0], a); a = fmaf(bfhi(qp[i].z), k1[1], a); a = fmaf(bflo(qp[i].w), k1[2], a); a = fmaf(bfhi(qp[i].w), k1[3], a);
            }
            if (a > v1) { v3 = v2; i3 = i2; v2 = v1; i2 = i1; v1 = a; i1 = n; }
            else if (a > v2) { v3 = v2; i3 = i2; v2 = a; i2 = n; }
            else if (a > v3) { v3 = a; i3 = n; }
        }
        if (i1 >= 0) selmask |= 1u << i1; if (i2 >= 0) selmask |= 1u << i2; if (i3 >= 0) selmask |= 1u << i3;
    }
    FlashState st; st.m = -1e30f; st.l = 0.f; st.o0 = (f32x16){}; st.o1 = (f32x16){};
    const unsigned KSa = (unsigned)(uintptr_t)KS, VSa = (unsigned)(uintptr_t)VS;
    for (int n = 0; n <= c; ++n) {
        __syncthreads();
        stage_rows(KS, BKp + (rowbase + 256 * n) * 256 + h * 64, 256, 0, F.tid);
        stage_rows(VS, BVp + (rowbase + 256 * n) * 256 + h * 64, 256, 0, F.tid);
        __syncthreads();
        const bool own = (n == c);
        const bool mine = own || ((selmask >> n) & 1u);
        if (__ballot(mine) == 0ull) continue;
        const int ktmax = own ? w : 7;
        for (int kt = 0; kt <= ktmax; ++kt) {
            unsigned vm = 0u;
            if (mine) {
                if (!own || kt < w) vm = 0xffffu;
                else {
#pragma unroll
                    for (int i = 0; i < 16; ++i) { const int kl = (i & 3) + 8 * (i >> 2) + 4 * half; if (kl <= r32) vm |= 1u << i; }
                }
            }
            flash_tile(st, qf, KSa + kt * 32 * KROW, VSa + kt * 32 * KROW, vm, lane);
        }
    }
    const float lt = half_sum(st.l);
    flash_store(st, 1.0f / lt, BQ + (rowbase + tq) * 256 + h * 64, lane);
}


constexpr int MB_ST = 0, MB_VST = 73728, MB_KM = 110592, MB_SELB = 118784, MB_ITQ = 119808  , MB_ITB = 126720  , MB_NIT = 126944;
constexpr int MB_STW = 36;
__device__ __forceinline__ void moba_item(Frame& F, FlashState& st, const bf16x8 (&qf)[4], const bf16* Kt, int hh, long krow0, const bf16* Vg, int ktiles, int lane, int w, unsigned vm_full, bool causal, int qloc) {
    const int r32 = lane & 31, half = lane >> 5;
    LAS unsigned char* VT = F.lds + MB_VST + w * (32 * KROW);
    const unsigned VTa = (unsigned)(uintptr_t)VT;
    bf16x8 kc[4], kn[4], kf2[4]; v4u vc[4], vn[4], vf2[4];
    const bf16* kp = Kt + bk_off(hh, krow0 + r32, half);
    const bf16* vpa = Vg + (long)((lane >> 3) + 8) * 256 + 8 * (lane & 7); const bf16* vpb = vpa + 16 * 256;
#define MB_LD(kd, vd, kt_) do { const int kq_ = min((kt_), ktiles - 1); const bf16* kq = kp + (long)kq_ * 2048; \
        _Pragma("unroll") for (int ks = 0; ks < 4; ++ks) kd[ks] = *(const bf16x8*)(kq + ks * 512); \
        const bf16* va_ = vpa + (long)kq_ * 8192; const bf16* vb_ = vpb + (long)kq_ * 8192; \
        vd[0] = *(const v4u*)(va_ - 2048); vd[1] = *(const v4u*)va_; vd[2] = *(const v4u*)(vb_ - 2048); vd[3] = *(const v4u*)vb_; } while (0)
#define MB_PIN() asm volatile("" ::: "memory")
#define MB_STEP(kd, vd, kt_) do { \
        _Pragma("unroll") for (int i = 0; i < 4; ++i) { const int p = lane + 64 * i; *(LAS v4u*)(VT + (p >> 3) * KROW + 16 * (p & 7)) = vd[i]; } \
        LDS_WAIT(); \
        unsigned vm = vm_full; \
        if (causal && (kt_) == ktiles - 1) { vm = 0u;                  \
            _Pragma("unroll") for (int g = 0; g < 4; ++g) { const int nb = min(max(qloc - 4 * half - 8 * g + 1, 0), 4); vm |= ((1u << nb) - 1u) << (4 * g); } \
            vm &= vm_full; } \
        flash_core(st, qf, kd, VTa, vm, lane); } while (0)
    MB_LD(kc, vc, 0); MB_PIN(); MB_LD(kn, vn, 1); MB_PIN(); MB_LD(kf2, vf2, 2); MB_PIN();
    for (int kt = 0; kt < ktiles; kt += 3) {
        MB_STEP(kc, vc, kt);
        MB_PIN(); MB_LD(kc, vc, kt + 3); MB_PIN();
        if (kt + 1 < ktiles) MB_STEP(kn, vn, kt + 1);
        MB_PIN(); MB_LD(kn, vn, kt + 4); MB_PIN();
        if (kt + 2 < ktiles) MB_STEP(kf2, vf2, kt + 2);
        MB_PIN(); MB_LD(kf2, vf2, kt + 5); MB_PIN();
    }
#undef MB_STEP
#undef MB_PIN
#undef MB_LD
}
__device__ __forceinline__ void moba_unit2(Frame& F, int b, int h, int c) {
    int lane_ = F.lane; asm volatile("" : "+v"(lane_));
    const int lane = lane_, w = F.wave, r32 = lane & 31, half = lane >> 5;
    const long rowbase = (long)b * SEQ;
    bf16* BQ = (bf16*)(F_WS + WS_BQ); const bf16* BKt = (const bf16*)(F_WS + WS_BK); const bf16* BVp = (const bf16*)(F_WS + WS_BV) + rowbase * 256 + h * 64;
    const float* KMP = (const float*)(F_WS + WS_KMP);
    LAS float* ST = (LAS float*)(F.lds + MB_ST); LAS float* KM = (LAS float*)(F.lds + MB_KM);
    LAS unsigned char* SELB = F.lds + MB_SELB; LAS unsigned char* ITQ = F.lds + MB_ITQ; LAS unsigned char* ITB = F.lds + MB_ITB; LAS int* NIT = (LAS int*)(F.lds + MB_NIT);
    __syncthreads();
    for (int i = F.tid; i < c * 64; i += NTHR) { const int n = i >> 6, d = i & 63; const float* p0 = KMP + (size_t)((b * 32 + n) * 2) * 256 + h * 64 + d; KM[i] = (p0[0] + p0[256]) * (1.0f / 256.0f); }
    for (int i = F.tid; i < 256 * 2 * MB_STW; i += NTHR) { const int f = i % MB_STW; ST[i] = (f == 32) ? -1e30f : 0.f; }
    __syncthreads();
    {
        const int tq = 256 * c + 32 * w + r32;
        const bf16* qrow = BQ + (rowbase + tq) * 256 + h * 64;
        v4u qp[8];
#pragma unroll
        for (int i = 0; i < 8; ++i) qp[i] = *(const v4u*)(qrow + 8 * i);
        float v1 = -INFINITY, v2 = -INFINITY, v3 = -INFINITY; int i1 = -1, i2 = -1, i3 = -1;
        for (int n = 0; n < c; ++n) {
            float a = 0.f;
#pragma unroll
            for (int i = 0; i < 8; ++i) {
                const f32x4 k0 = *(const LAS f32x4*)(KM + n * 64 + 8 * i), k1 = *(const LAS f32x4*)(KM + n * 64 + 8 * i + 4);
                a = fmaf(bflo(qp[i].x), k0[0], a); a = fmaf(bfhi(qp[i].x), k0[1], a); a = fmaf(bflo(qp[i].y), k0[2], a); a = fmaf(bfhi(qp[i].y), k0[3], a);
                a = fmaf(bflo(qp[i].z), k1[0], a); a = fmaf(bfhi(qp[i].z), k1[1], a); a = fmaf(bflo(qp[i].w), k1[2], a); a = fmaf(bfhi(qp[i].w), k1[3], a);
            }
            if (a > v1) { v3 = v2; i3 = i2; v2 = v1; i2 = i1; v1 = a; i1 = n; }
            else if (a > v2) { v3 = v2; i3 = i2; v2 = a; i2 = n; }
            else if (a > v3) { v3 = a; i3 = n; }
        }
        unsigned selmask = 0u;
        if (i1 >= 0) selmask |= 1u << i1; if (i2 >= 0) selmask |= 1u << i2; if (i3 >= 0) selmask |= 1u << i3;
        if (half == 0) { unsigned m = selmask; unsigned rec = 0u; int cnt = 0;
#pragma unroll
            for (int r = 0; r < 3; ++r) if (m) { const int n = __builtin_ctz(m); m &= m - 1u; rec |= (unsigned)n << (8 * r); ++cnt; }
            rec |= (unsigned)cnt << 24;
            *(LAS unsigned*)(SELB + 4 * (32 * w + r32)) = rec; }
    }
    __syncthreads();
    const unsigned long long lt_mask = (1ull << lane) - 1ull;
    if (w < 3) {
        const int r = w; LAS unsigned char* itq = ITQ + r * 2304; LAS unsigned char* itb = ITB + r * 72;
        unsigned rec[4];
#pragma unroll
        for (int ch = 0; ch < 4; ++ch) rec[ch] = *(const LAS unsigned*)(SELB + 4 * (64 * ch + lane));
        int nit = 0;
        for (int n = 0; n < c; ++n) {
            int pos = 0;
#pragma unroll
            for (int ch = 0; ch < 4; ++ch) {
                const bool hit = ((int)(rec[ch] >> 24) > r) && ((int)((rec[ch] >> (8 * r)) & 0xffu) == n);
                const unsigned long long bm = __ballot(hit);
                if (hit) { const int p = pos + __popcll(bm & lt_mask); itq[(nit + (p >> 5)) * 32 + (p & 31)] = (unsigned char)(64 * ch + lane); }
                pos += __popcll(bm);
            }
            const int ni = (pos + 31) >> 5;
            if (ni > 0) { const int tail = pos & 31; if (tail && lane >= tail && lane < 32) itq[(nit + ni - 1) * 32 + lane] = 0xffu;
                if (lane < ni) itb[nit + lane] = (unsigned char)n; }
            nit += ni;
        }
        if (lane == 0) NIT[r] = nit;
    }
    __syncthreads();
    for (int r = 0; r < 3; ++r) {
        LAS unsigned char* itq = ITQ + r * 2304; LAS unsigned char* itb = ITB + r * 72;
        const int nit = NIT[r];
        for (int it = w; it < nit; it += NWAVES) {
            const int n = itb[it]; const int q = itq[it * 32 + r32]; const bool valid = q != 0xff; const int qq = valid ? q : 0;
            const bf16* qrow = BQ + (rowbase + 256 * c + qq) * 256 + h * 64;
            bf16x8 qf[4];
#pragma unroll
            for (int ks = 0; ks < 4; ++ks) qf[ks] = *(const bf16x8*)(qrow + 16 * ks + 8 * half);
            FlashState st; LAS float* sp = ST + (qq * 2 + half) * MB_STW;
#pragma unroll
            for (int i = 0; i < 16; i += 4) { const f32x4 a = *(const LAS f32x4*)(sp + i), bq = *(const LAS f32x4*)(sp + 16 + i); st.o0[i] = a.x; st.o0[i + 1] = a.y; st.o0[i + 2] = a.z; st.o0[i + 3] = a.w; st.o1[i] = bq.x; st.o1[i + 1] = bq.y; st.o1[i + 2] = bq.z; st.o1[i + 3] = bq.w; }
            { const f32x2 ml = *(const LAS f32x2*)(sp + 32); st.m = ml.x; st.l = ml.y; }
            moba_item(F, st, qf, BKt, h, rowbase + 256 * n, BVp + (long)(256 * n) * 256, 8, lane, w, valid ? 0xffffu : 0u, false, 0);
            if (valid) {
#pragma unroll
                for (int i = 0; i < 16; i += 4) { *(LAS f32x4*)(sp + i) = (f32x4){st.o0[i], st.o0[i + 1], st.o0[i + 2], st.o0[i + 3]}; *(LAS f32x4*)(sp + 16 + i) = (f32x4){st.o1[i], st.o1[i + 1], st.o1[i + 2], st.o1[i + 3]}; }
                *(LAS f32x2*)(sp + 32) = (f32x2){st.m, st.l}; }
        }
        __syncthreads();
    }
    {
        const int qloc = 32 * w + r32; const int tq = 256 * c + qloc;
        bf16* qrow = BQ + (rowbase + tq) * 256 + h * 64;
        bf16x8 qf[4];
#pragma unroll
        for (int ks = 0; ks < 4; ++ks) qf[ks] = *(const bf16x8*)(qrow + 16 * ks + 8 * half);
        FlashState st; LAS float* sp = ST + (qloc * 2 + half) * MB_STW;
#pragma unroll
        for (int i = 0; i < 16; i += 4) { const f32x4 a = *(const LAS f32x4*)(sp + i), bq = *(const LAS f32x4*)(sp + 16 + i); st.o0[i] = a.x; st.o0[i + 1] = a.y; st.o0[i + 2] = a.z; st.o0[i + 3] = a.w; st.o1[i] = bq.x; st.o1[i + 1] = bq.y; st.o1[i + 2] = bq.z; st.o1[i + 3] = bq.w; }
        { const f32x2 ml = *(const LAS f32x2*)(sp + 32); st.m = ml.x; st.l = ml.y; }
        moba_item(F, st, qf, BKt, h, rowbase + 256 * c, BVp + (long)(256 * c) * 256, w + 1, lane, w, 0xffffu, true, r32);
        const float lt = half_sum(st.l);
        flash_store(st, 1.0f / lt, qrow, lane);
    }
}

__device__ __forceinline__ void swa_unit(Frame& F, int l, int b, int kvh, int nb) {
    LAS unsigned char* KS = F.lds; LAS unsigned char* VS = F.lds + 256 * KROW;
    const int lane = F.lane, w = F.wave, r32 = lane & 31, half = lane >> 5;
    const long rowbase = (long)b * SEQ;
    bf16* CQ = (bf16*)(F_WS + WS_CQ); const bf16* CKV = (const bf16*)(F_WS + WS_CKV);
    __syncthreads();
    const long band0 = rowbase + 128 * nb - 128;
    stage_rows2(KS, CKV + band0 * 256 + kvh * 64, VS, CKV + band0 * 256 + 128 + kvh * 64, 256, nb == 0 ? 128 : 0, F.tid);
    __syncthreads();
    const int hq = kvh * 4 + (w >> 1);
    const float zs = F_IN(I_SINK)[l * 8 + hq] * LOG2E;
    const unsigned KSa = (unsigned)(uintptr_t)KS, VSa = (unsigned)(uintptr_t)VS;
    for (int gi = 0; gi < 2; ++gi) {
        const int i0 = (w & 1) * 64 + 32 * gi, iq = i0 + r32;
        bf16* qrow = CQ + (rowbase + 128 * nb + iq) * 512 + hq * 64;
        bf16x8 qf[4];
#pragma unroll
        for (int ks = 0; ks < 4; ++ks) qf[ks] = *(const bf16x8*)(qrow + 16 * ks + 8 * half);
        FlashState st; st.m = -1e30f; st.l = 0.f; st.o0 = (f32x16){}; st.o1 = (f32x16){};
        const int kt0 = (i0 + 1) >> 5, kt1 = (i0 + 159) >> 5;
        for (int kt = kt0; kt <= kt1; ++kt) {
            unsigned vm = 0u;
#pragma unroll
            for (int i = 0; i < 16; ++i) { const int kk = kt * 32 + (i & 3) + 8 * (i >> 2) + 4 * half; const bool ok = (kk > iq) && (kk <= iq + 128) && (nb > 0 || kk >= 128); if (ok) vm |= 1u << i; }
            flash_tile(st, qf, KSa + kt * 32 * KROW, VSa + kt * 32 * KROW, vm, lane);
        }
        const float lt = half_sum(st.l);
        const float m2 = fmaxf(st.m, zs), f = __builtin_amdgcn_exp2f(st.m - m2);
        const float lf = lt * f + __builtin_amdgcn_exp2f(zs - m2);
        flash_store(st, f / lf, qrow, lane);
    }
}

constexpr int DSA_KEYS = 0, DSA_HIST = 131072, DSA_SEL = 139264, DSA_BIDX = 143360, DSA_BSC = 145408, DSA_IQ = 149504;
constexpr int DSA_TOPK = 256, DSA_BCAP = 128;
constexpr int DSA_ZC = 153600;
constexpr int DSA_NXT = 153632;
constexpr int CW_DSAQ = 200000;
constexpr int DSA_IWL = 153664;
constexpr int DSA_VROW = 144;
__device__ __forceinline__ unsigned sortable16(float s) { const unsigned b = (unsigned)__builtin_bit_cast(unsigned short, (_Float16)s); return (b ^ ((unsigned)((int)(b << 16) >> 31) | 0x8000u)) & 0xffffu; }
__device__ __forceinline__ float key_float(unsigned k16) { const unsigned b = (k16 & 0x8000u) ? (k16 ^ 0x8000u) : (~k16 & 0xffffu); return (float)__builtin_bit_cast(_Float16, (unsigned short)b); }
__device__ __forceinline__ int lin_bin(float sT, float inv, float c0) { return (int)__builtin_amdgcn_fmed3f(fmaf(sT, inv, c0), 0.f, 255.f); }
__device__ __forceinline__ int wave_prefix_incl(int v, int lane) {
    v += __builtin_amdgcn_update_dpp(0, v, 0x111, 0xf, 0xf, true); v += __builtin_amdgcn_update_dpp(0, v, 0x112, 0xf, 0xf, true);
    v += __builtin_amdgcn_update_dpp(0, v, 0x114, 0xf, 0xf, true); v += __builtin_amdgcn_update_dpp(0, v, 0x118, 0xf, 0xf, true);
    const int t0 = __builtin_amdgcn_readlane(v, 15), t1 = __builtin_amdgcn_readlane(v, 31), t2 = __builtin_amdgcn_readlane(v, 47);
    return v + (lane >= 48 ? t0 + t1 + t2 : (lane >= 32 ? t0 + t1 : (lane >= 16 ? t0 : 0)));
}
__device__ __forceinline__ unsigned pk_gt_flags(unsigned keys, unsigned t2, unsigned one2) { unsigned r; asm("v_pk_sub_u16 %0, %1, %2 clamp\n\tv_pk_min_u16 %0, %0, %3" : "=&v"(r) : "v"(keys), "v"(t2), "v"(one2)); return r; }
__device__ __forceinline__ unsigned pk_add16(unsigned a, unsigned b) { unsigned r; asm("v_pk_add_u16 %0, %1, %2" : "=v"(r) : "v"(a), "v"(b)); return r; }
__device__ __forceinline__ void find_bin(const LAS unsigned* hist, unsigned target, int lane, unsigned& bin, unsigned& above, unsigned& cnt) {
    const v4u hv = *(const LAS v4u*)(hist + 4 * lane);
    const unsigned tl = hv.x + hv.y + hv.z + hv.w;
    const int pin = wave_prefix_incl((int)tl, lane);
    const unsigned suf = (unsigned)(__builtin_amdgcn_readlane(pin, 63) - pin) + tl;
    const unsigned s4 = suf - tl;
    const unsigned S3 = s4 + hv.w, S2 = S3 + hv.z, S1 = S2 + hv.y, S0 = S1 + hv.x;
    int which = -1; unsigned ab = 0, cn = 0;
    if (S3 >= target && s4 < target) { which = 3; ab = s4; cn = hv.w; }
    else if (S2 >= target && S3 < target) { which = 2; ab = S3; cn = hv.z; }
    else if (S1 >= target && S2 < target) { which = 1; ab = S2; cn = hv.y; }
    else if (S0 >= target && S1 < target) { which = 0; ab = S1; cn = hv.x; }
    const unsigned long long bm = __ballot(which >= 0);
    const int src = bm ? (int)__builtin_ctzll(bm) : 0;
    bin = (unsigned)__builtin_amdgcn_readlane(4 * lane + which, src); above = __builtin_amdgcn_readlane(ab, src); cnt = __builtin_amdgcn_readlane(cn, src);
}
__device__ __forceinline__ void dsa_exact_boundary(const LAS u16* IQL, const u16* IKb, f32x4 wq, LAS u16* bidx, LAS float* bsc, LAS u16* sel, int nsel, int E, int need, int lane, unsigned long long lt_mask) {
    float sc[2]; int ki[2];
#pragma unroll
    for (int r = 0; r < 2; ++r) { const int e = lane + 64 * r; sc[r] = -INFINITY; ki[r] = 0x7fffffff;
        if (e < E) { const int key = bidx[e]; ki[r] = key; float s = 0.f;
            for (int hd = 0; hd < 4; ++hd) { float a = 0.f;
                for (int d = 0; d < 64; d += 8) { const f16x8 kv = *(const f16x8*)(IKb + ik_off(key, d >> 3)); const f16x8 qv = *(const LAS f16x8*)(IQL + hd * 64 + d);
#pragma unroll
                    for (int x = 0; x < 8; ++x) a = fmaf((float)qv[x], (float)kv[x], a); }
                s = fmaf(wq[hd], fmaxf(a, 0.f), s); }
            sc[r] = s; bsc[e] = s; } }
    LDS_WAIT();
#pragma unroll
    for (int r = 0; r < 2; ++r) { const int e = lane + 64 * r; int rank = 0;
        if (e < E) { for (int o = 0; o < E; ++o) { const float so = bsc[o]; const int io = bidx[o]; rank += (so > sc[r] || (so == sc[r] && io < ki[r])) ? 1 : 0; } }
        const bool take = (e < E) && rank < need;
        const unsigned long long tm = __ballot(take);
        if (take) sel[nsel + __popcll(tm & lt_mask)] = (u16)ki[r];
        nsel += __popcll(tm); }
}
__device__ __forceinline__ int dsa_rescore_select(LAS unsigned char* lds, const u16* IKb, f32x4 wq, LAS u16* bidx, LAS float* bsc, LAS u16* sel, int nsel, int En, int need_eq, int lane, int w, unsigned long long lt_mask, int dpe) {
    const int r32 = lane & 31, half = lane >> 5;
    f16x8 aop[4];
    { const int q = r32 >> 2, hd = r32 & 3; const LAS u16* pl = (const LAS u16*)(lds + DSA_IQ) + q * 256 + hd * 64 + 8 * half;
#pragma unroll
      for (int ks = 0; ks < 4; ++ks) aop[ks] = *(const LAS f16x8*)(pl + 16 * ks); }
    for (int r0 = 0; r0 < En; r0 += 32) {
        const int c = r0 + r32; const int key = (c < En) ? (int)bidx[c] : 0;
        f32x16 dacc = {};
        f16x8 bop[4];
#pragma unroll
        for (int ks = 0; ks < 4; ++ks) bop[ks] = *(const f16x8*)(IKb + ik_off(key, 2 * ks + half));
        asm volatile("" ::: "memory");
#pragma unroll
        for (int ks = 0; ks < 4; ++ks) dacc = __builtin_amdgcn_mfma_f32_32x32x16_f16(aop[ks], bop[ks], dacc, 0, 0, 0);
        const int g = w >> 1; float s = 0.f;
#pragma unroll
        for (int hd = 0; hd < 4; ++hd) { const float dv = g == 0 ? dacc[hd] : (g == 1 ? dacc[4 + hd] : (g == 2 ? dacc[8 + hd] : dacc[12 + hd])); s = fmaf(wq[hd], fmaxf(dv, 0.f), s); }
        if (half == (w & 1) && c < En) bsc[c] = s;
    }
    LDS_WAIT();
    {
        const bool v0 = lane < En, v1 = lane + 64 < En;
        unsigned k0 = 0u, k1 = 0u; int i0 = 0, i1 = 0;
        { const int e0 = v0 ? lane : 0, e1 = v1 ? lane + 64 : 0;
          unsigned u0 = __builtin_bit_cast(unsigned, bsc[e0]), u1 = __builtin_bit_cast(unsigned, bsc[e1]); i0 = (int)bidx[e0]; i1 = (int)bidx[e1];
          u0 ^= (unsigned)((int)u0 >> 31) | 0x80000000u; u1 ^= (unsigned)((int)u1 >> 31) | 0x80000000u; k0 = u0; k1 = u1; }
        unsigned prefix = 0u; int remaining = need_eq;
#pragma unroll 4
        for (int bit = 31; bit >= 0; --bit) {
            const unsigned test = prefix | (1u << bit), hm = ~((1u << bit) - 1u);
            const int c = __popcll(__ballot(v0 && (k0 & hm) == test)) + __popcll(__ballot(v1 && (k1 & hm) == test));
            if (c >= remaining) prefix = test; else remaining -= c;
        }
        const bool t0 = v0 && k0 == prefix, t1 = v1 && k1 == prefix;
        bool take0 = v0 && k0 > prefix, take1 = v1 && k1 > prefix;
        const unsigned long long tm0 = __ballot(t0), tm1 = __ballot(t1);
        if (__popcll(tm0) + __popcll(tm1) == remaining) { take0 = take0 || t0; take1 = take1 || t1; }
        else {
            int r0 = 0, r1 = 0;
            for (unsigned long long m = tm0; m; m &= m - 1ull) { const int ib = __builtin_amdgcn_readlane(i0, (int)__builtin_ctzll(m)); r0 += (ib < i0) ? 1 : 0; r1 += (ib < i1) ? 1 : 0; }
            for (unsigned long long m = tm1; m; m &= m - 1ull) { const int ib = __builtin_amdgcn_readlane(i1, (int)__builtin_ctzll(m)); r0 += (ib < i0) ? 1 : 0; r1 += (ib < i1) ? 1 : 0; }
            take0 = take0 || (t0 && r0 < remaining); take1 = take1 || (t1 && r1 < remaining);
        }
        const unsigned long long w0 = __ballot(take0);
        if (take0) sel[nsel + __popcll(w0 & lt_mask)] = (u16)i0;
        nsel += __popcll(w0);
        const unsigned long long w1 = __ballot(take1);
        if (take1) sel[nsel + __popcll(w1 & lt_mask)] = (u16)i1;
        nsel += __popcll(w1);
    }
    return nsel;
}
__device__ __forceinline__ void dsa_select_slow(LAS unsigned char* lds, int w, const LAS u16* myk, LAS unsigned* hist, LAS u16* sel, LAS u16* bidx, LAS float* bsc, const u16* IKb, f32x4 wq, int npad, int lane, unsigned long long lt_mask) {
    const LAS unsigned* k2 = (const LAS unsigned*)myk;
    for (int i = lane; i < npad / 2; i += 64) { const unsigned kk = k2[i]; __hip_atomic_fetch_add(hist + ((kk >> 8) & 0xffu), 1u, __ATOMIC_RELAXED, __HIP_MEMORY_SCOPE_WORKGROUP); __hip_atomic_fetch_add(hist + (kk >> 24), 1u, __ATOMIC_RELAXED, __HIP_MEMORY_SCOPE_WORKGROUP); }
    LDS_WAIT();
    unsigned B1, above1, c1; find_bin(hist, DSA_TOPK, lane, B1, above1, c1);
    LDS_WAIT();
    *(LAS v4u*)(hist + 4 * lane) = (v4u){0u, 0u, 0u, 0u};
    LDS_WAIT();
    for (int i = lane; i < npad / 2; i += 64) { const unsigned kk = k2[i];
        if (((kk >> 8) & 0xffu) == B1) __hip_atomic_fetch_add(hist + (kk & 0xffu), 1u, __ATOMIC_RELAXED, __HIP_MEMORY_SCOPE_WORKGROUP);
        if ((kk >> 24) == B1) __hip_atomic_fetch_add(hist + ((kk >> 16) & 0xffu), 1u, __ATOMIC_RELAXED, __HIP_MEMORY_SCOPE_WORKGROUP); }
    LDS_WAIT();
    unsigned B2, above2, E; find_bin(hist, DSA_TOPK - above1, lane, B2, above2, E);
    const unsigned bstar = (B1 << 8) | B2; const int need = DSA_TOPK - (int)(above1 + above2);
    const bool index_mode = ((int)E == need) || (E > (unsigned)DSA_BCAP) || (bstar == 0x8000u);
    int nsel = 0, neq = 0;
    for (int c0 = 0; c0 < npad; c0 += 64) {
        const int j = c0 + lane; const unsigned kk = (j < npad) ? myk[j] : 0u;
        const bool gt = kk > bstar, eq = (kk == bstar);
        const unsigned long long em = __ballot(eq);
        const int epos = neq + __popcll(em & lt_mask);
        const bool take = gt || (index_mode && eq && epos < need);
        const unsigned long long tm = __ballot(take);
        if (take) sel[nsel + __popcll(tm & lt_mask)] = (u16)j;
        if (!index_mode && eq) bidx[epos] = (u16)j;
        nsel += __popcll(tm); neq += __popcll(em);
    }
    if (!index_mode) { LDS_WAIT(); dsa_rescore_select(lds, IKb, wq, bidx, bsc, sel, nsel, (int)E, need, lane, w, lt_mask, 7); }
}

template <int DP = 7> __device__ __forceinline__ void dsa_unit(Frame& F, int b, int t0, int& nb, int& nt0, int grp, int ngrp, v2u& iqn, float& iwn, int dpr = 7) {
    const int dpe = DP & dpr;
    LAS u16* KEYS = (LAS u16*)(F.lds + DSA_KEYS);
    int lane_ = F.lane; asm volatile("" : "+v"(lane_));
    const int lane = lane_, w = F.wave, r32 = lane & 31, half = lane >> 5;
    const long rowbase = (long)b * SEQ;
    const u16* IQ = (const u16*)(F_WS + WS_IQ); const u16* IKb = (const u16*)(F_WS + WS_IK) + rowbase * 64; const float* IW = (const float*)(F_WS + WS_IW);
    const bf16* KAVAb = (const bf16*)(F_WS + WS_KAVA) + rowbase * 128; bf16* AQ = (bf16*)(F_WS + WS_AQ);
    const int nkeys = t0 + 8, ntiles = (nkeys + 31) >> 5, npad = ntiles * 32;
    LAS unsigned* HISTALL = (LAS unsigned*)(F.lds + DSA_HIST);
    __syncthreads();
    { const int nk = *(const LAS int*)(F.lds + DSA_NXT); const int per = (T / 8) / ngrp;
      if (nk >= per) { nb = 0; nt0 = -1; } else if (ngrp == 4) { nb = grp; nt0 = 8 * (per - 1 - nk); } else { nb = nk & 3; nt0 = 8 * ((T / 32) - 1 - (nk >> 2)); } }
    { LAS u16* IQLw = (LAS u16*)(F.lds + DSA_IQ); *(LAS v2u*)(IQLw + 4 * F.tid) = iqn; if (F.tid < 32) ((LAS float*)(F.lds + DSA_IWL))[F.tid] = iwn; }
#define DSA_PREFETCH_NEXT() do { if (nt0 >= 0) { iqn = *(const v2u*)(IQ + ((long)nb * SEQ + nt0) * 256 + 4 * F.tid); if (F.tid < 32) iwn = IW[((long)nb * SEQ + nt0) * 4 + F.tid]; } } while (0)
    float minv, mc0;
    {
        float binv[4], bc0[4];
        f16x8 bt0[4];
        f16x8 b0[4], b1[4], b2[4];
#define DSA_LDT(dst, ktile) do { const int kb_ = min((ktile), ntiles - 1) * 32 + r32; _Pragma("unroll") for (int ks = 0; ks < 4; ++ks) dst[ks] = *(const f16x8*)(IKb + ik_off(kb_, 2 * ks + half)); } while (0)
#define DSA_PIN() asm volatile("" ::: "memory")
#pragma unroll
        for (int ks = 0; ks < 4; ++ks) bt0[ks] = *(const f16x8*)(IKb + ik_off(r32, 2 * ks + half));
        DSA_PIN(); DSA_LDT(b0, w); DSA_PIN(); DSA_LDT(b1, w + NWAVES); DSA_PIN(); DSA_LDT(b2, w + 2 * NWAVES); DSA_PIN();
        __syncthreads();
        f16x8 aop[4];
        { const int q = r32 >> 2, hd = r32 & 3; const LAS u16* pl = (const LAS u16*)(F.lds + DSA_IQ) + q * 256 + hd * 64 + 8 * half;
#pragma unroll
          for (int ks = 0; ks < 4; ++ks) aop[ks] = *(const LAS f16x8*)(pl + 16 * ks); }
        f32x4 wv[4];
#pragma unroll
        for (int g = 0; g < 4; ++g) wv[g] = *(const LAS f32x4*)((const LAS float*)(F.lds + DSA_IWL) + (2 * g + half) * 4);
        float finf = INFINITY; asm volatile("" : "+s"(finf));
        {
            f32x16 dacc = {};
#pragma unroll
            for (int ks = 0; ks < 4; ++ks) dacc = __builtin_amdgcn_mfma_f32_32x32x16_f16(aop[ks], bt0[ks], dacc, 0, 0, 0);
#pragma unroll
            for (int g = 0; g < 4; ++g) {
                float s = 0.f;
#pragma unroll
                for (int hd = 0; hd < 4; ++hd) s = fmaf(wv[g][hd], fmaxf(dacc[4 * g + hd], 0.f), s);
                float m = row_sum(s); m += xor_f<16>(m); m *= (1.0f / 32.0f);
                float v = row_sum((s - m) * (s - m)); v += xor_f<16>(v);
                const float sg = sqrtf(v * (1.0f / 32.0f));
                const bool okf = (sg > 1e-20f) && (sg < 1e20f);
                binv[g] = okf ? 25.6f / sg : 0.f; bc0[g] = okf ? -(m - 1.5f * sg) * binv[g] : 0.f;
            }
        }
        { const int g = w >> 1; const float a = g == 0 ? binv[0] : (g == 1 ? binv[1] : (g == 2 ? binv[2] : binv[3])), c = g == 0 ? bc0[0] : (g == 1 ? bc0[1] : (g == 2 ? bc0[2] : bc0[3]));
          minv = __builtin_bit_cast(float, __builtin_amdgcn_readlane(__builtin_bit_cast(int, a), (w & 1) * 32)); mc0 = __builtin_bit_cast(float, __builtin_amdgcn_readlane(__builtin_bit_cast(int, c), (w & 1) * 32)); }
#define DSA_SCORE(g_) (fmaf(wv[g_][3], __builtin_amdgcn_fmed3f(dacc[4 * (g_) + 3], 0.f, finf), fmaf(wv[g_][2], __builtin_amdgcn_fmed3f(dacc[4 * (g_) + 2], 0.f, finf), \
            fmaf(wv[g_][1], __builtin_amdgcn_fmed3f(dacc[4 * (g_) + 1], 0.f, finf), fmaf(wv[g_][0], __builtin_amdgcn_fmed3f(dacc[4 * (g_)], 0.f, finf), 0.f)))))
#define DSA_PROC(bb, ktile) do { const int key = (ktile) * 32 + r32; \
            f32x16 dacc = {}; \
            _Pragma("unroll") for (int ks = 0; ks < 4; ++ks) dacc = __builtin_amdgcn_mfma_f32_32x32x16_f16(aop[ks], bb[ks], dacc, 0, 0, 0); \
            if ((ktile) * 32 + 31 <= t0) {                         \
                _Pragma("unroll") for (int g = 0; g < 4; ++g) { \
                    const float s = DSA_SCORE(g); const int q = 2 * g + half; const unsigned k16 = sortable16(s); \
                    if (!(dpe & 128)) KEYS[q * 8192 + key] = (u16)k16; \
                    if (!(dpe & 64)) { const float sT = (float)(_Float16)s;                         \
                          \
                        LAS unsigned* cnt = (k16 == 0x8000u) ? ((LAS unsigned*)(F.lds + DSA_ZC) + q) : (HISTALL + q * 256 + lin_bin(sT, binv[g], bc0[g])); \
                        __hip_atomic_fetch_add(cnt, 1u, __ATOMIC_RELAXED, __HIP_MEMORY_SCOPE_WORKGROUP); } \
                } \
            } else { \
                _Pragma("unroll") for (int g = 0; g < 4; ++g) { \
                    const float s = DSA_SCORE(g); const int q = 2 * g + half; \
                    const bool valid = key <= t0 + q; \
                    const unsigned k16 = valid ? sortable16(s) : 0u; \
                    if (!(dpe & 128)) KEYS[q * 8192 + key] = (u16)k16; \
                    if (!(dpe & 64)) if (valid) { const float sT = (float)(_Float16)s;                         \
                        LAS unsigned* cnt = (k16 == 0x8000u) ? ((LAS unsigned*)(F.lds + DSA_ZC) + q) : (HISTALL + q * 256 + lin_bin(sT, binv[g], bc0[g])); \
                        __hip_atomic_fetch_add(cnt, 1u, __ATOMIC_RELAXED, __HIP_MEMORY_SCOPE_WORKGROUP); } \
                } \
            } } while (0)
        for (int kt = (dpe & 256) ? ntiles : w; kt < ntiles; kt += 3 * NWAVES) {
            DSA_PROC(b0, kt);
            DSA_PIN(); DSA_LDT(b0, kt + 3 * NWAVES); DSA_PIN();
            if (kt + NWAVES < ntiles) DSA_PROC(b1, kt + NWAVES);
            DSA_PIN(); DSA_LDT(b1, kt + 4 * NWAVES); DSA_PIN();
            if (kt + 2 * NWAVES < ntiles) DSA_PROC(b2, kt + 2 * NWAVES);
            DSA_PIN(); DSA_LDT(b2, kt + 5 * NWAVES); DSA_PIN();
        }
#undef DSA_PROC
#undef DSA_SCORE
#undef DSA_LDT
#undef DSA_PIN
    }
#ifdef TP_DSA_RT
    DSA_PREFETCH_NEXT();
#endif
    __syncthreads();
    if (!(dpe & 2)) { *(LAS v4u*)(HISTALL + F.wave * 256 + 4 * lane) = (v4u){0u, 0u, 0u, 0u}; if (lane == 0) ((LAS unsigned*)(F.lds + DSA_ZC))[F.wave] = 0u; return; }
    const int t = t0 + w, n = t + 1;
    LAS u16* myk = KEYS + w * 8192; LAS unsigned* hist = HISTALL + w * 256; LAS u16* sel = (LAS u16*)(F.lds + DSA_SEL) + w * 256;
    LAS u16* bidx = (LAS u16*)(F.lds + DSA_BIDX) + w * DSA_BCAP; LAS float* bsc = (LAS float*)(F.lds + DSA_BSC) + w * DSA_BCAP;
    const LAS u16* IQL = (const LAS u16*)(F.lds + DSA_IQ) + w * 256;
    const unsigned long long lt_mask = (1ull << lane) - 1ull;
    int count;
    if (n <= DSA_TOPK) {
        count = n;
        for (int j = lane; j < DSA_TOPK; j += 64) sel[j] = (u16)(j < n ? j : 0);
        *(LAS v4u*)(hist + 4 * lane) = (v4u){0u, 0u, 0u, 0u};
        if (lane == 0) ((LAS unsigned*)(F.lds + DSA_ZC))[w] = 0u;
    } else {
        count = DSA_TOPK;
        const f32x4 wq = *(const LAS f32x4*)((const LAS float*)(F.lds + DSA_IWL) + w * 4);
        typedef unsigned short us2 __attribute__((ext_vector_type(2)));
        const LAS v4u* k8 = (const LAS v4u*)myk;
        LAS unsigned* ZC = (LAS unsigned*)(F.lds + DSA_ZC);
        const int Z = (int)ZC[w]; const int bz = lin_bin(0.f, minv, mc0);
        if (lane == (bz >> 2)) hist[bz] += (unsigned)Z;
        LDS_WAIT();
        if (lane == 0) ZC[w] = 0u;
        unsigned B, above, E; find_bin(hist, DSA_TOPK, lane, B, above, E);
        LDS_WAIT();
        *(LAS v4u*)(hist + 4 * lane) = (v4u){0u, 0u, 0u, 0u};
        LDS_WAIT();
        const int need = DSA_TOPK - (int)above;
        if (dpe & 16) return;
        const int nch = (npad + 511) >> 9;
        auto count_ge = [&](unsigned thr) -> int {
            const unsigned t1 = thr - 1u, t2 = t1 | (t1 << 16); unsigned one2 = 0x00010001u; asm volatile("" : "+v"(one2)); unsigned acc = 0u;
            for (int ch = 0; ch < nch; ch += 2) {
                v4u kv[2];
#pragma unroll
                for (int u2 = 0; u2 < 2; ++u2) kv[u2] = k8[min(ch + u2, nch - 1) * 64 + lane];
#pragma unroll
                for (int u2 = 0; u2 < 2; ++u2) {
                    const bool live = (ch + u2 < nch) && ((ch + u2) * 512 + 8 * lane < npad);
                    unsigned c4 = pk_gt_flags(kv[u2].x, t2, one2);
                    c4 = pk_add16(c4, pk_gt_flags(kv[u2].y, t2, one2)); c4 = pk_add16(c4, pk_gt_flags(kv[u2].z, t2, one2)); c4 = pk_add16(c4, pk_gt_flags(kv[u2].w, t2, one2));
                    acc = pk_add16(acc, live ? c4 : 0u); }
            }
            return (int)(acc & 0xffffu) + (int)(acc >> 16); };
        bool done = false;
        if (minv > 0.f) {
            unsigned kLo, kHi;
            {
                auto first_ge = [&](int tb) -> unsigned {
                    const float bnd = ((float)tb - mc0) / minv; unsigned k = sortable16(bnd); k = k < 0x0404u ? 0x0404u : (k > 0xfbfbu ? 0xfbfbu : k);
                    unsigned r = 0u;
#pragma unroll
                    for (int d = 4; d >= -3; --d) { const unsigned kk = k + (unsigned)d; if (lin_bin(key_float(kk), minv, mc0) >= tb) r = kk; }
                    const bool okw = (r != 0u) && (lin_bin(key_float(r), minv, mc0) >= tb) && (lin_bin(key_float(r - 1u), minv, mc0) < tb) && (r > 0x0400u);
                    if (okw) return r;
                    unsigned lo = 0x0400u, hi = 0xfc00u;
                    while (lo < hi) { const unsigned mid = (lo + hi) >> 1; if (lin_bin(key_float(mid), minv, mc0) >= tb) hi = mid; else lo = mid + 1; }
                    return lo; };
                kLo = first_ge((int)B);
                kHi = (B == 255u) ? 0xffffu : first_ge((int)B + 1) - 1u;
            }
            unsigned cLo = kLo, cHi = kHi; int need_eq = need, extra_zero = 0; bool ok = (E <= (unsigned)DSA_BCAP);
            if ((int)B == bz && Z > 0) {
                const int mine = count_ge(0x8001u); const int P = (int)wave_sum((float)mine) - (int)above;
                if (need <= P) { cLo = 0x8001u; ok = (P <= DSA_BCAP); }
                else if (need <= P + Z) { cLo = 0x8001u; cHi = 0x8000u; need_eq = 0; extra_zero = need - P; ok = true; }
                else { cHi = 0x7fffu; need_eq = need - P - Z; ok = ((int)E - P - Z <= DSA_BCAP) && ((int)above + (int)E <= 512); }
            }
            if (ok) {
                done = true;
                const unsigned lo1 = cLo - 1u, tl2 = lo1 | (lo1 << 16);
                LAS u16* cand = (LAS u16*)hist;
                const int mycnt = count_ge(cLo);
                const int pre = wave_prefix_incl(mycnt, lane);
                const int C = min(__builtin_amdgcn_readlane(pre, 63), 512);
                int pos = pre - mycnt;
                unsigned one2 = 0x00010001u; asm volatile("" : "+v"(one2));
                for (int ch = 0; ch < nch; ch += 2) {
                    v4u kv[2];
#pragma unroll
                    for (int u2 = 0; u2 < 2; ++u2) kv[u2] = k8[min(ch + u2, nch - 1) * 64 + lane];
#pragma unroll
                    for (int u2 = 0; u2 < 2; ++u2) {
                        const int j0 = (ch + u2) * 512 + 8 * lane;
                        const bool live = (ch + u2 < nch) && (j0 < npad);
                        unsigned m = 0u;
#pragma unroll
                        for (int d = 0; d < 4; ++d) { const unsigned wd = d == 0 ? kv[u2].x : (d == 1 ? kv[u2].y : (d == 2 ? kv[u2].z : kv[u2].w));
                            m |= pk_gt_flags(wd, tl2, one2) << d; }
                        if (!live) m = 0u;
                        while (m) { const int x = __builtin_ctz(m); m &= m - 1u; if (pos < 512) cand[pos] = (u16)(j0 + 2 * (x & 15) + (x >> 4)); ++pos; }
                    }
                }
                LDS_WAIT();
                if (dpe & 32) { *(LAS v4u*)(hist + 4 * lane) = (v4u){0u, 0u, 0u, 0u}; return; }
                int nsel = 0, neq = 0;
                {
                    int idx5[5]; unsigned kk5[5];
#pragma unroll
                    for (int r = 0; r < 5; ++r) { const int e = lane + 64 * r; const int v = (int)cand[e]; idx5[r] = (e < C) ? v : 0; }
#pragma unroll
                    for (int r = 0; r < 5; ++r) kk5[r] = (unsigned)myk[idx5[r]];
#pragma unroll
                    for (int r = 0; r < 5; ++r) {
                        const int e = lane + 64 * r; const bool in = e < C; const int idx = idx5[r]; const unsigned kk = in ? kk5[r] : 0u;
                        const bool gt = in && kk > cHi, eq = in && !gt;
                        const unsigned long long tm = __ballot(gt), em = __ballot(eq);
                        if (gt) sel[nsel + __popcll(tm & lt_mask)] = (u16)idx;
                        if (eq) { const int ep = neq + __popcll(em & lt_mask); if (ep < DSA_BCAP) bidx[ep] = (u16)idx; }
                        nsel += __popcll(tm); neq += __popcll(em);
                    }
                }
                for (int r = 5; r * 64 < C; ++r) {
                    const int e = lane + 64 * r; const bool in = e < C; const int idx = in ? (int)cand[e] : 0; const unsigned kk = in ? (unsigned)myk[idx] : 0u;
                    const bool gt = in && kk > cHi, eq = in && !gt;
                    const unsigned long long tm = __ballot(gt), em = __ballot(eq);
                    if (gt) sel[nsel + __popcll(tm & lt_mask)] = (u16)idx;
                    if (eq) { const int ep = neq + __popcll(em & lt_mask); if (ep < DSA_BCAP) bidx[ep] = (u16)idx; }
                    nsel += __popcll(tm); neq += __popcll(em);
                }
                LDS_WAIT();
                *(LAS v4u*)(hist + 4 * lane) = (v4u){0u, 0u, 0u, 0u};
                if (neq == need_eq) { for (int e = lane; e < neq; e += 64) sel[nsel + e] = bidx[e]; nsel += neq; }
                else if (need_eq > 0) {
                    nsel = dsa_rescore_select(F.lds, IKb, wq, bidx, bsc, sel, nsel, min(neq, DSA_BCAP), need_eq, lane, w, lt_mask, dpe);
                }
                if (extra_zero > 0) {
                    int base = 0;
                    for (int c0 = 0; c0 < npad && base < extra_zero; c0 += 512) {
                        const int j0 = c0 + 8 * lane; v4u kv = (v4u){0u, 0u, 0u, 0u}; if (j0 < npad) kv = k8[j0 >> 3];
                        unsigned m8 = 0u;
#pragma unroll
                        for (int x = 0; x < 8; ++x) { const unsigned wd = x < 2 ? kv.x : (x < 4 ? kv.y : (x < 6 ? kv.z : kv.w)); const unsigned kk = (x & 1) ? (wd >> 16) : (wd & 0xffffu); m8 |= (kk == 0x8000u ? 1u : 0u) << x; }
                        const int c = __builtin_popcount(m8);
                        int ex = 0;
#pragma unroll
                        for (int bit = 0; bit < 4; ++bit) ex += __popcll(__ballot((c >> bit) & 1) & lt_mask) << bit;
                        int tot = 0;
#pragma unroll
                        for (int bit = 0; bit < 4; ++bit) tot += __popcll(__ballot((c >> bit) & 1)) << bit;
                        int rk = base + ex;
#pragma unroll
                        for (int x = 0; x < 8; ++x) if ((m8 >> x) & 1u) { if (rk < extra_zero) sel[nsel + rk] = (u16)(j0 + x); ++rk; }
                        base += tot;
                    }
                    nsel += extra_zero;
                }
            }
        }
        if (!done) {
            dsa_select_slow(F.lds, w, myk, hist, sel, bidx, bsc, IKb, wq, npad, lane, lt_mask);
            LDS_WAIT();
            *(LAS v4u*)(hist + 4 * lane) = (v4u){0u, 0u, 0u, 0u};
        }
    }
    LDS_WAIT();
    if (!(dpe & 4)) return;
    {
        LAS float* PF = (LAS float*)myk;
        LAS u16* PB = (LAS u16*)(PF + 1024);
        LAS unsigned char* VS = (LAS unsigned char*)(PB + 1024);
        const int l16 = lane & 15, qt = lane >> 4, r8 = lane >> 3;
        const bf16* gb = KAVAb + 8 * (lane & 7);
        LAS unsigned char* stw = VS + r8 * DSA_VROW + 16 * (lane & 7);
        v4u kk[32];
#pragma unroll
        for (int i = 0; i < 32; ++i) { const int idx = (int)sel[r8 + 8 * i]; kk[i] = *(const v4u*)(gb + (long)idx * 128); }
        v4u vq[4][8];
#pragma unroll
        for (int i = 0; i < 8; ++i) { const int idx = (int)sel[r8 + 8 * i]; vq[0][i] = *(const v4u*)(gb + (long)idx * 128 + 64); }
        bf16x8 aq[2];
#pragma unroll
        for (int ks = 0; ks < 2; ++ks) { v4u z = (v4u){0u, 0u, 0u, 0u}; if (l16 < 4) z = *(const v4u*)(AQ + (rowbase + t) * 256 + l16 * 64 + 32 * ks + 8 * qt); aq[ks] = __builtin_bit_cast(bf16x8, z); }
#pragma unroll
        for (int c = 0; c < 4; ++c) {
#pragma unroll
            for (int i = 0; i < 8; ++i) *(LAS v4u*)(stw + 8 * i * DSA_VROW) = kk[8 * c + i];
#pragma unroll
            for (int t4 = 0; t4 < 4; ++t4) {
                const LAS unsigned char* rp = VS + (16 * t4 + l16) * DSA_VROW + 16 * qt;
                const bf16x8 kA = *(const LAS bf16x8*)rp, kB = *(const LAS bf16x8*)(rp + 64);
                f32x4 acc = {0.f, 0.f, 0.f, 0.f};
                acc = __builtin_amdgcn_mfma_f32_16x16x32_bf16(aq[0], kA, acc, 0, 0, 0);
                acc = __builtin_amdgcn_mfma_f32_16x16x32_bf16(aq[1], kB, acc, 0, 0, 0);
                const int j = 64 * c + 16 * t4 + l16;
                if (qt == 0) *(LAS f32x4*)(PF + j * 4) = (j < count) ? acc * SM_C : (f32x4){-1e30f, -1e30f, -1e30f, -1e30f};
            }
        }
#ifndef TP_DSA_RT
        DSA_PREFETCH_NEXT();
#endif
#pragma unroll
        for (int c = 1; c < 4; ++c)
#pragma unroll
            for (int i = 0; i < 8; ++i) { const int idx = (int)sel[64 * c + r8 + 8 * i]; vq[c][i] = *(const v4u*)(gb + (long)idx * 128 + 64); }
        LDS_WAIT();
        {
            f32x4 z4[4];
#pragma unroll
            for (int jj = 0; jj < 4; ++jj) z4[jj] = *(const LAS f32x4*)(PF + (lane + 64 * jj) * 4);
#pragma unroll
            for (int hd = 0; hd < 4; ++hd) {
                const float m = wave_max(fmaxf(fmaxf(z4[0][hd], z4[1][hd]), fmaxf(z4[2][hd], z4[3][hd])));
                float s = 0.f;
#pragma unroll
                for (int jj = 0; jj < 4; ++jj) { const float p = (lane + 64 * jj < count) ? __builtin_amdgcn_exp2f(z4[jj][hd] - m) : 0.f; z4[jj][hd] = p; s += p; }
                const float inv = 1.0f / wave_sum(s);
#pragma unroll
                for (int jj = 0; jj < 4; ++jj) PB[hd * 256 + lane + 64 * jj] = (u16)f2bf(z4[jj][hd] * inv);
            }
        }
        LDS_WAIT();
        f32x4 o[4];
#pragma unroll
        for (int nt = 0; nt < 4; ++nt) o[nt] = (f32x4){0.f, 0.f, 0.f, 0.f};
        const unsigned VSa = (unsigned)(uintptr_t)VS;
#pragma unroll
        for (int c = 0; c < 4; ++c) {
#pragma unroll
            for (int i = 0; i < 8; ++i) *(LAS v4u*)(stw + 8 * i * DSA_VROW) = vq[c][i];
            LDS_WAIT();
#pragma unroll
            for (int kk2 = 0; kk2 < 2; ++kk2) {
                v4u pz = (v4u){0u, 0u, 0u, 0u}; if (l16 < 4) pz = *(const LAS v4u*)(PB + l16 * 256 + 64 * c + 32 * kk2 + 8 * qt);
                const bf16x8 pf = __builtin_bit_cast(bf16x8, pz);
#pragma unroll
                for (int nt = 0; nt < 4; ++nt) {
                    const unsigned a0 = VSa + (32 * kk2 + 8 * qt + (l16 >> 2)) * DSA_VROW + (16 * nt + 4 * (l16 & 3)) * 2;
                    s16x4 lo = tr_read(a0), hi = tr_read(a0 + 4 * DSA_VROW);
                    asm volatile("s_waitcnt lgkmcnt(0)" : "+v"(lo), "+v"(hi) :: "memory");
                    const bf16x8 vf = (bf16x8){lo[0], lo[1], lo[2], lo[3], hi[0], hi[1], hi[2], hi[3]};
                    o[nt] = __builtin_amdgcn_mfma_f32_16x16x32_bf16(pf, vf, o[nt], 0, 0, 0);
                }
            }
            LDS_WAIT();
        }
        if (qt == 0 && !(dpe & 512)) { bf16* orow = AQ + (rowbase + t) * 256 + l16;
#pragma unroll
            for (int hd = 0; hd < 4; ++hd)
#pragma unroll
                for (int nt = 0; nt < 4; ++nt) orow[hd * 64 + 16 * nt] = (bf16)f2bf(o[nt][hd]); }
    }
#undef DSA_PREFETCH_NEXT
}

template <int PART = 7, int DSAP = 7> __device__ __forceinline__ void phase_attention(Frame& F, int l) {
    if (PART & 2) for (int L = F.vcu; L < 256; L += F.G) { const int b = L >> 6, h = (L >> 4) & 3, p = L & 15; moba_unit2(F, b, h, p); moba_unit2(F, b, h, 31 - p); }
    if (PART & 4) for (int L = F.vcu; L < 512; L += F.G) swa_unit(F, l, L >> 7, (L >> 6) & 1, L & 63);
    if (PART & 1) { __syncthreads(); for (int i = F.tid; i < 2048; i += NTHR) ((LAS unsigned*)(F.lds + DSA_HIST))[i] = 0u; if (F.tid < 8) ((LAS unsigned*)(F.lds + DSA_ZC))[F.tid] = 0u; }
#ifdef TP_DSA_RT
    int npass = 2; asm volatile("" : "+s"(npass));
    for (int pass = 0; pass < npass; ++pass) { int dpr = (pass + 1 < npass) ? (TP_DSA_RT) : 7; asm volatile("" : "+s"(dpr));
#else
    { constexpr int dpr = 7;
#endif
    if (PART & 1) {
        const int ngrp = (F.G == 256) ? 4 : 1, grp = (F.G == 256) ? (F.vcu >> 6) : 0, per = (T / 8) / ngrp;
#ifdef TP_DSA_RT
        gu32* qc = (gu32*)(F_WS + WS_CTL) + CW_DSAQ + 64 * l + 16 * pass + grp;
#else
        gu32* qc = (gu32*)(F_WS + WS_CTL) + CW_DSAQ + 64 * l + grp;
#endif
        LAS int* NXT = (LAS int*)(F.lds + DSA_NXT);
        int pend = 0;
        if (F.tid == 0) { NXT[0] = (int)__hip_atomic_fetch_add(qc, 1u, RLX_AGENT); pend = (int)__hip_atomic_fetch_add(qc, 1u, RLX_AGENT); }
        __syncthreads();
        int b, t0;
        { const int k0 = NXT[0]; if (k0 >= per) { b = 0; t0 = -1; } else if (ngrp == 4) { b = grp; t0 = 8 * (per - 1 - k0); } else { b = k0 & 3; t0 = 8 * ((T / 32) - 1 - (k0 >> 2)); } }
        __syncthreads();
        v2u iqn = (v2u){0u, 0u}; float iwn = 0.f;
        if (t0 >= 0) { const u16* IQ = (const u16*)(F_WS + WS_IQ); const float* IW = (const float*)(F_WS + WS_IW);
            iqn = *(const v2u*)(IQ + ((long)b * SEQ + t0) * 256 + 4 * F.tid); if (F.tid < 32) iwn = IW[((long)b * SEQ + t0) * 4 + F.tid]; }
        while (t0 >= 0) { int nb = 0, nt0 = -1;
            if (F.tid == 0) { NXT[0] = pend; pend = (int)__hip_atomic_fetch_add(qc, 1u, RLX_AGENT); }
#ifdef TP_DSA_RT
            dsa_unit<0x7fffffff>(F, b, t0, nb, nt0, grp, ngrp, iqn, iwn, dpr);
#else
            dsa_unit<DSAP>(F, b, t0, nb, nt0, grp, ngrp, iqn, iwn, dpr);
#endif
            b = nb; t0 = nt0; }
    }
    }
    __syncthreads();
}

struct SchedBranch {
    unsigned char* ws; const char* Bw; int G, vcu;
    __device__ __forceinline__ bool next(int i, pg8::Unit& u) const {
        const int tau = (i / 3) * G + vcu, br = i % 3; if (tau >= 512) return false;
        const int pm = tau >> 2, pn = tau & 3;
        const size_t aoff = br == 0 ? WS_AQ : (br == 1 ? WS_BQ : WS_CQ); const int lda = br == 2 ? 512 : 256; const int kb = br == 0 ? 0 : (br == 1 ? 256 : 512);
        u.A = (const char*)(ws + aoff) + (size_t)pm * 256 * lda * 2; u.B = Bw + (size_t)pn * 256 * 1024 * 2 + kb * 2; u.rowlist = nullptr; u.nvalid = 256; u.lda = lda; u.nt = lda / 64;
        u.ksplit = 1 << 30; u.bdelta = 0; u.p0 = pm; u.p1 = pn; u.p2 = br; u.p3 = 0; return true;
    }
};
struct EpiBranch {
    static constexpr bool PERM = true;
    static __device__ __forceinline__ bool keep_acc(const pg8::Unit& u) { return u.p2 < 2; }
    unsigned char* ws;
    __device__ __forceinline__ void operator()(f32x4 (&acc)[2][2][4][2], const pg8::Unit& u, int wr, int wc, int fr, int fq) const {
        const int pm = u.p0, pn = u.p1, br = u.p2;
        bf16* MG = (bf16*)(ws + WS_MERGED);
        const int row0 = pm * 256 + wr * 64 + fr, col0 = pn * 256 + wc * 32 + 8 * fq;
        const unsigned char* GATES8 = (const unsigned char*)(ws + WS_GATES);
        const unsigned char* gp = GATES8 + (size_t)row0 * 3072 + br * 1024 + col0;
#define GQ(vv_, ee_) ((float)(((ee_) < 4 ? (vv_)[0] >> (8 * ((ee_) & 3)) : (vv_)[1] >> (8 * ((ee_) & 3))) & 0xffu))
        if (br < 2) {
#pragma unroll
            for (int ai = 0; ai < 2; ++ai) {
                v2u g[4][2], gn[4][2];
#pragma unroll
                for (int m = 0; m < 4; ++m)
#pragma unroll
                    for (int bj = 0; bj < 2; ++bj) { const unsigned char* q = gp + (size_t)(ai * 128 + m * 16) * 3072 + bj * 128; g[m][bj] = *(const v2u*)q; gn[m][bj] = *(const v2u*)(q + 1024); }
#pragma unroll
                for (int m = 0; m < 4; ++m)
#pragma unroll
                    for (int bj = 0; bj < 2; ++bj) {
                        const v2u a = g[m][bj], d = gn[m][bj];
#pragma unroll
                        for (int e = 0; e < 4; ++e) { acc[ai][bj][m][0][e] *= GQ(a, e) * __builtin_amdgcn_rcpf(GQ(d, e)); acc[ai][bj][m][1][e] *= GQ(a, 4 + e) * __builtin_amdgcn_rcpf(GQ(d, 4 + e)); }
                    }
            }
        } else {
#pragma unroll
            for (int ai = 0; ai < 2; ++ai) {
                v2u g[4][2];
#pragma unroll
                for (int m = 0; m < 4; ++m)
#pragma unroll
                    for (int bj = 0; bj < 2; ++bj) g[m][bj] = *(const v2u*)(gp + (size_t)(ai * 128 + m * 16) * 3072 + bj * 128);
#pragma unroll
                for (int m = 0; m < 4; ++m)
#pragma unroll
                    for (int bj = 0; bj < 2; ++bj) {
                        const v2u a = g[m][bj];
                        f32x4 x0 = acc[ai][bj][m][0], x1 = acc[ai][bj][m][1];
#pragma unroll
                        for (int e = 0; e < 4; ++e) { x0[e] *= GQ(a, e) * (1.0f / 255.0f); x1[e] *= GQ(a, 4 + e) * (1.0f / 255.0f); }
                        v4u w; w.x = cvt_pk_bf16(x0[0], x0[1]); w.y = cvt_pk_bf16(x0[2], x0[3]); w.z = cvt_pk_bf16(x1[0], x1[1]); w.w = cvt_pk_bf16(x1[2], x1[3]);
                        *(v4u*)(MG + (size_t)(row0 + ai * 128 + m * 16) * 1024 + col0 + bj * 128) = w;
                    }
            }
        }
#undef GQ
    }
};
__device__ __forceinline__ void phase_branch(Frame& F, int l) {
    SchedBranch S{F_WS, (const char*)(F_WS + WS_WBR) + (size_t)l * 1024 * 1024 * 2, F.G, F.vcu};
    EpiBranch E{F_WS};
    pg8::gemm_phase<EpiBranch, SchedBranch, true>(F.lds, F.tid, 1024, S, E);
}

struct EpiY {
    static constexpr bool PERM = true;
    static __device__ __forceinline__ bool keep_acc(const pg8::Unit&) { return false; }
    bf16* Y;
    __device__ __forceinline__ void operator()(const f32x4 (&acc)[2][2][4][2], const pg8::Unit& u, int wr, int wc, int fr, int fq) const {
        const int row0 = u.p0 * 256 + wr * 64 + fr, col0 = u.p1 * 256 + wc * 32 + 8 * fq;
#pragma unroll
        for (int ai = 0; ai < 2; ++ai)
#pragma unroll
            for (int m = 0; m < 4; ++m) { bf16* rp = Y + (size_t)(row0 + ai * 128 + m * 16) * 1024 + col0;
#pragma unroll
                for (int bj = 0; bj < 2; ++bj) { const f32x4 a = acc[ai][bj][m][0], b = acc[ai][bj][m][1];
                    v4u w; w.x = cvt_pk_bf16(a[0], a[1]); w.y = cvt_pk_bf16(a[2], a[3]); w.z = cvt_pk_bf16(b[0], b[1]); w.w = cvt_pk_bf16(b[2], b[3]);
                    *(v4u*)(rp + bj * 128) = w; } }
    }
};
__device__ __forceinline__ void phase_wo(Frame& F, int l) {
    SchedDense S; S.A = (const char*)(F_WS + WS_MERGED); S.B = (const char*)(F_WS + WS_WO) + (size_t)l * 1024 * 1024 * 2; S.lda = 1024; S.lda_b = 256 * 1024 * 2; S.ldb_b = 256 * 1024 * 2; S.nN = 4; S.nt = 16; S.G = F.G; S.vcu = F.vcu; S.ntiles = 512;
    EpiY E{(bf16*)(F_WS + WS_Y)};
    pg8::gemm_phase<EpiY, SchedDense, true>(F.lds, F.tid, 1024, S, E);
}

struct LnIn { f32x4 a[4]; v2u b[4]; };
__device__ __forceinline__ void ln_load(LnIn& R, const float* xin, const bf16* y, int lane) {
#pragma unroll
    for (int j = 0; j < 4; ++j) { R.a[j] = *(const f32x4*)(xin + 4 * lane + 256 * j); R.b[j] = *(const v2u*)(y + 4 * lane + 256 * j); }
}
__device__ __forceinline__ void ln_finish(const LnIn& R, const f32x4 (&gg)[4], const f32x4 (&bb)[4], float* xout, bf16* xb, int lane, f32x4 (&o)[4]) {
    f32x4 v[4]; float s = 0.f;
#pragma unroll
    for (int j = 0; j < 4; ++j) { const f32x4 yv = (f32x4){bflo(R.b[j].x), bfhi(R.b[j].x), bflo(R.b[j].y), bfhi(R.b[j].y)}; v[j] = R.a[j] * DN_ALPHA + yv; s += (v[j].x + v[j].y) + (v[j].z + v[j].w); }
    const float mean = wave_sum(s) * (1.f / D); float s2 = 0.f;
#pragma unroll
    for (int j = 0; j < 4; ++j) { v[j] = v[j] - mean; s2 += (v[j].x * v[j].x + v[j].y * v[j].y) + (v[j].z * v[j].z + v[j].w * v[j].w); }
    const float rstd = 1.0f / sqrtf(wave_sum(s2) * (1.f / D) + LN_EPS);
#pragma unroll
    for (int j = 0; j < 4; ++j) { o[j] = v[j] * rstd * gg[j] + bb[j]; *(f32x4*)(xout + 4 * lane + 256 * j) = o[j];
        v2u w; w.x = pk2(o[j].x, o[j].y); w.y = pk2(o[j].z, o[j].w); *(v2u*)(xb + 4 * lane + 256 * j) = w; }
}
__device__ __forceinline__ void phase_ln1_route(Frame& F, int l) {
    convert_moe_weights(F, l);
    __syncthreads();
    LAS float* RWL = (LAS float*)F.lds;
    LAS int* lcnt = (LAS int*)(F.lds + 140000);
    LAS int* lbase = lcnt + 32;
    LAS int* ent = lcnt + 64;
    LAS float* entw = (LAS float*)(ent + 1024);
    const float* xin = (l == 0) ? F_IN(I_X) : F_OUT; const bf16* Y = (const bf16*)(F_WS + WS_Y);
    const float* g = F_IN(I_LN1G) + l * D; const float* bt = F_IN(I_LN1B) + l * D; const float* RW = F_IN(I_RW); const float* RB = F_IN(I_RB);
    bf16* XB = (bf16*)(F_WS + WS_XB);
    unsigned* gcnt = (unsigned*)(F_WS + WS_CTL) + CW_CNT + l * 24 * 64;
    int* LIST = (int*)(F_WS + WS_LIST); f32x2* CWp = (f32x2*)(F_WS + WS_CW);
    for (int i = F.tid; i < 16384; i += NTHR) RWL[(i & 15) * 1024 + (i >> 4)] = RW[i];
    f32x4 gg[4], bb[4];
#pragma unroll
    for (int j = 0; j < 4; ++j) { gg[j] = *(const f32x4*)(g + 4 * F.lane + 256 * j); bb[j] = *(const f32x4*)(bt + 4 * F.lane + 256 * j); }
    const int rows_per = (T + F.G - 1) / F.G;
    for (int chunk = 0; chunk < rows_per; chunk += 512) {
        if (F.tid < 24) lcnt[F.tid] = 0;
        __syncthreads();
        const int r_lo = F.vcu * rows_per + chunk, r_hi = min(min(r_lo + 512, (F.vcu + 1) * rows_per), T);
        LnIn cur, nxt;
        int row = r_lo + F.wave;
        if (row < r_hi) ln_load(cur, xin + (size_t)row * D, Y + (size_t)row * D, F.lane);
        for (; row < r_hi; row += NWAVES) {
            if (row + NWAVES < r_hi) ln_load(nxt, xin + (size_t)(row + NWAVES) * D, Y + (size_t)(row + NWAVES) * D, F.lane);
            f32x4 o[4];
            ln_finish(cur, gg, bb, F_OUT + (size_t)row * D, XB + (size_t)row * D, F.lane, o);
            float lg[16];
#pragma unroll
            for (int e = 0; e < 16; ++e) { float a = 0.f;
#pragma unroll
                for (int j = 0; j < 4; ++j) { const f32x4 w4 = *(const LAS f32x4*)(RWL + e * 1024 + 4 * F.lane + 256 * j); a = fmaf(o[j].x, w4.x, a); a = fmaf(o[j].y, w4.y, a); a = fmaf(o[j].z, w4.z, a); a = fmaf(o[j].w, w4.w, a); }
                lg[e] = a; }
#pragma unroll
            for (int e = 0; e < 16; ++e) lg[e] = wave_sum(lg[e]);
            if (F.lane == 0) {
                float aff[16], ss[16];
#pragma unroll
                for (int e = 0; e < 16; ++e) { aff[e] = 1.0f / (1.0f + expf(-lg[e])); ss[e] = aff[e] + RB[e]; }
                int gbest = 0; float gs = -INFINITY;
#pragma unroll
                for (int gq = 0; gq < 4; ++gq) { float m1 = -INFINITY, m2 = -INFINITY;
#pragma unroll
                    for (int i = 0; i < 4; ++i) { const float v = ss[4 * gq + i]; if (v > m1) { m2 = m1; m1 = v; } else if (v > m2) m2 = v; }
                    const float sc = m1 + m2; if (sc > gs) { gs = sc; gbest = gq; } }
                float m1 = -INFINITY, m2 = -INFINITY; int i1 = 0, i2 = 0;
#pragma unroll
                for (int gq = 0; gq < 4; ++gq) if (gq == gbest) {
#pragma unroll
                    for (int i = 0; i < 4; ++i) { const float v = ss[4 * gq + i]; if (v > m1) { m2 = m1; i2 = i1; m1 = v; i1 = i; } else if (v > m2) { m2 = v; i2 = i; } } }
                float a1 = 0.f, a2 = 0.f;
#pragma unroll
                for (int e = 0; e < 16; ++e) { if (e == 4 * gbest + i1) a1 = aff[e]; if (e == 4 * gbest + i2) a2 = aff[e]; }
                const float inv = 1.0f / (a1 + a2);
                const int lo_i = min(i1, i2), hi_i = max(i1, i2);
                const float c_lo = (i1 < i2 ? a1 : a2) * inv, c_hi = (i1 < i2 ? a2 : a1) * inv;
                const int pidx = (lo_i == 0) ? (hi_i - 1) : (lo_i == 1 ? 1 + hi_i : 5);
                const int pair = min(max(gbest * 6 + pidx, 0), NPAIR - 1);
                const int lp = __hip_atomic_fetch_add(lcnt + pair, 1, __ATOMIC_RELAXED, __HIP_MEMORY_SCOPE_WORKGROUP);
                const int k = row - r_lo; ent[2 * k] = pair; ent[2 * k + 1] = lp; entw[2 * k] = c_lo; entw[2 * k + 1] = c_hi;
            }
#pragma unroll
            for (int j = 0; j < 4; ++j) { cur.a[j] = nxt.a[j]; cur.b[j] = nxt.b[j]; }
        }
        __syncthreads();
        if (F.tid < 24) lbase[F.tid] = (int)__hip_atomic_fetch_add(gcnt + F.tid * 64, (unsigned)lcnt[F.tid], __ATOMIC_RELAXED, __HIP_MEMORY_SCOPE_AGENT);
        __syncthreads();
        for (int k = F.tid; k < r_hi - r_lo; k += NTHR) { const int pair = ent[2 * k], pos = lbase[pair] + ent[2 * k + 1];
            LIST[(size_t)pair * T + pos] = r_lo + k; CWp[(size_t)pair * T + pos] = (f32x2){entw[2 * k], entw[2 * k + 1]}; }
        __syncthreads();
    }
}
__device__ __forceinline__ void phase_ln2(Frame& F, int l) {
    const bf16* Y = (const bf16*)(F_WS + WS_Y); const float* g = F_IN(I_LN2G) + l * D; const float* bt = F_IN(I_LN2B) + l * D; bf16* XB = (bf16*)(F_WS + WS_XB);
    const int gw = F.vcu * NWAVES + F.wave, NGW = F.G * NWAVES;
    f32x4 gg[4], bb[4];
#pragma unroll
    for (int j = 0; j < 4; ++j) { gg[j] = *(const f32x4*)(g + 4 * F.lane + 256 * j); bb[j] = *(const f32x4*)(bt + 4 * F.lane + 256 * j); }
    LnIn cur, nxt;
    int row = gw;
    if (row < T) ln_load(cur, F_OUT + (size_t)row * D, Y + (size_t)row * D, F.lane);
    for (; row < T; row += NGW) {
        if (row + NGW < T) ln_load(nxt, F_OUT + (size_t)(row + NGW) * D, Y + (size_t)(row + NGW) * D, F.lane);
        f32x4 o[4]; ln_finish(cur, gg, bb, F_OUT + (size_t)row * D, XB + (size_t)row * D, F.lane, o);
#pragma unroll
        for (int j = 0; j < 4; ++j) { cur.a[j] = nxt.a[j]; cur.b[j] = nxt.b[j]; }
    }
}

__device__ __forceinline__ void moe_table(Frame& F, int l, LAS int* tp, LAS int* cn) {
    const unsigned* gcnt = (const unsigned*)(F_WS + WS_CTL) + CW_CNT + l * 24 * 64;
    if (F.tid == 0) { int acc = 0; for (int p = 0; p < 24; ++p) { const int c = (int)__hip_atomic_load(gcnt + p * 64, __ATOMIC_RELAXED, __HIP_MEMORY_SCOPE_AGENT); cn[p] = c; tp[p] = acc; acc += (c + 255) >> 8; } tp[24] = acc; }
    __syncthreads();
}
__device__ __forceinline__ void pair_experts(int p, int& e0, int& e1) { const int gq = p / 6, k = p % 6; const int lo = k < 3 ? 0 : (k < 5 ? 1 : 2); const int hi = k < 3 ? k + 1 : (k < 5 ? k - 1 : 3); e0 = 4 * gq + lo; e1 = 4 * gq + hi; }
struct SchedMoeUp {
    unsigned char* ws; const LAS int* tp; const LAS int* cn; int G, vcu, RT;
    __device__ __forceinline__ bool next(int i, pg8::Unit& u) const {
        const int L = i * G + vcu; if (L >= RT * 8) return false;
        const int rt = L >> 3, ct = L & 7; int p = 0;
        for (int q = 1; q < 24; ++q) if (tp[q] <= rt) p = q;
        int e0, e1; pair_experts(p, e0, e1); const int e = ct < 4 ? e0 : e1; const int lr0 = (rt - tp[p]) * 256;
        u.A = (const char*)(ws + WS_XB); u.B = (const char*)(ws + WS_WGU) + ((size_t)e * 1024 + (ct & 3) * 256) * 1024 * 2;
        u.rowlist = (const int*)(ws + WS_LIST) + (size_t)p * T + lr0; u.nvalid = min(256, cn[p] - lr0); u.lda = 1024; u.nt = 16; u.ksplit = 1 << 30; u.bdelta = 0;
        u.p0 = rt; u.p1 = ct; u.p2 = p; u.p3 = lr0; return true;
    }
};
struct EpiMoeUp {
    static constexpr bool PERM = true;
    static __device__ __forceinline__ bool keep_acc(const pg8::Unit&) { return false; }
    unsigned char* ws;
    __device__ __forceinline__ void operator()(const f32x4 (&acc)[2][2][4][2], const pg8::Unit& u, int wr, int wc, int fr, int fq) const {
        const int rt = u.p0, ct = u.p1, p = u.p2, lr0 = u.p3;
        bf16* H = (bf16*)(ws + WS_H); const f32x2* CWp = (const f32x2*)(ws + WS_CW) + (size_t)p * T + lr0;
        const int slot = ct >> 2;
        float cw1[2][4];
#pragma unroll
        for (int ai = 0; ai < 2; ++ai)
#pragma unroll
            for (int m = 0; m < 4; ++m) cw1[ai][m] = ((const float*)CWp)[2 * min(ai * 128 + wr * 64 + m * 16 + fr, u.nvalid - 1) + slot];
#pragma unroll
        for (int ai = 0; ai < 2; ++ai)
#pragma unroll
            for (int m = 0; m < 4; ++m) { const int r = ai * 128 + wr * 64 + m * 16 + fr; const bool ok = r < u.nvalid;
                const float cw = ok ? cw1[ai][m] : 0.f;
#pragma unroll
                for (int bj = 0; bj < 2; ++bj) { const f32x4 gv = acc[ai][bj][m][0], uv = acc[ai][bj][m][1];
                    float hh[4];
#pragma unroll
                    for (int x = 0; x < 4; ++x) { const float gx = gv[x]; hh[x] = ok ? gx * sigmoidf_(gx) * uv[x] * cw : 0.f; }
                    v2u w; w.x = cvt_pk_bf16(hh[0], hh[1]); w.y = cvt_pk_bf16(hh[2], hh[3]);
                    *(v2u*)(H + (size_t)(rt * 256 + r) * 1024 + slot * 512 + (ct & 3) * 128 + bj * 64 + wc * 16 + 4 * fq) = w; } }
    }
};
struct SchedMoeDown {
    unsigned char* ws; const LAS int* tp; const LAS int* cn; int G, vcu, RT;
    __device__ __forceinline__ bool next(int i, pg8::Unit& u) const {
        const int L = i * G + vcu; if (L >= RT * 4) return false;
        const int rt = L >> 2, ct = L & 3; int p = 0;
        for (int q = 1; q < 24; ++q) if (tp[q] <= rt) p = q;
        int e0, e1; pair_experts(p, e0, e1); const int lr0 = (rt - tp[p]) * 256;
        u.A = (const char*)(ws + WS_H) + (size_t)rt * 256 * 1024 * 2; u.B = (const char*)(ws + WS_WD) + ((size_t)ct * 256 * (NEXP * DE) + e0 * DE) * 2;
        u.rowlist = nullptr; u.nvalid = min(256, cn[p] - lr0); u.lda = 1024; u.nt = 16; u.ksplit = 8; u.bdelta = (long)(e1 - e0 - 1) * DE * 2;
        u.p0 = rt; u.p1 = ct; u.p2 = p; u.p3 = lr0; return true;
    }
};
struct EpiMoeDown {
    static constexpr bool PERM = true;
    static __device__ __forceinline__ bool keep_acc(const pg8::Unit&) { return false; }
    unsigned char* ws;
    __device__ __forceinline__ void operator()(const f32x4 (&acc)[2][2][4][2], const pg8::Unit& u, int wr, int wc, int fr, int fq) const {
        const int ct = u.p1, p = u.p2, lr0 = u.p3;
        bf16* Y = (bf16*)(ws + WS_Y); const int* LIST = (const int*)(ws + WS_LIST) + (size_t)p * T + lr0;
        const int col0 = ct * 256 + wc * 32 + 8 * fq;
#pragma unroll
        for (int ai = 0; ai < 2; ++ai)
#pragma unroll
            for (int m = 0; m < 4; ++m) { const int r = ai * 128 + wr * 64 + m * 16 + fr;
                if (r < u.nvalid) { const int tok = LIST[r]; bf16* rp = Y + (size_t)tok * 1024 + col0;
#pragma unroll
                    for (int bj = 0; bj < 2; ++bj) { const f32x4 a = acc[ai][bj][m][0], b = acc[ai][bj][m][1];
                        v4u w; w.x = cvt_pk_bf16(a[0], a[1]); w.y = cvt_pk_bf16(a[2], a[3]); w.z = cvt_pk_bf16(b[0], b[1]); w.w = cvt_pk_bf16(b[2], b[3]);
                        *(v4u*)(rp + bj * 128) = w; } } }
    }
};
__device__ __forceinline__ void phase_moe_up(Frame& F, int l) {
    LAS int* tp = (LAS int*)(F.lds + LDS_MISC_OFF + 64); LAS int* cn = tp + 32;
    moe_table(F, l, tp, cn);
    SchedMoeUp S{F_WS, tp, cn, F.G, F.vcu, __builtin_amdgcn_readfirstlane(tp[24])}; EpiMoeUp E{F_WS};
    pg8::gemm_phase<EpiMoeUp, SchedMoeUp, true>(F.lds, F.tid, 1024, S, E);
}
__device__ __forceinline__ void phase_moe_down(Frame& F, int l) {
    LAS int* tp = (LAS int*)(F.lds + LDS_MISC_OFF + 64); LAS int* cn = tp + 32;
    moe_table(F, l, tp, cn);
    SchedMoeDown S{F_WS, tp, cn, F.G, F.vcu, __builtin_amdgcn_readfirstlane(tp[24])}; EpiMoeDown E{F_WS};
    pg8::gemm_phase<EpiMoeDown, SchedMoeDown, true>(F.lds, F.tid, NEXP * DE, S, E);
}


#ifndef TP_DSAP
#define TP_DSAP 7
#endif
#ifndef TP_PHASE
#define TP_PHASE -1
#endif
__global__ void __launch_bounds__(NTHR, 2) fwd_kernel(Args args) {
    extern __shared__ __attribute__((aligned(16))) unsigned char lds[];
    Frame F;
    F.lds = (LAS unsigned char*)lds; F.wsg = (gbyte*)args.ws; F.outg = (GAS float*)args.out;
#pragma unroll
    for (int i = 0; i < 16; ++i) F.ing[i] = (GAS const float*)args.in[i];
    const int wave0 = __builtin_amdgcn_readfirstlane((int)threadIdx.x >> 6);
    F.lane = lane_id(); F.tid = wave0 * 64 + F.lane; F.wave = wave0;
    F.G = gridDim.x; { const int bx = blockIdx.x; F.vcu = (F.G % 8 == 0) ? (bx % 8) * (F.G / 8) + bx / 8 : bx; }
    volatile LAS unsigned* MISC = (volatile LAS unsigned*)(F.lds + LDS_MISC_OFF);
    for (int u = F.tid; u < 128; u += NTHR) MISC[u] = 0u;
    __syncthreads();
    XcdBarrier bar = xcd_barrier_post((gu32*)(F.wsg + WS_CTL) + CW_BAR, MISC + 8, F.tid == 0);
    const int lo = args.ph_lo, hi = args.ph_hi;
#define IN(k) (lo <= (k) && (k) < hi)
#define PB() do { gbyte* w_ = (gbyte*)args.ws; asm volatile("" : "+s"(w_)); F.wsg = w_; int t_ = wave0 * 64 + lane_id(); asm volatile("" : "+v"(t_)); F.tid = t_; F.lane = t_ & 63; F.wave = wave0; } while (0)
#define XBAR() xcd_barrier(bar, wave0 == 0 && lane_id() == 0)
#define SEAM(k) do { if (IN(k) && IN((k) + 1)) xcd_barrier(bar, wave0 == 0 && lane_id() == 0); } while (0)
    if (IN(0)) { PB(); phase_prologue_a(F); XBAR(); PB(); phase_prologue(F); } SEAM(0);
    if (TP_PHASE == 20) { PB(); phase_prologue_a(F); XBAR(); PB(); phase_prologue(F); XBAR(); }
    if (TP_PHASE == 21) { PB(); convert_moe_weights(F, 0); XBAR(); }
    if (TP_PHASE == 40) { XBAR(); XBAR(); XBAR(); XBAR(); XBAR(); XBAR(); XBAR(); XBAR(); XBAR(); XBAR(); XBAR(); XBAR(); XBAR(); XBAR(); XBAR(); XBAR(); }
#define LAYER(l) do { const int pb = 1 + 8 * (l); \
        if (IN(pb + 0)) { PB(); phase_inproj(F, (l)); } SEAM(pb + 0); \
        if (TP_PHASE == 0 && (l) == 0) { PB(); phase_inproj(F, (l)); XBAR(); } \
        if (TP_PHASE == 30 && (l) == 0) { PB(); phase_inproj_probe(F, (l)); XBAR(); } \
        if (TP_PHASE == 31 && (l) == 0) { PB(); phase_inproj_mode<1>(F, (l)); XBAR(); PB(); phase_inproj(F, (l)); XBAR(); } \
        if (TP_PHASE == 32 && (l) == 0) { PB(); phase_inproj_mode<2>(F, (l)); XBAR(); PB(); phase_inproj(F, (l)); XBAR(); } \
        if (TP_PHASE >= 11 && TP_PHASE <= 13 && (l) == 0) { PB(); phase_attention<((TP_PHASE >= 11 && TP_PHASE <= 13) ? (1 << ((TP_PHASE >= 11 ? TP_PHASE : 11) - 11)) : 7), TP_DSAP>(F, (l)); XBAR(); PB(); phase_inproj(F, (l)); XBAR(); } \
        if (IN(pb + 1)) { PB(); phase_attention(F, (l)); } SEAM(pb + 1); \
        if (TP_PHASE == 1 && (l) == 0) { PB(); phase_inproj(F, (l)); XBAR(); PB(); phase_attention(F, (l)); XBAR(); } \
        if (IN(pb + 2)) { PB(); phase_branch(F, (l)); } SEAM(pb + 2); \
        if (TP_PHASE == 2 && (l) == 0) { PB(); phase_branch(F, (l)); XBAR(); } \
        if (IN(pb + 3)) { PB(); phase_wo(F, (l)); } SEAM(pb + 3); \
        if (TP_PHASE == 3 && (l) == 0) { PB(); phase_wo(F, (l)); XBAR(); } \
        if (IN(pb + 4)) { PB(); phase_ln1_route(F, (l)); } SEAM(pb + 4); \
        if (IN(pb + 5)) { PB(); phase_moe_up(F, (l)); } SEAM(pb + 5); \
        if (TP_PHASE == 5 && (l) == 0) { PB(); phase_moe_up(F, (l)); XBAR(); } \
        if (IN(pb + 6)) { PB(); phase_moe_down(F, (l)); } SEAM(pb + 6); \
        if (TP_PHASE == 6 && (l) == 0) { PB(); phase_moe_down(F, (l)); XBAR(); } \
        if (IN(pb + 7)) { PB(); phase_ln2(F, (l)); } SEAM(pb + 7); \
    } while (0)
    LAYER(0);
    LAYER(1);
#undef LAYER
#undef IN
#undef SEAM
}

extern "C" void kernel_launch(void* const* d_in, const int* in_sizes, int n_in, void* d_out, int out_size, void* d_ws, size_t ws_size, hipStream_t stream) {
    static int grid = 0;
    if (grid == 0) {
        if (n_in != 16 || out_size != T * D || ws_size < WS_END) { fprintf(stderr, "kernel_launch: unexpected shapes (n_in %d out %d ws %zu)\n", n_in, out_size, ws_size); grid = -1; return; }
        int dev = 0, cus = 0, per_cu = 0;
        if (hipGetDevice(&dev) != hipSuccess || hipDeviceGetAttribute(&cus, hipDeviceAttributeMultiprocessorCount, dev) != hipSuccess) { grid = -1; return; }
        if (hipFuncSetAttribute((const void*)fwd_kernel, hipFuncAttributeMaxDynamicSharedMemorySize, LDS_BYTES) != hipSuccess) { fprintf(stderr, "kernel_launch: hipFuncSetAttribute failed\n"); grid = -1; return; }
        if (hipOccupancyMaxActiveBlocksPerMultiprocessor(&per_cu, (const void*)fwd_kernel, NTHR, LDS_BYTES) != hipSuccess || per_cu < 1) { fprintf(stderr, "kernel_launch: occupancy query says %d\n", per_cu); }
        (void)hipGetLastError();
        grid = cus;
    }
    if (grid < 0) return;
    (void)hipMemsetAsync((char*)d_ws + WS_CTL, 0, CTL_ZERO_BYTES, stream);
    Args a{};
    for (int i = 0; i < 16; ++i) a.in[i] = (const float*)d_in[i];
    a.out = (float*)d_out; a.ws = (unsigned char*)d_ws; a.ph_lo = 0; a.ph_hi = 1000;
    hipLaunchKernelGGL(fwd_kernel, dim3(grid), dim3(NTHR), LDS_BYTES, stream, a);
}
```

```cpp
#include <hip/hip_runtime.h>
#include <cstdio>
#include <cstdint>

#define GAS __attribute__((address_space(1)))
#define LAS __attribute__((address_space(3)))
typedef unsigned short bf16;
typedef unsigned short u16;
typedef unsigned v4u __attribute__((ext_vector_type(4)));
typedef unsigned v2u __attribute__((ext_vector_type(2)));
typedef float f32x4 __attribute__((ext_vector_type(4)));
typedef float f32x2 __attribute__((ext_vector_type(2)));
typedef float f32x16 __attribute__((ext_vector_type(16)));
typedef short bf16x8 __attribute__((ext_vector_type(8)));
typedef _Float16 f16x8 __attribute__((ext_vector_type(8)));
typedef _Float16 f16x2 __attribute__((ext_vector_type(2)));
typedef short s16x4 __attribute__((ext_vector_type(4)));
typedef GAS unsigned gu32;
#define RLX_AGENT __ATOMIC_RELAXED, __HIP_MEMORY_SCOPE_AGENT
#define LDS_WAIT() asm volatile("s_waitcnt lgkmcnt(0)" ::: "memory")
#define VM_WAIT() asm volatile("s_waitcnt vmcnt(0)" ::: "memory")

constexpr int T = 32768, SEQ = 8192, NB = 4, D = 1024, DEPTH = 2;
constexpr int N_IN = 5316, N_INP = 5376;
constexpr int C_AQ = 0, C_AC = 256, C_IQ = 384, C_IK = 640, C_IW = 704, C_BQ = 708, C_BK = 964, C_BV = 1220, C_CQ = 1476, C_CK = 1988, C_CV = 2116, C_G = 2244;
constexpr int NEXP = 16, DE = 512, NPAIR = 24;
constexpr float LN_EPS = 1e-5f;
constexpr float DN_ALPHA = 1.41421356237309515f;
constexpr float LOG2E = 1.4426950408889634f;
constexpr float SM_C = 0.125f * LOG2E;
constexpr int NWAVES = 8, NTHR = 512;

constexpr size_t MiB = 1u << 20;
constexpr size_t WS_CTL = 0, CTL_ZERO_BYTES = 1 * MiB;
constexpr size_t WS_ROPE = 1 * MiB;
constexpr size_t WS_WIN = 3 * MiB;
constexpr size_t WS_WBR = 24 * MiB;
constexpr size_t WS_WO = 28 * MiB;
constexpr size_t WS_XB = 32 * MiB;
constexpr size_t WS_ATT = 96 * MiB;
constexpr size_t WS_AQ = WS_ATT, WS_BQ = WS_AQ + 16 * MiB, WS_CQ = WS_BQ + 16 * MiB;
constexpr size_t WS_IQ = WS_CQ + 32 * MiB;
constexpr size_t WS_KAVA = WS_IQ + 16 * MiB;
constexpr size_t WS_IK = WS_KAVA + 8 * MiB;
constexpr size_t WS_BK = WS_IK + 4 * MiB, WS_BV = WS_BK + 16 * MiB;
constexpr size_t WS_CKV = WS_BV + 16 * MiB;
constexpr size_t WS_MERGED = WS_IQ;
constexpr size_t WS_H = WS_ATT;
constexpr size_t WS_GATES = 236 * MiB;
constexpr size_t WS_Y = WS_GATES;
constexpr size_t WS_MISC = 428 * MiB;
constexpr size_t WS_IW = WS_MISC;
constexpr size_t WS_KMP = WS_MISC + 1 * MiB;
constexpr size_t WS_LIST = WS_MISC + 2 * MiB;
constexpr size_t WS_CW = WS_MISC + 5 * MiB;
constexpr size_t WS_WF = WS_MISC + 11 * MiB;
constexpr size_t WS_WGU = 440 * MiB;
constexpr size_t WS_WD = 472 * MiB;
constexpr size_t WS_END = 488 * MiB;
static_assert(WS_CKV + 16 * MiB == WS_GATES && WS_MERGED + 64 * MiB <= WS_CKV + 16 * MiB && WS_CW + 6 * MiB <= WS_WGU, "ws map");
constexpr int CW_TMO = 0;
constexpr int CW_BAR = 4096;
constexpr int CW_CNT = 16384;

constexpr int RING_BYTES = 131072;
constexpr int LDS_MISC_OFF = 155648 - 512;
constexpr int LDS_BYTES = 155648;

__device__ __forceinline__ unsigned f2bf(float f) { unsigned u = __builtin_bit_cast(unsigned, f); return (u + 0x7fffu + ((u >> 16) & 1u)) >> 16; }
__device__ __forceinline__ unsigned pk2(float lo, float hi) { return f2bf(lo) | (f2bf(hi) << 16); }
typedef __bf16 bf16x2_t __attribute__((ext_vector_type(2)));
__device__ __forceinline__ unsigned cvt_pk_bf16(float lo, float hi) { f32x2 v = {lo, hi}; bf16x2_t b = __builtin_convertvector(v, bf16x2_t); return __builtin_bit_cast(unsigned, b); }
__device__ __forceinline__ unsigned pk2h(float lo, float hi) { f16x2 v; v.x = (_Float16)lo; v.y = (_Float16)hi; return __builtin_bit_cast(unsigned, v); }
__device__ __forceinline__ float bf2f(unsigned short b) { return __builtin_bit_cast(float, (unsigned)b << 16); }
__device__ __forceinline__ float bflo(unsigned w) { return __builtin_bit_cast(float, w << 16); }
__device__ __forceinline__ float bfhi(unsigned w) { return __builtin_bit_cast(float, w & 0xffff0000u); }
template <int M> __device__ __forceinline__ float xor_f(float v) { return __builtin_bit_cast(float, __builtin_amdgcn_ds_swizzle(__builtin_bit_cast(int, v), (M << 10) | 0x1f)); }
template <int M> __device__ __forceinline__ unsigned xor_u(unsigned v) { return (unsigned)__builtin_amdgcn_ds_swizzle((int)v, (M << 10) | 0x1f); }
__device__ __forceinline__ void half_swap(unsigned& a, unsigned& b) { asm volatile("v_nop\n\tv_nop\n\tv_permlane32_swap_b32 %0, %1\n\tv_nop" : "+v"(a), "+v"(b)); }
__device__ __forceinline__ float half_sum(float v) { unsigned a = __builtin_bit_cast(unsigned, v), b = a; half_swap(a, b); return __builtin_bit_cast(float, a) + __builtin_bit_cast(float, b); }
__device__ __forceinline__ float half_max(float v) { unsigned a = __builtin_bit_cast(unsigned, v), b = a; half_swap(a, b); return fmaxf(__builtin_bit_cast(float, a), __builtin_bit_cast(float, b)); }
template <int CTRL> __device__ __forceinline__ float dpp_f(float v) { return __builtin_bit_cast(float, __builtin_amdgcn_update_dpp(0, __builtin_bit_cast(int, v), CTRL, 0xf, 0xf, false)); }
__device__ __forceinline__ float row_sum(float v) { v += dpp_f<0xB1>(v); v += dpp_f<0x4E>(v); v += dpp_f<0x141>(v); v += dpp_f<0x140>(v); return v; }
__device__ __forceinline__ float row_max(float v) { v = fmaxf(v, dpp_f<0xB1>(v)); v = fmaxf(v, dpp_f<0x4E>(v)); v = fmaxf(v, dpp_f<0x141>(v)); v = fmaxf(v, dpp_f<0x140>(v)); return v; }
__device__ __forceinline__ float wave_sum(float v) { v = row_sum(v); v += xor_f<16>(v); return half_sum(v); }
__device__ __forceinline__ float wave_max(float v) { v = row_max(v); v = fmaxf(v, xor_f<16>(v)); return half_max(v); }
__device__ __forceinline__ long ik_off(int key, int piece) { return ((long)(key >> 5) * 8 + piece) * 256 + (key & 31) * 8; }
__device__ __forceinline__ long bk_off(int h, long row, int piece) { return (((long)h * (T / 32) + (row >> 5)) * 8 + piece) * 256 + (row & 31) * 8; }
__device__ __forceinline__ int lane_id() { int r; asm volatile("v_mbcnt_lo_u32_b32 %0, -1, 0\n\tv_mbcnt_hi_u32_b32 %0, -1, %0" : "=v"(r)); return r; }
__device__ __forceinline__ float sigmoidf_(float x) { return __builtin_amdgcn_rcpf(1.0f + __builtin_amdgcn_exp2f(-LOG2E * x)); }

namespace pg8 {
constexpr int BM = 256, BK = 64, HALF = 128, HTB = HALF * BK * 2, STAGE_BYTES = 8 * HTB;
__host__ __device__ __forceinline__ int lds_byte(int r, int c) { const int st = (r >> 4) * 2 + (c >> 5), rr = r & 15, cc = c & 31, ob = rr * 64 + cc * 2; return st * 1024 + (ob ^ (((ob >> 9) & 1) << 5)); }
__host__ __device__ __forceinline__ void stage_rc(int b, int& R, int& C) { const int st = b / 1024, sb = b % 1024, swz = sb ^ (((sb >> 9) & 1) << 5); R = (st >> 1) * 16 + swz / 64; C = (st & 1) * 32 + (swz % 64) / 2; }
__host__ __device__ __forceinline__ int perm32(int rho) { const int n = rho >> 4, i = rho & 15; return 8 * (i >> 2) + 4 * n + (i & 3); }

struct Unit { const char* A; const char* B; const int* rowlist; int nvalid; int lda; int nt; int ksplit; long bdelta; int p0, p1, p2, p3; };

template <class Epi, class Sched, bool ALIGN_EPI>
__device__ __forceinline__ void gemm_phase(LAS unsigned char* lds, int tid, int ldb, const Sched& S, const Epi& E) {
    const int wid = __builtin_amdgcn_readfirstlane(tid >> 6), lane = tid & 63, wr = wid >> 2, wc = wid & 3, fr = lane & 15, fq = lane >> 4;
    int R0, C0; stage_rc(tid * 16, R0, C0);
    const int Rb0 = Epi::PERM ? ((R0 & ~31) + perm32(R0 & 31)) : R0;
    unsigned voffB[2];
    voffB[0] = (unsigned)(Rb0 * ldb + C0) * 2u; voffB[1] = (unsigned)((Rb0 + 64) * ldb + C0) * 2u;
    const size_t kstep = (size_t)(BK * 2);
    const size_t hstepB = (size_t)HALF * ldb * 2;
    const unsigned ldsw = (unsigned)wid * 1024u;
    const int aoff = lds_byte(wr * 64 + fr, fq * 8), boff = lds_byte(wc * 32 + fr, fq * 8);
#define PG8_SA(b, h) (((b) * 2 + (h)) * HTB)
#define PG8_SB(b, h) ((4 + (b) * 2 + (h)) * HTB)
#define PG8_STAGEB(bufoff, gbase) do { _Pragma("unroll") for (int _i = 0; _i < 2; ++_i) \
        __builtin_amdgcn_global_load_lds((const unsigned*)((const char*)(gbase) + voffB[_i]), (LAS unsigned*)(lds + (bufoff) + ldsw + _i * 8192), 16, 0, 0); } while (0)
#define PG8_STAGEA(bufoff, gbase, vo, h) do { \
        __builtin_amdgcn_global_load_lds((const unsigned*)((const char*)(gbase) + vo##h##0), (LAS unsigned*)(lds + (bufoff) + ldsw), 16, 0, 0); \
        __builtin_amdgcn_global_load_lds((const unsigned*)((const char*)(gbase) + vo##h##1), (LAS unsigned*)(lds + (bufoff) + ldsw + 8192), 16, 0, 0); } while (0)
#define PG8_LDA(dst, b, h) do { _Pragma("unroll") for (int m = 0; m < 4; ++m) _Pragma("unroll") for (int k = 0; k < 2; ++k) dst[m][k] = *(const LAS bf16x8*)(lds + PG8_SA(b, h) + aoff + m * 2048 + k * 1024); } while (0)
#define PG8_LDB(dst, b, h) do { _Pragma("unroll") for (int n = 0; n < 2; ++n) _Pragma("unroll") for (int k = 0; k < 2; ++k) dst[n][k] = *(const LAS bf16x8*)(lds + PG8_SB(b, h) + boff + n * 2048 + k * 1024); } while (0)
#define PG8_MMA(ai, bj, At, Bt) do { __builtin_amdgcn_s_setprio(1); _Pragma("unroll") for (int m = 0; m < 4; ++m) _Pragma("unroll") for (int n = 0; n < 2; ++n) _Pragma("unroll") for (int k = 0; k < 2; ++k) \
        acc[ai][bj][m][n] = __builtin_amdgcn_mfma_f32_16x16x32_bf16(Bt[n][k], At[m][k], acc[ai][bj][m][n], 0, 0, 0); __builtin_amdgcn_s_setprio(0); } while (0)
#define PG8_WAIT_V(n) asm volatile("s_waitcnt vmcnt(" #n ")" ::: "memory")
#define PG8_WAIT_L(n) asm volatile("s_waitcnt lgkmcnt(" #n ")" ::: "memory")
#define PG8_BAR __builtin_amdgcn_s_barrier()
#define PG8_SCHED __builtin_amdgcn_sched_barrier(0)
#define PG8_BK(u, tt) ((u).B + (size_t)(tt) * kstep + (((tt) >= (u).ksplit) ? (u).bdelta : 0))
#define PG8_VOFF1(u, dst, rr) do { const int _r = (rr) + R0; int _g = _r; if ((u).rowlist) { _g = (u).rowlist[(_r < (u).nvalid) ? _r : 0]; } dst = (unsigned)(_g * (u).lda + C0) * 2u; } while (0)
#define PG8_VOFFA(u, vo) do { PG8_VOFF1(u, vo##00, 0); PG8_VOFF1(u, vo##01, 64); PG8_VOFF1(u, vo##10, 128); PG8_VOFF1(u, vo##11, 192); } while (0)
    Unit cur, nxt; int ui = 0;
    if (!S.next(0, cur)) return;
    f32x4 acc[2][2][4][2];
#pragma unroll
    for (int a = 0; a < 2; ++a)
#pragma unroll
        for (int b = 0; b < 2; ++b)
#pragma unroll
            for (int m = 0; m < 4; ++m)
#pragma unroll
                for (int n = 0; n < 2; ++n) acc[a][b][m][n] = (f32x4){0.f, 0.f, 0.f, 0.f};
    bf16x8 At[4][2], B0[2][2], B1[2][2];
    unsigned cvo00, cvo01, cvo10, cvo11;
    LAS v4u* park = (LAS v4u*)(lds + STAGE_BYTES) + tid;
    PG8_VOFFA(cur, cvo);
    {
        const char* cA = cur.A; const char* b0 = PG8_BK(cur, 0); const char* b1 = PG8_BK(cur, 1);
        PG8_STAGEB(PG8_SB(0, 0), b0); PG8_STAGEB(PG8_SB(0, 1), b0 + hstepB); PG8_STAGEA(PG8_SA(0, 0), cA, cvo, 0); PG8_STAGEA(PG8_SA(0, 1), cA, cvo, 1);
        if (wr == 1) PG8_BAR;
        PG8_WAIT_V(2); PG8_BAR;
        PG8_STAGEB(PG8_SB(1, 0), b1); PG8_STAGEA(PG8_SA(1, 0), cA + kstep, cvo, 0); PG8_STAGEB(PG8_SB(1, 1), b1 + hstepB);
        PG8_WAIT_V(6); PG8_BAR;
    }
    for (;;) {
        const bool has_next = S.next(ui + 1, nxt);
        if (!has_next) nxt = cur;
        { unsigned nvo00, nvo01, nvo10, nvo11; PG8_VOFFA(nxt, nvo); *park = (v4u){nvo00, nvo01, nvo10, nvo11}; }
        const int nt = cur.nt;
        const char* cA = cur.A;
        for (int t = 0; t < nt; t += 2) {
            const bool last = (t == nt - 2);
            const char* a1 = cA + (size_t)(t + 1) * kstep;
            const char* a2 = last ? nxt.A : cA + (size_t)(t + 2) * kstep;
            const char* a3 = a2 + kstep;
            const char* b2 = last ? PG8_BK(nxt, 0) : PG8_BK(cur, t + 2);
            const char* b3 = last ? PG8_BK(nxt, 1) : PG8_BK(cur, t + 3);
            unsigned vo200 = cvo00, vo201 = cvo01, vo210 = cvo10, vo211 = cvo11;
            if (last) { const v4u nv = *park; vo200 = nv.x; vo201 = nv.y; vo210 = nv.z; vo211 = nv.w; }
            PG8_LDB(B0, 0, 0); PG8_LDB(B1, 0, 1); PG8_SCHED; PG8_LDA(At, 0, 0); PG8_STAGEA(PG8_SA(1, 1), a1, cvo, 1);
            PG8_WAIT_V(8); PG8_WAIT_L(0); PG8_BAR; PG8_MMA(0, 0, At, B0); PG8_MMA(0, 1, At, B1); PG8_BAR; PG8_SCHED;
            PG8_LDA(At, 0, 1); PG8_STAGEB(PG8_SB(0, 0), b2); PG8_STAGEB(PG8_SB(0, 1), b2 + hstepB); PG8_STAGEA(PG8_SA(0, 0), a2, vo2, 0);
            PG8_WAIT_V(8); PG8_WAIT_L(0); PG8_BAR; PG8_MMA(1, 0, At, B0); PG8_MMA(1, 1, At, B1); PG8_BAR; PG8_SCHED;
            PG8_LDB(B0, 1, 0); PG8_LDB(B1, 1, 1); PG8_SCHED; PG8_LDA(At, 1, 0); PG8_STAGEA(PG8_SA(0, 1), a2, vo2, 1);
            PG8_WAIT_V(8); PG8_WAIT_L(0); PG8_BAR; PG8_MMA(0, 0, At, B0); PG8_MMA(0, 1, At, B1); PG8_BAR; PG8_SCHED;
            PG8_LDA(At, 1, 1); PG8_STAGEB(PG8_SB(1, 0), b3); PG8_STAGEB(PG8_SB(1, 1), b3 + hstepB); PG8_STAGEA(PG8_SA(1, 0), a3, vo2, 0);
            PG8_WAIT_V(8); PG8_WAIT_L(0); PG8_BAR; PG8_MMA(1, 0, At, B0); PG8_MMA(1, 1, At, B1); PG8_BAR; PG8_SCHED;
        }
        if constexpr (ALIGN_EPI) { if (wr == 0) PG8_BAR; }
        E(acc, cur, wr, wc, fr, fq);
        if (!has_next) break;
        if (!Epi::keep_acc(cur))
#pragma unroll
        for (int a = 0; a < 2; ++a)
#pragma unroll
            for (int b = 0; b < 2; ++b)
#pragma unroll
                for (int m = 0; m < 4; ++m)
#pragma unroll
                    for (int n = 0; n < 2; ++n) acc[a][b][m][n] = (f32x4){0.f, 0.f, 0.f, 0.f};
        cur = nxt; ++ui;
        { const v4u nv = *park; cvo00 = nv.x; cvo01 = nv.y; cvo10 = nv.z; cvo11 = nv.w; }
        if constexpr (ALIGN_EPI) { if (wr == 1) PG8_BAR; }
    }
    PG8_WAIT_V(0);
    if constexpr (!ALIGN_EPI) { if (wr == 0) PG8_BAR; }
    PG8_BAR;
#undef PG8_SA
#undef PG8_SB
#undef PG8_STAGEA
#undef PG8_STAGEB
#undef PG8_LDA
#undef PG8_LDB
#undef PG8_MMA
#undef PG8_WAIT_V
#undef PG8_WAIT_L
#undef PG8_BAR
#undef PG8_SCHED
#undef PG8_BK
#undef PG8_VOFFA
}
}

#define XB_TMO      128
#define XB_XCNT(j)  (256  + 64 * (j))
#define XB_XSUB(j)  (1280 + 64 * (j))
#define XB_XGEN(j)  (2304 + 64 * (j))
#define XB_TOP      3328
#define XB_TOPGEN   3392
#define XCD_BAR_WORDS 3456
#define XB_SPIN_CAP (1u << 20)
__device__ __forceinline__ unsigned xb_ld(gu32* p)              { return __hip_atomic_load(p, __ATOMIC_RELAXED, __HIP_MEMORY_SCOPE_AGENT); }
__device__ __forceinline__ unsigned xb_add(gu32* p, unsigned v) { return __hip_atomic_fetch_add(p, v, __ATOMIC_RELAXED, __HIP_MEMORY_SCOPE_AGENT); }
__device__ __forceinline__ unsigned xb_xcc_id() { return (unsigned)__builtin_amdgcn_s_getreg((3 << 11) | 20) & 0xFu; }
#define XB_SPIN(cond, bar) do { unsigned _sp = 0; while (cond) { __builtin_amdgcn_s_sleep(1); \
    if ((++_sp & 255u) == 0u) { if (xb_ld(&(bar)[XB_TMO])) break; if (_sp > XB_SPIN_CAP) { (void)xb_add(&(bar)[XB_TMO], 1u); break; } } } } while (0)
struct XcdBarrier { gu32* bar; unsigned x; volatile LAS unsigned* st; };
__device__ __forceinline__ XcdBarrier xcd_barrier_post(gu32* bar, volatile LAS unsigned* st, bool leader) {
    XcdBarrier b; b.bar = bar; b.x = xb_xcc_id(); b.st = st;
    if (leader) (void)xb_add(&bar[XB_XCNT(b.x)], 1u);
    return b;
}
__device__ __forceinline__ void xcd_barrier_complete(gu32* bar, unsigned x, unsigned& nloc, unsigned& nx) {
    const unsigned G = gridDim.x * gridDim.y * gridDim.z;
    unsigned sum, cnt, mine, sp = 0u;
    for (;;) {
        sum = 0u; cnt = 0u; mine = 0u;
#pragma unroll
        for (unsigned j = 0; j < 16; ++j) { const unsigned c = xb_ld(&bar[XB_XCNT(j)]); sum += c; cnt += (c > 0u) ? 1u : 0u; mine = (j == x) ? c : mine; }
        if (sum == G) break;
        __builtin_amdgcn_s_sleep(1);
        if ((++sp & 255u) == 0u) { if (xb_ld(&bar[XB_TMO])) break; if (sp > XB_SPIN_CAP) { (void)xb_add(&bar[XB_TMO], 1u); break; } }
    }
    nloc = mine > 0u ? mine : 1u; nx = cnt > 0u ? cnt : 1u;
}
__device__ __forceinline__ void xcd_barrier(const XcdBarrier& b, bool leader) {
    asm volatile("s_waitcnt vmcnt(0)" ::: "memory");
    __syncthreads();
    if (leader) {
        gu32* bar = b.bar; asm volatile("" : "+s"(bar));
        __builtin_amdgcn_s_waitcnt(0);
        unsigned nloc = b.st[0], nx = b.st[1];
        if (nloc == 0u) { xcd_barrier_complete(bar, b.x, nloc, nx); b.st[0] = nloc; b.st[1] = nx; }
        const unsigned old = xb_add(&bar[XB_XSUB(b.x)], 1u);
        const unsigned gen = old / nloc;
        if (old + 1u == (gen + 1u) * nloc) {
            __builtin_amdgcn_fence(__ATOMIC_RELEASE, "agent");
            asm volatile("s_waitcnt vmcnt(0)" ::: "memory");
            const unsigned og = xb_add(&bar[XB_TOP], 1u);
            const unsigned tg = og / nx;
            if (og + 1u == (tg + 1u) * nx) xb_add(&bar[XB_TOPGEN], 1u);
            else XB_SPIN(xb_ld(&bar[XB_TOPGEN]) == tg, bar);
            __builtin_amdgcn_fence(__ATOMIC_ACQUIRE, "agent");
            xb_add(&bar[XB_XGEN(b.x)], 1u);
            asm volatile("s_waitcnt vmcnt(0)" ::: "memory");
        } else {
            XB_SPIN(xb_ld(&bar[XB_XGEN(b.x)]) == gen, bar);
            __builtin_amdgcn_fence(__ATOMIC_ACQUIRE, "agent");
            asm volatile("s_waitcnt vmcnt(0)" ::: "memory");
        }
    }
    __syncthreads();
}

struct Args { const float* in[16]; float* out; unsigned char* ws; int ph_lo, ph_hi; };
enum { I_X = 0, I_WIN, I_UK, I_UV, I_SINK, I_WBR, I_WO, I_LN1G, I_LN1B, I_RW, I_RB, I_MG, I_MU, I_MD, I_LN2G, I_LN2B };

typedef GAS unsigned char gbyte;
struct Frame {
    LAS unsigned char* lds;
    gbyte* wsg;
    GAS const float* ing[16];
    GAS float* outg;
    int tid, lane, wave, vcu, G;
};
#define F_WS ((unsigned char*)F.wsg)
#define F_IN(i) ((const float*)F.ing[i])
#define F_OUT ((float*)F.outg)

template <class F>
__device__ __forceinline__ void transpose_item(bf16* WT, int ldk, int row0, int k0, LAS float* scr, int lane, const F& val) {
    float tv[32];
#pragma unroll
    for (int i = 0; i < 32; ++i) tv[i] = val(k0 + 2 * i + (lane >> 5), row0 + (lane & 31));
#pragma unroll
    for (int i = 0; i < 32; ++i) scr[(2 * i + (lane >> 5)) * 33 + (lane & 31)] = tv[i];
    LDS_WAIT(); asm volatile("" ::: "memory");
    const int c = lane & 7;
#pragma unroll
    for (int j = 0; j < 4; ++j) { const int n = (lane >> 3) + 8 * j; const LAS float* s = scr + (8 * c) * 33 + n;
        v4u o; o.x = pk2(s[0 * 33], s[1 * 33]); o.y = pk2(s[2 * 33], s[3 * 33]); o.z = pk2(s[4 * 33], s[5 * 33]); o.w = pk2(s[6 * 33], s[7 * 33]);
        *(GAS v4u*)(WT + (size_t)(row0 + n) * ldk + k0 + 8 * c) = o; }
    LDS_WAIT(); asm volatile("" ::: "memory");
}
__device__ __forceinline__ int rope_dim(int p) { return (p >> 1) + 32 * (p & 1); }

__device__ __forceinline__ int win_src(int s) {
    const int tile = s >> 8, u = s & 255;
    switch (tile) {
        case 0: return C_AQ + (u & ~63) + rope_dim(u & 63);
        case 1: return C_IQ + (u & ~63) + rope_dim(u & 63);
        case 2: if (u < 64) return -2 - rope_dim(u); if (u < 128) return -100 - (u - 64); if (u < 192) return C_IK + rope_dim(u - 128); if (u < 196) return C_IW + (u - 192); return -1;
        case 3: return C_BQ + (u & ~63) + rope_dim(u & 63);
        case 4: return C_BK + (u & ~63) + rope_dim(u & 63);
        case 5: return C_BV + u;
        case 6: return C_CQ + (u & ~63) + rope_dim(u & 63);
        case 7: return C_CQ + 256 + (u & ~63) + rope_dim(u & 63);
        case 8: if (u < 128) return C_CK + (u & ~63) + rope_dim(u & 63); return C_CV + (u - 128);
        default: return C_G + (s - 2304);
    }
}

__device__ __forceinline__ void phase_prologue_a(Frame& F) {
    const int gw = F.vcu * NWAVES + F.wave, NGW = F.G * NWAVES;
    {
        float* WFp = (float*)(F_WS + WS_WF);
        for (int i = gw * 64 + F.lane; i < DEPTH * 1024 * 128; i += NGW * 64) {
            const int l = i >> 17, k = (i >> 7) & 1023, c = i & 127;
            const float* W = F_IN(I_WIN) + (size_t)l * D * N_IN + (size_t)k * N_IN + C_AC;
            const float* U = (c < 64 ? F_IN(I_UK) : F_IN(I_UV)) + (size_t)l * 128 * 64 + (c & 63);
            float a = 0.f;
#pragma unroll 8
            for (int r = 0; r < 128; ++r) a = fmaf(W[r], U[r * 64], a);
            WFp[i] = a;
        }
    }
    {
        float* COS = (float*)(F_WS + WS_ROPE); float* SIN = COS + SEQ * 32;
        for (int i = gw * 64 + F.lane; i < SEQ * 32; i += NGW * 64) {
            const int pos = i >> 5, j = i & 31;
            const float inv = 1.0f / (float)pow(10000.0, (double)(2 * j) / 64.0);
            const float ang = (float)pos * inv;
            COS[i] = (float)cos((double)ang); SIN[i] = (float)sin((double)ang);
        }
    }
    {
        const f32x4* x4 = (const f32x4*)F_IN(I_X); v2u* xb = (v2u*)(F_WS + WS_XB);
        for (size_t i = (size_t)gw * 64 + F.lane; i < (size_t)T * D / 4; i += (size_t)NGW * 64) { const f32x4 v = x4[i]; v2u o; o.x = pk2(v.x, v.y); o.y = pk2(v.z, v.w); xb[i] = o; }
    }
}
__device__ __forceinline__ void phase_prologue(Frame& F) {
    LAS float* scr = (LAS float*)(F.lds + F.wave * 16384);
    const int gw = F.vcu * NWAVES + F.wave, NGW = F.G * NWAVES;
    constexpr int I_WINL = (N_INP / 32) * (D / 64);
    constexpr int I_BRL = (1024 / 32) * (1024 / 64);
    constexpr int I_WOL = (1024 / 32) * (1024 / 64);
    constexpr int NITEMS = DEPTH * (I_WINL + I_BRL + I_WOL);
    for (int it = gw; it < NITEMS; it += NGW) {
        int r = it; const int l = r / (I_WINL + I_BRL + I_WOL); r -= l * (I_WINL + I_BRL + I_WOL);
        if (r < I_WINL) {
            const float* W = F_IN(I_WIN) + (size_t)l * D * N_IN; const float* WFp = (const float*)(F_WS + WS_WF);
            bf16* WT = (bf16*)(F_WS + WS_WIN) + (size_t)l * N_INP * D;
            const int rg = r / 16, kc = r % 16;
            const int c = win_src(rg * 32 + (F.lane & 31));
            const int cc = (c > -100) ? (-2 - c) : (64 + (-100 - c));
            const float* sb = (c >= 0) ? (W + c) : (WFp + (size_t)l * 1024 * 128 + (c == -1 ? 0 : cc));
            const long sst = (c >= 0) ? (long)N_IN : 128L; const float sm = (c == -1) ? 0.f : 1.f;
            transpose_item(WT, D, rg * 32, kc * 64, scr, F.lane, [&](int k, int row) -> float { return sb[(size_t)k * sst] * sm; });
            continue; }
        r -= I_WINL;
        if (r < I_BRL) {
            const float* W = F_IN(I_WBR) + (size_t)l * 1024 * 1024; bf16* WT = (bf16*)(F_WS + WS_WBR) + (size_t)l * 1024 * 1024;
            const int rg = r / 16, kc = r % 16;
            transpose_item(WT, 1024, rg * 32, kc * 64, scr, F.lane, [&](int k, int row) -> float { return W[(size_t)k * 1024 + row]; });
            continue; }
        r -= I_BRL;
        {
            const float* W = F_IN(I_WO) + (size_t)l * 1024 * 1024; bf16* WT = (bf16*)(F_WS + WS_WO) + (size_t)l * 1024 * 1024;
            const int rg = r / 16, kc = r % 16;
            transpose_item(WT, 1024, rg * 32, kc * 64, scr, F.lane, [&](int k, int row) -> float { return W[(size_t)k * 1024 + row]; });
        }
    }
}

__device__ __forceinline__ void convert_moe_weights(Frame& F, int l) {
    LAS float* scr = (LAS float*)(F.lds + F.wave * 16384);
    const int gw = F.vcu * NWAVES + F.wave, NGW = F.G * NWAVES;
    constexpr int I_GU = NEXP * (1024 / 32) * (1024 / 64);
    constexpr int I_D = NEXP * (1024 / 32) * (512 / 64);
    const float* WG = F_IN(I_MG) + (size_t)l * NEXP * D * DE; const float* WU = F_IN(I_MU) + (size_t)l * NEXP * D * DE; const float* WD = F_IN(I_MD) + (size_t)l * NEXP * DE * D;
    for (int it = gw; it < I_GU + I_D; it += NGW) {
        if (it < I_GU) {
            const int e = it / 512, r = it % 512, rg = r / 16, kc = r % 16;
            bf16* WT = (bf16*)(F_WS + WS_WGU) + (size_t)e * 1024 * 1024;
            const float* g = WG + (size_t)e * D * DE; const float* u = WU + (size_t)e * D * DE;
            transpose_item(WT, 1024, rg * 32, kc * 64, scr, F.lane, [&](int k, int row) -> float { const int j = 4 * (row >> 3) + (row & 3); return (row & 4) ? u[(size_t)k * DE + j] : g[(size_t)k * DE + j]; });
        } else {
            const int r0 = it - I_GU, e = r0 / 256, r = r0 % 256, rg = r / 8, kc = r % 8;
            bf16* WT = (bf16*)(F_WS + WS_WD) + (size_t)e * DE;
            const float* w = WD + (size_t)e * DE * D;
            transpose_item(WT, NEXP * DE, rg * 32, kc * 64, scr, F.lane, [&](int k, int row) -> float { return w[(size_t)k * D + row]; });
        }
    }
}

struct SchedDense {
    const char* A; const char* B; int lda, lda_b, ldb_b, nN, nt, G, vcu, ntiles;
    __device__ __forceinline__ bool next(int i, pg8::Unit& u) const {
        const int L = i * G + vcu; if (L >= ntiles) return false;
        const int per_grp = 8 * nN, grp = L / per_grp, w = L % per_grp, pn = w / 8, pm = grp * 8 + (w % 8);
        u.A = A + (size_t)pm * lda_b; u.B = B + (size_t)pn * ldb_b; u.rowlist = nullptr; u.nvalid = 256; u.lda = lda; u.nt = nt; u.ksplit = 1 << 30; u.bdelta = 0; u.p0 = pm; u.p1 = pn; u.p2 = 0; u.p3 = 0; return true;
    }
};

template <int EMODE = 0> struct EpiInProjT {
    static constexpr bool PERM = true;
    static __device__ __forceinline__ bool keep_acc(const pg8::Unit&) { return false; }
    unsigned char* ws;
    __device__ __forceinline__ void operator()(const f32x4 (&acc)[2][2][4][2], const pg8::Unit& u, int wr, int wc, int fr, int fq) const {
        const int pm = u.p0, pn = u.p1;
        const float* COS = (const float*)(ws + WS_ROPE); const float* SIN = COS + SEQ * 32;
        const int row0 = pm * 256 + wr * 64 + fr;
        float ksum[2][8];
#pragma unroll
        for (int bj = 0; bj < 2; ++bj)
#pragma unroll
            for (int e = 0; e < 8; ++e) ksum[bj][e] = 0.f;
        f32x4 rcs[2][4], rsn[2][4];
        if (pn <= 8) {
            const int j0 = ((wc * 32 + 8 * fq) & 63) >> 1;
#pragma unroll
            for (int ai = 0; ai < 2; ++ai)
#pragma unroll
                for (int m = 0; m < 4; ++m) { const int pos = (row0 + ai * 128 + m * 16) & (SEQ - 1); rcs[ai][m] = *(const f32x4*)(COS + pos * 32 + j0); rsn[ai][m] = *(const f32x4*)(SIN + pos * 32 + j0); }
        }
#pragma unroll
        for (int ai = 0; ai < 2; ++ai)
#pragma unroll
            for (int m = 0; m < 4; ++m) {
                const int row = row0 + ai * 128 + m * 16; const int pos = row & (SEQ - 1);
#pragma unroll
                for (int bj = 0; bj < 2; ++bj) {
                    const int cl = bj * 128 + wc * 32 + 8 * fq;
                    float v[8];
#pragma unroll
                    for (int e = 0; e < 4; ++e) { v[e] = acc[ai][bj][m][0][e]; v[4 + e] = acc[ai][bj][m][1][e]; }
                    int kind;
                    unsigned char* obase; int pitch, ocol;
                    if (pn == 0) { kind = 1; obase = ws + WS_AQ; pitch = 256; ocol = cl; }
                    else if (pn == 1) { kind = 2; obase = ws + WS_IQ; pitch = 256; ocol = cl; }
                    else if (pn == 2) {
                        if (cl < 64) { kind = 1; obase = ws + WS_KAVA; pitch = 128; ocol = cl; }
                        else if (cl < 128) { kind = 0; obase = ws + WS_KAVA; pitch = 128; ocol = cl; }
                        else if (cl < 192) { kind = 2; obase = ws + WS_IK; pitch = 64; ocol = cl - 128; }
                        else if (cl == 192) { kind = 4; obase = ws + WS_IW; pitch = 4; ocol = 0; }
                        else { kind = 5; obase = ws; pitch = 0; ocol = 0; }
                    }
                    else if (pn == 3) { kind = 1; obase = ws + WS_BQ; pitch = 256; ocol = cl; }
                    else if (pn == 4) { kind = 1; obase = ws + WS_BK; pitch = 256; ocol = cl; }
                    else if (pn == 5) { kind = 0; obase = ws + WS_BV; pitch = 256; ocol = cl; }
                    else if (pn == 6) { kind = 1; obase = ws + WS_CQ; pitch = 512; ocol = cl; }
                    else if (pn == 7) { kind = 1; obase = ws + WS_CQ; pitch = 512; ocol = 256 + cl; }
                    else if (pn == 8) { kind = (cl < 128) ? 1 : 0; obase = ws + WS_CKV; pitch = 256; ocol = cl; }
                    else { kind = 3; obase = ws + WS_GATES; pitch = 3072; ocol = (pn - 9) * 256 + cl; }
                    if ((kind == 1 || kind == 2) && !(EMODE & 1)) {
                        const f32x4 cs = rcs[ai][m], sn = rsn[ai][m];
#pragma unroll
                        for (int e = 0; e < 4; ++e) { const float t1 = v[2 * e], t2 = v[2 * e + 1]; v[2 * e] = t1 * cs[e] - t2 * sn[e]; v[2 * e + 1] = t2 * cs[e] + t1 * sn[e]; }
                    }
                    if (kind == 3) {
                        unsigned q0 = 0u, q1 = 0u;
#pragma unroll
                        for (int e = 0; e < 4; ++e) {
                            q0 = __builtin_amdgcn_cvt_pk_u8_f32(__builtin_amdgcn_fmed3f(sigmoidf_(v[e]) * 255.0f, 1.0f, 255.0f), e, q0);
                            q1 = __builtin_amdgcn_cvt_pk_u8_f32(__builtin_amdgcn_fmed3f(sigmoidf_(v[4 + e]) * 255.0f, 1.0f, 255.0f), e, q1); }
                        *(v2u*)(obase + (size_t)row * pitch + ocol) = (v2u){q0, q1};
                    }
                    if (pn == 4) {
#pragma unroll
                        for (int e = 0; e < 8; ++e) ksum[bj][e] += v[e];
                    }
                    if (kind == 0 || kind == 1) {
                        v4u w; w.x = cvt_pk_bf16(v[0], v[1]); w.y = cvt_pk_bf16(v[2], v[3]); w.z = cvt_pk_bf16(v[4], v[5]); w.w = cvt_pk_bf16(v[6], v[7]);
                        if (pn == 4) *(v4u*)((bf16*)obase + bk_off(cl >> 6, row, (cl & 63) >> 3)) = w;
                        else *(v4u*)((bf16*)obase + (size_t)row * pitch + ocol) = w;
                    } else if (kind == 2) {
                        v4u w; w.x = pk2h(v[0], v[1]); w.y = pk2h(v[2], v[3]); w.z = pk2h(v[4], v[5]); w.w = pk2h(v[6], v[7]);
                        if (pn == 2) *(v4u*)((u16*)obase + ik_off(row, ocol >> 3)) = w;
                        else *(v4u*)((u16*)obase + (size_t)row * pitch + ocol) = w;
                    } else if (kind == 4) {
                        *(f32x4*)((float*)obase + (size_t)row * 4) = (f32x4){v[0], v[1], v[2], v[3]};
                    }
                }
            }
        if (pn == 4) {
            float* KMP = (float*)(ws + WS_KMP) + (size_t)(pm * 2 + wr) * 256;
#pragma unroll
            for (int bj = 0; bj < 2; ++bj)
#pragma unroll
                for (int e = 0; e < 8; ++e) { float s = ksum[bj][e]; s += xor_f<1>(s); s += xor_f<2>(s); s += xor_f<4>(s); s += xor_f<8>(s); ksum[bj][e] = s; }
            if (fr == 0) {
#pragma unroll
                for (int bj = 0; bj < 2; ++bj) { float* o = KMP + bj * 128 + wc * 32 + 8 * fq;
                    *(f32x4*)o = (f32x4){ksum[bj][0], ksum[bj][1], ksum[bj][2], ksum[bj][3]}; *(f32x4*)(o + 4) = (f32x4){ksum[bj][4], ksum[bj][5], ksum[bj][6], ksum[bj][7]}; }
            }
        }
    }
};

typedef EpiInProjT<0> EpiInProj;
struct EpiNone { static constexpr bool PERM = true; static __device__ __forceinline__ bool keep_acc(const pg8::Unit&) { return false; }
    float* sink; __device__ __forceinline__ void operator()(const f32x4 (&acc)[2][2][4][2], const pg8::Unit& u, int wr, int wc, int fr, int fq) const { float s = 0.f;
#pragma unroll
        for (int a = 0; a < 2; ++a)
#pragma unroll
            for (int b = 0; b < 2; ++b)
#pragma unroll
                for (int m = 0; m < 4; ++m)
#pragma unroll
                    for (int n = 0; n < 2; ++n) s += (acc[a][b][m][n][0] + acc[a][b][m][n][1]) + (acc[a][b][m][n][2] + acc[a][b][m][n][3]);
        if (s == 1.2345e-30f) sink[0] = 1.f; } };
__device__ __forceinline__ void phase_inproj_probe(Frame& F, int l) {
    SchedDense S; S.A = (const char*)(F_WS + WS_XB); S.B = (const char*)(F_WS + WS_WIN) + (size_t)l * N_INP * D * 2; S.lda = D; S.lda_b = 256 * D * 2; S.ldb_b = 256 * D * 2; S.nN = N_INP / 256; S.nt = D / 64; S.G = F.G; S.vcu = F.vcu; S.ntiles = (T / 256) * (N_INP / 256);
    EpiNone E{(float*)(F_WS + WS_CTL) + 8};
    pg8::gemm_phase<EpiNone, SchedDense, true>(F.lds, F.tid, D, S, E);
}
template <int EMODE> __device__ __forceinline__ void phase_inproj_mode(Frame& F, int l) {
    SchedDense S; S.A = (const char*)(F_WS + WS_XB); S.B = (const char*)(F_WS + WS_WIN) + (size_t)l * N_INP * D * 2; S.lda = D; S.lda_b = 256 * D * 2; S.ldb_b = 256 * D * 2; S.nN = N_INP / 256; S.nt = D / 64; S.G = F.G; S.vcu = F.vcu; S.ntiles = (T / 256) * (N_INP / 256);
    EpiInProjT<EMODE> E{F_WS};
    pg8::gemm_phase<EpiInProjT<EMODE>, SchedDense, true>(F.lds, F.tid, D, S, E);
}
__device__ __forceinline__ void phase_inproj(Frame& F, int l) {
    SchedDense S; S.A = (const char*)(F_WS + WS_XB); S.B = (const char*)(F_WS + WS_WIN) + (size_t)l * N_INP * D * 2; S.lda = D; S.lda_b = 256 * D * 2; S.ldb_b = 256 * D * 2; S.nN = N_INP / 256; S.nt = D / 64; S.G = F.G; S.vcu = F.vcu; S.ntiles = (T / 256) * (N_INP / 256);
    EpiInProj E{F_WS};
    pg8::gemm_phase<EpiInProj, SchedDense, true>(F.lds, F.tid, D, S, E);
}

constexpr int KROW = 144;
struct FlashState { float m, l; f32x16 o0, o1; };
__device__ __forceinline__ s16x4 tr_read(unsigned addr) { s16x4 r; asm volatile("ds_read_b64_tr_b16 %0, %1" : "=v"(r) : "v"(addr) : "memory"); return r; }
__device__ __forceinline__ void flash_core(FlashState& st, const bf16x8 (&qf)[4], const bf16x8 (&kfr)[4], unsigned Vt, unsigned vmask, int lane);
__device__ __forceinline__ void flash_tile(FlashState& st, const bf16x8 (&qf)[4], unsigned Kt, unsigned Vt, unsigned vmask, int lane) {
    const int r32 = lane & 31, half = lane >> 5;
    bf16x8 kfr[4];
#pragma unroll
    for (int ks = 0; ks < 4; ++ks) kfr[ks] = *(const LAS bf16x8*)(uintptr_t)(Kt + r32 * KROW + (16 * ks + 8 * half) * 2);
    flash_core(st, qf, kfr, Vt, vmask, lane);
}
__device__ __forceinline__ void flash_core(FlashState& st, const bf16x8 (&qf)[4], const bf16x8 (&kfr)[4], unsigned Vt, unsigned vmask, int lane) {
    const int half = lane >> 5;
    f32x16 s = {};
#pragma unroll
    for (int ks = 0; ks < 4; ++ks) s = __builtin_amdgcn_mfma_f32_32x32x16_bf16(kfr[ks], qf[ks], s, 0, 0, 0);
    const bool full = __ballot(vmask != 0xffffu) == 0ull;
    float mx = -1e30f;
    if (full) {
#pragma unroll
        for (int i = 0; i < 16; ++i) mx = fmaxf(mx, s[i]);
        mx *= SM_C;
    } else {
#pragma unroll
        for (int i = 0; i < 16; ++i) { const float v = ((vmask >> i) & 1u) ? s[i] : -1e30f; mx = fmaxf(mx, v); }
        mx = fmaxf(mx * SM_C, -1e30f);
    }
    mx = half_max(mx);
    const float mn = fmaxf(st.m, mx), alpha = __builtin_amdgcn_exp2f(st.m - mn);
    float ls = 0.f; float p[16];
    if (full) {
#pragma unroll
        for (int i = 0; i < 16; ++i) { p[i] = __builtin_amdgcn_exp2f(fmaf(s[i], SM_C, -mn)); ls += p[i]; }
    } else {
#pragma unroll
        for (int i = 0; i < 16; ++i) { p[i] = ((vmask >> i) & 1u) ? __builtin_amdgcn_exp2f(fmaf(s[i], SM_C, -mn)) : 0.f; ls += p[i]; }
    }
    st.l = st.l * alpha + ls; st.m = mn;
    if (__ballot(alpha != 1.0f) != 0ull) {
#pragma unroll
        for (int i = 0; i < 16; ++i) { st.o0[i] *= alpha; st.o1[i] *= alpha; }
    }
#pragma unroll
    for (int sx = 0; sx < 2; ++sx) {
        v4u pw; pw.x = cvt_pk_bf16(p[8 * sx + 0], p[8 * sx + 1]); pw.y = cvt_pk_bf16(p[8 * sx + 2], p[8 * sx + 3]); pw.z = cvt_pk_bf16(p[8 * sx + 4], p[8 * sx + 5]); pw.w = cvt_pk_bf16(p[8 * sx + 6], p[8 * sx + 7]);
        const bf16x8 pf = __builtin_bit_cast(bf16x8, pw);
        const int g = lane >> 4, i16 = lane & 15, q_ = i16 >> 2, pp = i16 & 3;
#pragma unroll
        for (int dt = 0; dt < 2; ++dt) {
            const unsigned a0 = Vt + (16 * sx + 4 * (g >> 1) + q_) * KROW + (32 * dt + 16 * (g & 1) + 4 * pp) * 2;
            s16x4 lo = tr_read(a0), hi = tr_read(a0 + 8 * KROW);
            asm volatile("s_waitcnt lgkmcnt(0)" : "+v"(lo), "+v"(hi) :: "memory");
            const bf16x8 vf = (bf16x8){lo[0], lo[1], lo[2], lo[3], hi[0], hi[1], hi[2], hi[3]};
            if (dt == 0) st.o0 = __builtin_amdgcn_mfma_f32_32x32x16_bf16(vf, pf, st.o0, 0, 0, 0);
            else st.o1 = __builtin_amdgcn_mfma_f32_32x32x16_bf16(vf, pf, st.o1, 0, 0, 0);
        }
    }
}
__device__ __forceinline__ void flash_store(const FlashState& st, float scale, bf16* orow, int lane) {
    const int half = lane >> 5;
#pragma unroll
    for (int dt = 0; dt < 2; ++dt)
#pragma unroll
        for (int g = 0; g < 4; ++g) {
            const f32x16& o = dt ? st.o1 : st.o0;
            v2u w; w.x = cvt_pk_bf16(o[4 * g] * scale, o[4 * g + 1] * scale); w.y = cvt_pk_bf16(o[4 * g + 2] * scale, o[4 * g + 3] * scale);
            *(v2u*)(orow + 32 * dt + 8 * g + 4 * half) = w;
        }
}
__device__ __forceinline__ void stage_rows(LAS unsigned char* dst, const bf16* src, long pitch, int first_valid, int tid) {
#pragma unroll
    for (int i = 0; i < 4; ++i) { const int pid = tid + 512 * i, r = pid >> 3, pc = pid & 7;
        v4u v = (v4u){0u, 0u, 0u, 0u};
        if (r >= first_valid) v = *(const v4u*)(src + (long)r * pitch + pc * 8);
        *(LAS v4u*)(dst + r * KROW + pc * 16) = v; }
}

__device__ __forceinline__ void moba_unit(Frame& F, int b, int h, int c) {
    LAS unsigned char* KS = F.lds; LAS unsigned char* VS = F.lds + 256 * KROW; LAS float* KM = (LAS float*)(F.lds + 2 * 256 * KROW);
    const int lane = F.lane, w = F.wave, r32 = lane & 31, half = lane >> 5;
    const long rowbase = (long)b * SEQ;
    bf16* BQ = (bf16*)(F_WS + WS_BQ); const bf16* BKp = (const bf16*)(F_WS + WS_BK); const bf16* BVp = (const bf16*)(F_WS + WS_BV);
    const float* KMP = (const float*)(F_WS + WS_KMP);
    __syncthreads();
    for (int i = F.tid; i < c * 64; i += NTHR) { const int n = i >> 6, d = i & 63; const float* p0 = KMP + (size_t)((b * 32 + n) * 2) * 256 + h * 64 + d; KM[i] = (p0[0] + p0[256]) * (1.0f / 256.0f); }
    const int tq = 256 * c + 32 * w + r32;
    const bf16* qrow = BQ + (rowbase + tq) * 256 + h * 64;
    bf16x8 qf[4];
#pragma unroll
    for (int ks = 0; ks < 4; ++ks) qf[ks] = *(const bf16x8*)(qrow + 16 * ks + 8 * half);
    __syncthreads();
    unsigned selmask = 0u;
    {
        v4u qp[8];
#pragma unroll
        for (int i = 0; i < 8; ++i) qp[i] = *(const v4u*)(qrow + 8 * i);
        float v1 = -INFINITY, v2 = -INFINITY, v3 = -INFINITY; int i1 = -1, i2 = -1, i3 = -1;
        for (int n = 0; n < c; ++n) {
            float a = 0.f;
#pragma unroll
            for (int i = 0; i < 8; ++i) {
                const f32x4 k0 = *(const LAS f32x4*)(KM + n * 64 + 8 * i), k1 = *(const LAS f32x4*)(KM + n * 64 + 8 * i + 4);
                a = fmaf(bflo(qp[i].x), k0[0], a); a = fmaf(bfhi(qp[i].x), k0[1], a); a = fmaf(bflo(qp[i].y), k0[2], a); a = fmaf(bfhi(qp[i].y), k0[3], a);
                a = fmaf(bflo(qp[i].z), k1[0], a); a = fmaf(bfhi(qp[i].z), k1[1], a); a = fmaf(bflo(qp[i].w), k1[2], a); a = fmaf(bfhi(qp[i].w), k1[3], a);
            }
            if (a > v1) { v3 = v2; i3 = i2; v2 = v1; i2 = i1; v1 = a; i1 = n; }
            else if (a > v2) { v3 = v2; i3 = i2; v2 = a; i2 = n; }
            else if (a > v3) { v3 = a; i3 = n; }
        }
        if (i1 >= 0) selmask |= 1u << i1; if (i2 >= 0) selmask |= 1u << i2; if (i3 >= 0) selmask |= 1u << i3;
    }
    FlashState st; st.m = -1e30f; st.l = 0.f; st.o0 = (f32x16){}; st.o1 = (f32x16){};
    const unsigned KSa = (unsigned)(uintptr_t)KS, VSa = (unsigned)(uintptr_t)VS;
    for (int n = 0; n <= c; ++n) {
        __syncthreads();
        stage_rows(KS, BKp + (rowbase + 256 * n) * 256 + h * 64, 256, 0, F.tid);
        stage_rows(VS, BVp + (rowbase + 256 * n) * 256 + h * 64, 256, 0, F.tid);
        __syncthreads();
        const bool own = (n == c);
        const bool mine = own || ((selmask >> n) & 1u);
        if (__ballot(mine) == 0ull) continue;
        const int ktmax = own ? w : 7;
        for (int kt = 0; kt <= ktmax; ++kt) {
            unsigned vm = 0u;
            if (mine) {
                if (!own || kt < w) vm = 0xffffu;
                else {
#pragma unroll
                    for (int i = 0; i < 16; ++i) { const int kl = (i & 3) + 8 * (i >> 2) + 4 * half; if (kl <= r32) vm |= 1u << i; }
                }
            }
            flash_tile(st, qf, KSa + kt * 32 * KROW, VSa + kt * 32 * KROW, vm, lane);
        }
    }
    const float lt = half_sum(st.l);
    flash_store(st, 1.0f / lt, BQ + (rowbase + tq) * 256 + h * 64, lane);
}


constexpr int MB_ST = 0, MB_VST = 73728, MB_KM = 110592, MB_SELB = 118784, MB_ITQ = 119808  , MB_ITB = 126720  , MB_NIT = 126944;
constexpr int MB_STW = 36;
__device__ __forceinline__ void moba_item(Frame& F, FlashState& st, const bf16x8 (&qf)[4], const bf16* Kt, int hh, long krow0, const bf16* Vg, int ktiles, int lane, int w, unsigned vm_full, bool causal, int qloc) {
    const int r32 = lane & 31, half = lane >> 5;
    LAS unsigned char* VT = F.lds + MB_VST + w * (32 * KROW);
    const unsigned VTa = (unsigned)(uintptr_t)VT;
    bf16x8 kc[4], kn[4], kf2[4]; v4u vc[4], vn[4], vf2[4];
    const bf16* kp = Kt + bk_off(hh, krow0 + r32, half);
    const bf16* vpa = Vg + (long)((lane >> 3) + 8) * 256 + 8 * (lane & 7); const bf16* vpb = vpa + 16 * 256;
#define MB_LD(kd, vd, kt_) do { const int kq_ = min((kt_), ktiles - 1); const bf16* kq = kp + (long)kq_ * 2048; \
        _Pragma("unroll") for (int ks = 0; ks < 4; ++ks) kd[ks] = *(const bf16x8*)(kq + ks * 512); \
        const bf16* va_ = vpa + (long)kq_ * 8192; const bf16* vb_ = vpb + (long)kq_ * 8192; \
        vd[0] = *(const v4u*)(va_ - 2048); vd[1] = *(const v4u*)va_; vd[2] = *(const v4u*)(vb_ - 2048); vd[3] = *(const v4u*)vb_; } while (0)
#define MB_PIN() asm volatile("" ::: "memory")
#define MB_STEP(kd, vd, kt_) do { \
        _Pragma("unroll") for (int i = 0; i < 4; ++i) { const int p = lane + 64 * i; *(LAS v4u*)(VT + (p >> 3) * KROW + 16 * (p & 7)) = vd[i]; } \
        LDS_WAIT(); \
        unsigned vm = vm_full; \
        if (causal && (kt_) == ktiles - 1) { vm = 0u;                  \
            _Pragma("unroll") for (int g = 0; g < 4; ++g) { const int nb = min(max(qloc - 4 * half - 8 * g + 1, 0), 4); vm |= ((1u << nb) - 1u) << (4 * g); } \
            vm &= vm_full; } \
        flash_core(st, qf, kd, VTa, vm, lane); } while (0)
    MB_LD(kc, vc, 0); MB_PIN(); MB_LD(kn, vn, 1); MB_PIN(); MB_LD(kf2, vf2, 2); MB_PIN();
    for (int kt = 0; kt < ktiles; kt += 3) {
        MB_STEP(kc, vc, kt);
        MB_PIN(); MB_LD(kc, vc, kt + 3); MB_PIN();
        if (kt + 1 < ktiles) MB_STEP(kn, vn, kt + 1);
        MB_PIN(); MB_LD(kn, vn, kt + 4); MB_PIN();
        if (kt + 2 < ktiles) MB_STEP(kf2, vf2, kt + 2);
        MB_PIN(); MB_LD(kf2, vf2, kt + 5); MB_PIN();
    }
#undef MB_STEP
#undef MB_PIN
#undef MB_LD
}
__device__ __forceinline__ void moba_unit2(Frame& F, int b, int h, int c) {
    int lane_ = F.lane; asm volatile("" : "+v"(lane_));
    const int lane = lane_, w = F.wave, r32 = lane & 31, half = lane >> 5;
    const long rowbase = (long)b * SEQ;
    bf16* BQ = (bf16*)(F_WS + WS_BQ); const bf16* BKt = (const bf16*)(F_WS + WS_BK); const bf16* BVp = (const bf16*)(F_WS + WS_BV) + rowbase * 256 + h * 64;
    const float* KMP = (const float*)(F_WS + WS_KMP);
    LAS float* ST = (LAS float*)(F.lds + MB_ST); LAS float* KM = (LAS float*)(F.lds + MB_KM);
    LAS unsigned char* SELB = F.lds + MB_SELB; LAS unsigned char* ITQ = F.lds + MB_ITQ; LAS unsigned char* ITB = F.lds + MB_ITB; LAS int* NIT = (LAS int*)(F.lds + MB_NIT);
    __syncthreads();
    for (int i = F.tid; i < c * 64; i += NTHR) { const int n = i >> 6, d = i & 63; const float* p0 = KMP + (size_t)((b * 32 + n) * 2) * 256 + h * 64 + d; KM[i] = (p0[0] + p0[256]) * (1.0f / 256.0f); }
    for (int i = F.tid; i < 256 * 2 * MB_STW; i += NTHR) { const int f = i % MB_STW; ST[i] = (f == 32) ? -1e30f : 0.f; }
    __syncthreads();
    {
        const int tq = 256 * c + 32 * w + r32;
        const bf16* qrow = BQ + (rowbase + tq) * 256 + h * 64;
        v4u qp[8];
#pragma unroll
        for (int i = 0; i < 8; ++i) qp[i] = *(const v4u*)(qrow + 8 * i);
        float v1 = -INFINITY, v2 = -INFINITY, v3 = -INFINITY; int i1 = -1, i2 = -1, i3 = -1;
        for (int n = 0; n < c; ++n) {
            float a = 0.f;
#pragma unroll
            for (int i = 0; i < 8; ++i) {
                const f32x4 k0 = *(const LAS f32x4*)(KM + n * 64 + 8 * i), k1 = *(const LAS f32x4*)(KM + n * 64 + 8 * i + 4);
                a = fmaf(bflo(qp[i].x), k0[0], a); a = fmaf(bfhi(qp[i].x), k0[1], a); a = fmaf(bflo(qp[i].y), k0[2], a); a = fmaf(bfhi(qp[i].y), k0[3], a);
                a = fmaf(bflo(qp[i].z), k1[0], a); a = fmaf(bfhi(qp[i].z), k1[1], a); a = fmaf(bflo(qp[i].w), k1[2], a); a = fmaf(bfhi(qp[i].w), k1[3], a);
            }
            if (a > v1) { v3 = v2; i3 = i2; v2 = v1; i2 = i1; v1 = a; i1 = n; }
            else if (a > v2) { v3 = v2; i3 = i2; v2 = a; i2 = n; }
            else if (a > v3) { v3 = a; i3 = n; }
        }
        unsigned selmask = 0u;
        if (i1 >= 0) selmask |= 1u << i1; if (i2 >= 0) selmask |= 1u << i2; if (i3 >= 0) selmask |= 1u << i3;
        if (half == 0) { unsigned m = selmask; unsigned rec = 0u; int cnt = 0;
#pragma unroll
            for (int r = 0; r < 3; ++r) if (m) { const int n = __builtin_ctz(m); m &= m - 1u; rec |= (unsigned)n << (8 * r); ++cnt; }
            rec |= (unsigned)cnt << 24;
            *(LAS unsigned*)(SELB + 4 * (32 * w + r32)) = rec; }
    }
    __syncthreads();
    const unsigned long long lt_mask = (1ull << lane) - 1ull;
    if (w < 3) {
        const int r = w; LAS unsigned char* itq = ITQ + r * 2304; LAS unsigned char* itb = ITB + r * 72;
        unsigned rec[4];
#pragma unroll
        for (int ch = 0; ch < 4; ++ch) rec[ch] = *(const LAS unsigned*)(SELB + 4 * (64 * ch + lane));
        int nit = 0;
        for (int n = 0; n < c; ++n) {
            int pos = 0;
#pragma unroll
            for (int ch = 0; ch < 4; ++ch) {
                const bool hit = ((int)(rec[ch] >> 24) > r) && ((int)((rec[ch] >> (8 * r)) & 0xffu) == n);
                const unsigned long long bm = __ballot(hit);
                if (hit) { const int p = pos + __popcll(bm & lt_mask); itq[(nit + (p >> 5)) * 32 + (p & 31)] = (unsigned char)(64 * ch + lane); }
                pos += __popcll(bm);
            }
            const int ni = (pos + 31) >> 5;
            if (ni > 0) { const int tail = pos & 31; if (tail && lane >= tail && lane < 32) itq[(nit + ni - 1) * 32 + lane] = 0xffu;
                if (lane < ni) itb[nit + lane] = (unsigned char)n; }
            nit += ni;
        }
        if (lane == 0) NIT[r] = nit;
    }
    __syncthreads();
    for (int r = 0; r < 3; ++r) {
        LAS unsigned char* itq = ITQ + r * 2304; LAS unsigned char* itb = ITB + r * 72;
        const int nit = NIT[r];
        for (int it = w; it < nit; it += NWAVES) {
            const int n = itb[it]; const int q = itq[it * 32 + r32]; const bool valid = q != 0xff; const int qq = valid ? q : 0;
            const bf16* qrow = BQ + (rowbase + 256 * c + qq) * 256 + h * 64;
            bf16x8 qf[4];
#pragma unroll
            for (int ks = 0; ks < 4; ++ks) qf[ks] = *(const bf16x8*)(qrow + 16 * ks + 8 * half);
            FlashState st; LAS float* sp = ST + (qq * 2 + half) * MB_STW;
#pragma unroll
            for (int i = 0; i < 16; i += 4) { const f32x4 a = *(const LAS f32x4*)(sp + i), bq = *(const LAS f32x4*)(sp + 16 + i); st.o0[i] = a.x; st.o0[i + 1] = a.y; st.o0[i + 2] = a.z; st.o0[i + 3] = a.w; st.o1[i] = bq.x; st.o1[i + 1] = bq.y; st.o1[i + 2] = bq.z; st.o1[i + 3] = bq.w; }
            { const f32x2 ml = *(const LAS f32x2*)(sp + 32); st.m = ml.x; st.l = ml.y; }
            moba_item(F, st, qf, BKt, h, rowbase + 256 * n, BVp + (long)(256 * n) * 256, 8, lane, w, valid ? 0xffffu : 0u, false, 0);
            if (valid) {
#pragma unroll
                for (int i = 0; i < 16; i += 4) { *(LAS f32x4*)(sp + i) = (f32x4){st.o0[i], st.o0[i + 1], st.o0[i + 2], st.o0[i + 3]}; *(LAS f32x4*)(sp + 16 + i) = (f32x4){st.o1[i], st.o1[i + 1], st.o1[i + 2], st.o1[i + 3]}; }
                *(LAS f32x2*)(sp + 32) = (f32x2){st.m, st.l}; }
        }
        __syncthreads();
    }
    {
        const int qloc = 32 * w + r32; const int tq = 256 * c + qloc;
        bf16* qrow = BQ + (rowbase + tq) * 256 + h * 64;
        bf16x8 qf[4];
#pragma unroll
        for (int ks = 0; ks < 4; ++ks) qf[ks] = *(const bf16x8*)(qrow + 16 * ks + 8 * half);
        FlashState st; LAS float* sp = ST + (qloc * 2 + half) * MB_STW;
#pragma unroll
        for (int i = 0; i < 16; i += 4) { const f32x4 a = *(const LAS f32x4*)(sp + i), bq = *(const LAS f32x4*)(sp + 16 + i); st.o0[i] = a.x; st.o0[i + 1] = a.y; st.o0[i + 2] = a.z; st.o0[i + 3] = a.w; st.o1[i] = bq.x; st.o1[i + 1] = bq.y; st.o1[i + 2] = bq.z; st.o1[i + 3] = bq.w; }
        { const f32x2 ml = *(const LAS f32x2*)(sp + 32); st.m = ml.x; st.l = ml.y; }
        moba_item(F, st, qf, BKt, h, rowbase + 256 * c, BVp + (long)(256 * c) * 256, w + 1, lane, w, 0xffffu, true, r32);
        const float lt = half_sum(st.l);
        flash_store(st, 1.0f / lt, qrow, lane);
    }
}

__device__ __forceinline__ void swa_unit(Frame& F, int l, int b, int kvh, int nb) {
    LAS unsigned char* KS = F.lds; LAS unsigned char* VS = F.lds + 256 * KROW;
    const int lane = F.lane, w = F.wave, r32 = lane & 31, half = lane >> 5;
    const long rowbase = (long)b * SEQ;
    bf16* CQ = (bf16*)(F_WS + WS_CQ); const bf16* CKV = (const bf16*)(F_WS + WS_CKV);
    __syncthreads();
    const long band0 = rowbase + 128 * nb - 128;
    stage_rows(KS, CKV + band0 * 256 + kvh * 64, 256, nb == 0 ? 128 : 0, F.tid);
    stage_rows(VS, CKV + band0 * 256 + 128 + kvh * 64, 256, nb == 0 ? 128 : 0, F.tid);
    __syncthreads();
    const int hq = kvh * 4 + (w >> 1);
    const float zs = F_IN(I_SINK)[l * 8 + hq] * LOG2E;
    const unsigned KSa = (unsigned)(uintptr_t)KS, VSa = (unsigned)(uintptr_t)VS;
    for (int gi = 0; gi < 2; ++gi) {
        const int i0 = (w & 1) * 64 + 32 * gi, iq = i0 + r32;
        bf16* qrow = CQ + (rowbase + 128 * nb + iq) * 512 + hq * 64;
        bf16x8 qf[4];
#pragma unroll
        for (int ks = 0; ks < 4; ++ks) qf[ks] = *(const bf16x8*)(qrow + 16 * ks + 8 * half);
        FlashState st; st.m = -1e30f; st.l = 0.f; st.o0 = (f32x16){}; st.o1 = (f32x16){};
        const int kt0 = (i0 + 1) >> 5, kt1 = (i0 + 159) >> 5;
        for (int kt = kt0; kt <= kt1; ++kt) {
            unsigned vm = 0u;
#pragma unroll
            for (int i = 0; i < 16; ++i) { const int kk = kt * 32 + (i & 3) + 8 * (i >> 2) + 4 * half; const bool ok = (kk > iq) && (kk <= iq + 128) && (nb > 0 || kk >= 128); if (ok) vm |= 1u << i; }
            flash_tile(st, qf, KSa + kt * 32 * KROW, VSa + kt * 32 * KROW, vm, lane);
        }
        const float lt = half_sum(st.l);
        const float m2 = fmaxf(st.m, zs), f = __builtin_amdgcn_exp2f(st.m - m2);
        const float lf = lt * f + __builtin_amdgcn_exp2f(zs - m2);
        flash_store(st, f / lf, qrow, lane);
    }
}

constexpr int DSA_KEYS = 0, DSA_HIST = 131072, DSA_SEL = 139264, DSA_BIDX = 143360, DSA_BSC = 145408, DSA_IQ = 149504;
constexpr int DSA_TOPK = 256, DSA_BCAP = 128;
constexpr int DSA_ZC = 153600;
constexpr int DSA_NXT = 153632;
constexpr int CW_DSAQ = 200000;
constexpr int DSA_IWL = 153664;
constexpr int DSA_VROW = 144;
__device__ __forceinline__ unsigned sortable16(float s) { const unsigned b = (unsigned)__builtin_bit_cast(unsigned short, (_Float16)s); return (b ^ ((unsigned)((int)(b << 16) >> 31) | 0x8000u)) & 0xffffu; }
__device__ __forceinline__ float key_float(unsigned k16) { const unsigned b = (k16 & 0x8000u) ? (k16 ^ 0x8000u) : (~k16 & 0xffffu); return (float)__builtin_bit_cast(_Float16, (unsigned short)b); }
__device__ __forceinline__ int lin_bin(float sT, float inv, float c0) { return (int)__builtin_amdgcn_fmed3f(fmaf(sT, inv, c0), 0.f, 255.f); }
__device__ __forceinline__ int wave_prefix_incl(int v, int lane) {
    v += __builtin_amdgcn_update_dpp(0, v, 0x111, 0xf, 0xf, true); v += __builtin_amdgcn_update_dpp(0, v, 0x112, 0xf, 0xf, true);
    v += __builtin_amdgcn_update_dpp(0, v, 0x114, 0xf, 0xf, true); v += __builtin_amdgcn_update_dpp(0, v, 0x118, 0xf, 0xf, true);
    const int t0 = __builtin_amdgcn_readlane(v, 15), t1 = __builtin_amdgcn_readlane(v, 31), t2 = __builtin_amdgcn_readlane(v, 47);
    return v + (lane >= 48 ? t0 + t1 + t2 : (lane >= 32 ? t0 + t1 : (lane >= 16 ? t0 : 0)));
}
__device__ __forceinline__ unsigned pk_gt_flags(unsigned keys, unsigned t2, unsigned one2) { unsigned r; asm("v_pk_sub_u16 %0, %1, %2 clamp\n\tv_pk_min_u16 %0, %0, %3" : "=&v"(r) : "v"(keys), "v"(t2), "v"(one2)); return r; }
__device__ __forceinline__ unsigned pk_add16(unsigned a, unsigned b) { unsigned r; asm("v_pk_add_u16 %0, %1, %2" : "=v"(r) : "v"(a), "v"(b)); return r; }
__device__ __forceinline__ void find_bin(const LAS unsigned* hist, unsigned target, int lane, unsigned& bin, unsigned& above, unsigned& cnt) {
    const v4u hv = *(const LAS v4u*)(hist + 4 * lane);
    const unsigned tl = hv.x + hv.y + hv.z + hv.w;
    const int pin = wave_prefix_incl((int)tl, lane);
    const unsigned suf = (unsigned)(__builtin_amdgcn_readlane(pin, 63) - pin) + tl;
    const unsigned s4 = suf - tl;
    const unsigned S3 = s4 + hv.w, S2 = S3 + hv.z, S1 = S2 + hv.y, S0 = S1 + hv.x;
    int which = -1; unsigned ab = 0, cn = 0;
    if (S3 >= target && s4 < target) { which = 3; ab = s4; cn = hv.w; }
    else if (S2 >= target && S3 < target) { which = 2; ab = S3; cn = hv.z; }
    else if (S1 >= target && S2 < target) { which = 1; ab = S2; cn = hv.y; }
    else if (S0 >= target && S1 < target) { which = 0; ab = S1; cn = hv.x; }
    const unsigned long long bm = __ballot(which >= 0);
    const int src = bm ? (int)__builtin_ctzll(bm) : 0;
    bin = (unsigned)__builtin_amdgcn_readlane(4 * lane + which, src); above = __builtin_amdgcn_readlane(ab, src); cnt = __builtin_amdgcn_readlane(cn, src);
}
__device__ __forceinline__ void dsa_exact_boundary(const LAS u16* IQL, const u16* IKb, f32x4 wq, LAS u16* bidx, LAS float* bsc, LAS u16* sel, int nsel, int E, int need, int lane, unsigned long long lt_mask) {
    float sc[2]; int ki[2];
#pragma unroll
    for (int r = 0; r < 2; ++r) { const int e = lane + 64 * r; sc[r] = -INFINITY; ki[r] = 0x7fffffff;
        if (e < E) { const int key = bidx[e]; ki[r] = key; float s = 0.f;
            for (int hd = 0; hd < 4; ++hd) { float a = 0.f;
                for (int d = 0; d < 64; d += 8) { const f16x8 kv = *(const f16x8*)(IKb + ik_off(key, d >> 3)); const f16x8 qv = *(const LAS f16x8*)(IQL + hd * 64 + d);
#pragma unroll
                    for (int x = 0; x < 8; ++x) a = fmaf((float)qv[x], (float)kv[x], a); }
                s = fmaf(wq[hd], fmaxf(a, 0.f), s); }
            sc[r] = s; bsc[e] = s; } }
    LDS_WAIT();
#pragma unroll
    for (int r = 0; r < 2; ++r) { const int e = lane + 64 * r; int rank = 0;
        if (e < E) { for (int o = 0; o < E; ++o) { const float so = bsc[o]; const int io = bidx[o]; rank += (so > sc[r] || (so == sc[r] && io < ki[r])) ? 1 : 0; } }
        const bool take = (e < E) && rank < need;
        const unsigned long long tm = __ballot(take);
        if (take) sel[nsel + __popcll(tm & lt_mask)] = (u16)ki[r];
        nsel += __popcll(tm); }
}
__device__ __forceinline__ int dsa_rescore_select(LAS unsigned char* lds, const u16* IKb, f32x4 wq, LAS u16* bidx, LAS float* bsc, LAS u16* sel, int nsel, int En, int need_eq, int lane, int w, unsigned long long lt_mask, int dpe) {
    const int r32 = lane & 31, half = lane >> 5;
    f16x8 aop[4];
    { const int q = r32 >> 2, hd = r32 & 3; const LAS u16* pl = (const LAS u16*)(lds + DSA_IQ) + q * 256 + hd * 64 + 8 * half;
#pragma unroll
      for (int ks = 0; ks < 4; ++ks) aop[ks] = *(const LAS f16x8*)(pl + 16 * ks); }
    for (int r0 = 0; r0 < En; r0 += 32) {
        const int c = r0 + r32; const int key = (c < En) ? (int)bidx[c] : 0;
        f32x16 dacc = {};
#pragma unroll
        for (int ks = 0; ks < 4; ++ks) { const f16x8 bop = *(const f16x8*)(IKb + ik_off(key, 2 * ks + half)); dacc = __builtin_amdgcn_mfma_f32_32x32x16_f16(aop[ks], bop, dacc, 0, 0, 0); }
        const int g = w >> 1; float s = 0.f;
#pragma unroll
        for (int hd = 0; hd < 4; ++hd) { const float dv = g == 0 ? dacc[hd] : (g == 1 ? dacc[4 + hd] : (g == 2 ? dacc[8 + hd] : dacc[12 + hd])); s = fmaf(wq[hd], fmaxf(dv, 0.f), s); }
        if (half == (w & 1) && c < En) bsc[c] = s;
    }
    LDS_WAIT();
    {
        const bool v0 = lane < En, v1 = lane + 64 < En;
        unsigned k0 = 0u, k1 = 0u; int i0 = 0, i1 = 0;
        { const int e0 = v0 ? lane : 0, e1 = v1 ? lane + 64 : 0;
          unsigned u0 = __builtin_bit_cast(unsigned, bsc[e0]), u1 = __builtin_bit_cast(unsigned, bsc[e1]); i0 = (int)bidx[e0]; i1 = (int)bidx[e1];
          u0 ^= (unsigned)((int)u0 >> 31) | 0x80000000u; u1 ^= (unsigned)((int)u1 >> 31) | 0x80000000u; k0 = u0; k1 = u1; }
        unsigned prefix = 0u; int remaining = need_eq;
#pragma unroll 4
        for (int bit = 31; bit >= 0; --bit) {
            const unsigned test = prefix | (1u << bit), hm = ~((1u << bit) - 1u);
            const int c = __popcll(__ballot(v0 && (k0 & hm) == test)) + __popcll(__ballot(v1 && (k1 & hm) == test));
            if (c >= remaining) prefix = test; else remaining -= c;
        }
        const bool t0 = v0 && k0 == prefix, t1 = v1 && k1 == prefix;
        bool take0 = v0 && k0 > prefix, take1 = v1 && k1 > prefix;
        const unsigned long long tm0 = __ballot(t0), tm1 = __ballot(t1);
        if (__popcll(tm0) + __popcll(tm1) == remaining) { take0 = take0 || t0; take1 = take1 || t1; }
        else {
            int r0 = 0, r1 = 0;
            for (unsigned long long m = tm0; m; m &= m - 1ull) { const int ib = __builtin_amdgcn_readlane(i0, (int)__builtin_ctzll(m)); r0 += (ib < i0) ? 1 : 0; r1 += (ib < i1) ? 1 : 0; }
            for (unsigned long long m = tm1; m; m &= m - 1ull) { const int ib = __builtin_amdgcn_readlane(i1, (int)__builtin_ctzll(m)); r0 += (ib < i0) ? 1 : 0; r1 += (ib < i1) ? 1 : 0; }
            take0 = take0 || (t0 && r0 < remaining); take1 = take1 || (t1 && r1 < remaining);
        }
        const unsigned long long w0 = __ballot(take0);
        if (take0) sel[nsel + __popcll(w0 & lt_mask)] = (u16)i0;
        nsel += __popcll(w0);
        const unsigned long long w1 = __ballot(take1);
        if (take1) sel[nsel + __popcll(w1 & lt_mask)] = (u16)i1;
        nsel += __popcll(w1);
    }
    return nsel;
}
__device__ __forceinline__ void dsa_select_slow(LAS unsigned char* lds, int w, const LAS u16* myk, LAS unsigned* hist, LAS u16* sel, LAS u16* bidx, LAS float* bsc, const u16* IKb, f32x4 wq, int npad, int lane, unsigned long long lt_mask) {
    const LAS unsigned* k2 = (const LAS unsigned*)myk;
    for (int i = lane; i < npad / 2; i += 64) { const unsigned kk = k2[i]; __hip_atomic_fetch_add(hist + ((kk >> 8) & 0xffu), 1u, __ATOMIC_RELAXED, __HIP_MEMORY_SCOPE_WORKGROUP); __hip_atomic_fetch_add(hist + (kk >> 24), 1u, __ATOMIC_RELAXED, __HIP_MEMORY_SCOPE_WORKGROUP); }
    LDS_WAIT();
    unsigned B1, above1, c1; find_bin(hist, DSA_TOPK, lane, B1, above1, c1);
    LDS_WAIT();
    *(LAS v4u*)(hist + 4 * lane) = (v4u){0u, 0u, 0u, 0u};
    LDS_WAIT();
    for (int i = lane; i < npad / 2; i += 64) { const unsigned kk = k2[i];
        if (((kk >> 8) & 0xffu) == B1) __hip_atomic_fetch_add(hist + (kk & 0xffu), 1u, __ATOMIC_RELAXED, __HIP_MEMORY_SCOPE_WORKGROUP);
        if ((kk >> 24) == B1) __hip_atomic_fetch_add(hist + ((kk >> 16) & 0xffu), 1u, __ATOMIC_RELAXED, __HIP_MEMORY_SCOPE_WORKGROUP); }
    LDS_WAIT();
    unsigned B2, above2, E; find_bin(hist, DSA_TOPK - above1, lane, B2, above2, E);
    const unsigned bstar = (B1 << 8) | B2; const int need = DSA_TOPK - (int)(above1 + above2);
    const bool index_mode = ((int)E == need) || (E > (unsigned)DSA_BCAP) || (bstar == 0x8000u);
    int nsel = 0, neq = 0;
    for (int c0 = 0; c0 < npad; c0 += 64) {
        const int j = c0 + lane; const unsigned kk = (j < npad) ? myk[j] : 0u;
        const bool gt = kk > bstar, eq = (kk == bstar);
        const unsigned long long em = __ballot(eq);
        const int epos = neq + __popcll(em & lt_mask);
        const bool take = gt || (index_mode && eq && epos < need);
        const unsigned long long tm = __ballot(take);
        if (take) sel[nsel + __popcll(tm & lt_mask)] = (u16)j;
        if (!index_mode && eq) bidx[epos] = (u16)j;
        nsel += __popcll(tm); neq += __popcll(em);
    }
    if (!index_mode) { LDS_WAIT(); dsa_rescore_select(lds, IKb, wq, bidx, bsc, sel, nsel, (int)E, need, lane, w, lt_mask, 7); }
}

template <int DP = 7> __device__ __forceinline__ void dsa_unit(Frame& F, int b, int t0, int& nb, int& nt0, int grp, int ngrp, v2u& iqn, float& iwn, int dpr = 7) {
    const int dpe = DP & dpr;
    LAS u16* KEYS = (LAS u16*)(F.lds + DSA_KEYS);
    int lane_ = F.lane; asm volatile("" : "+v"(lane_));
    const int lane = lane_, w = F.wave, r32 = lane & 31, half = lane >> 5;
    const long rowbase = (long)b * SEQ;
    const u16* IQ = (const u16*)(F_WS + WS_IQ); const u16* IKb = (const u16*)(F_WS + WS_IK) + rowbase * 64; const float* IW = (const float*)(F_WS + WS_IW);
    const bf16* KAVAb = (const bf16*)(F_WS + WS_KAVA) + rowbase * 128; bf16* AQ = (bf16*)(F_WS + WS_AQ);
    const int nkeys = t0 + 8, ntiles = (nkeys + 31) >> 5, npad = ntiles * 32;
    LAS unsigned* HISTALL = (LAS unsigned*)(F.lds + DSA_HIST);
    __syncthreads();
    { const int nk = *(const LAS int*)(F.lds + DSA_NXT); const int per = (T / 8) / ngrp;
      if (nk >= per) { nb = 0; nt0 = -1; } else if (ngrp == 4) { nb = grp; nt0 = 8 * (per - 1 - nk); } else { nb = nk & 3; nt0 = 8 * ((T / 32) - 1 - (nk >> 2)); } }
    { LAS u16* IQLw = (LAS u16*)(F.lds + DSA_IQ); *(LAS v2u*)(IQLw + 4 * F.tid) = iqn; if (F.tid < 32) ((LAS float*)(F.lds + DSA_IWL))[F.tid] = iwn; }
#define DSA_PREFETCH_NEXT() do { if (nt0 >= 0) { iqn = *(const v2u*)(IQ + ((long)nb * SEQ + nt0) * 256 + 4 * F.tid); if (F.tid < 32) iwn = IW[((long)nb * SEQ + nt0) * 4 + F.tid]; } } while (0)
    float minv, mc0;
    {
        float binv[4], bc0[4];
        f16x8 bt0[4];
        f16x8 b0[4], b1[4], b2[4];
#define DSA_LDT(dst, ktile) do { const int kb_ = min((ktile), ntiles - 1) * 32 + r32; _Pragma("unroll") for (int ks = 0; ks < 4; ++ks) dst[ks] = *(const f16x8*)(IKb + ik_off(kb_, 2 * ks + half)); } while (0)
#define DSA_PIN() asm volatile("" ::: "memory")
#pragma unroll
        for (int ks = 0; ks < 4; ++ks) bt0[ks] = *(const f16x8*)(IKb + ik_off(r32, 2 * ks + half));
        DSA_PIN(); DSA_LDT(b0, w); DSA_PIN(); DSA_LDT(b1, w + NWAVES); DSA_PIN(); DSA_LDT(b2, w + 2 * NWAVES); DSA_PIN();
        __syncthreads();
        f16x8 aop[4];
        { const int q = r32 >> 2, hd = r32 & 3; const LAS u16* pl = (const LAS u16*)(F.lds + DSA_IQ) + q * 256 + hd * 64 + 8 * half;
#pragma unroll
          for (int ks = 0; ks < 4; ++ks) aop[ks] = *(const LAS f16x8*)(pl + 16 * ks); }
        f32x4 wv[4];
#pragma unroll
        for (int g = 0; g < 4; ++g) wv[g] = *(const LAS f32x4*)((const LAS float*)(F.lds + DSA_IWL) + (2 * g + half) * 4);
        float finf = INFINITY; asm volatile("" : "+s"(finf));
        {
            f32x16 dacc = {};
#pragma unroll
            for (int ks = 0; ks < 4; ++ks) dacc = __builtin_amdgcn_mfma_f32_32x32x16_f16(aop[ks], bt0[ks], dacc, 0, 0, 0);
#pragma unroll
            for (int g = 0; g < 4; ++g) {
                float s = 0.f;
#pragma unroll
                for (int hd = 0; hd < 4; ++hd) s = fmaf(wv[g][hd], fmaxf(dacc[4 * g + hd], 0.f), s);
                float m = row_sum(s); m += xor_f<16>(m); m *= (1.0f / 32.0f);
                float v = row_sum((s - m) * (s - m)); v += xor_f<16>(v);
                const float sg = sqrtf(v * (1.0f / 32.0f));
                const bool okf = (sg > 1e-20f) && (sg < 1e20f);
                binv[g] = okf ? 25.6f / sg : 0.f; bc0[g] = okf ? -(m - 1.5f * sg) * binv[g] : 0.f;
            }
        }
        { const int g = w >> 1; const float a = g == 0 ? binv[0] : (g == 1 ? binv[1] : (g == 2 ? binv[2] : binv[3])), c = g == 0 ? bc0[0] : (g == 1 ? bc0[1] : (g == 2 ? bc0[2] : bc0[3]));
          minv = __builtin_bit_cast(float, __builtin_amdgcn_readlane(__builtin_bit_cast(int, a), (w & 1) * 32)); mc0 = __builtin_bit_cast(float, __builtin_amdgcn_readlane(__builtin_bit_cast(int, c), (w & 1) * 32)); }
#define DSA_SCORE(g_) (fmaf(wv[g_][3], __builtin_amdgcn_fmed3f(dacc[4 * (g_) + 3], 0.f, finf), fmaf(wv[g_][2], __builtin_amdgcn_fmed3f(dacc[4 * (g_) + 2], 0.f, finf), \
            fmaf(wv[g_][1], __builtin_amdgcn_fmed3f(dacc[4 * (g_) + 1], 0.f, finf), fmaf(wv[g_][0], __builtin_amdgcn_fmed3f(dacc[4 * (g_)], 0.f, finf), 0.f)))))
#define DSA_PROC(bb, ktile) do { const int key = (ktile) * 32 + r32; \
            f32x16 dacc = {}; \
            _Pragma("unroll") for (int ks = 0; ks < 4; ++ks) dacc = __builtin_amdgcn_mfma_f32_32x32x16_f16(aop[ks], bb[ks], dacc, 0, 0, 0); \
            if ((ktile) * 32 + 31 <= t0) {                         \
                _Pragma("unroll") for (int g = 0; g < 4; ++g) { \
                    const float s = DSA_SCORE(g); const int q = 2 * g + half; const unsigned k16 = sortable16(s); \
                    if (!(dpe & 128)) KEYS[q * 8192 + key] = (u16)k16; \
                    if (!(dpe & 64)) { const float sT = (float)(_Float16)s;                         \
                          \
                        LAS unsigned* cnt = (k16 == 0x8000u) ? ((LAS unsigned*)(F.lds + DSA_ZC) + q) : (HISTALL + q * 256 + lin_bin(sT, binv[g], bc0[g])); \
                        __hip_atomic_fetch_add(cnt, 1u, __ATOMIC_RELAXED, __HIP_MEMORY_SCOPE_WORKGROUP); } \
                } \
            } else { \
                _Pragma("unroll") for (int g = 0; g < 4; ++g) { \
                    const float s = DSA_SCORE(g); const int q = 2 * g + half; \
                    const bool valid = key <= t0 + q; \
                    const unsigned k16 = valid ? sortable16(s) : 0u; \
                    if (!(dpe & 128)) KEYS[q * 8192 + key] = (u16)k16; \
                    if (!(dpe & 64)) if (valid) { const float sT = (float)(_Float16)s;                         \
                        LAS unsigned* cnt = (k16 == 0x8000u) ? ((LAS unsigned*)(F.lds + DSA_ZC) + q) : (HISTALL + q * 256 + lin_bin(sT, binv[g], bc0[g])); \
                        __hip_atomic_fetch_add(cnt, 1u, __ATOMIC_RELAXED, __HIP_MEMORY_SCOPE_WORKGROUP); } \
                } \
            } } while (0)
        for (int kt = (dpe & 256) ? ntiles : w; kt < ntiles; kt += 3 * NWAVES) {
            DSA_PROC(b0, kt);
            DSA_PIN(); DSA_LDT(b0, kt + 3 * NWAVES); DSA_PIN();
            if (kt + NWAVES < ntiles) DSA_PROC(b1, kt + NWAVES);
            DSA_PIN(); DSA_LDT(b1, kt + 4 * NWAVES); DSA_PIN();
            if (kt + 2 * NWAVES < ntiles) DSA_PROC(b2, kt + 2 * NWAVES);
            DSA_PIN(); DSA_LDT(b2, kt + 5 * NWAVES); DSA_PIN();
        }
#undef DSA_PROC
#undef DSA_SCORE
#undef DSA_LDT
#undef DSA_PIN
    }
#ifdef TP_DSA_RT
    DSA_PREFETCH_NEXT();
#endif
    __syncthreads();
    if (!(dpe & 2)) { *(LAS v4u*)(HISTALL + F.wave * 256 + 4 * lane) = (v4u){0u, 0u, 0u, 0u}; if (lane == 0) ((LAS unsigned*)(F.lds + DSA_ZC))[F.wave] = 0u; return; }
    const int t = t0 + w, n = t + 1;
    LAS u16* myk = KEYS + w * 8192; LAS unsigned* hist = HISTALL + w * 256; LAS u16* sel = (LAS u16*)(F.lds + DSA_SEL) + w * 256;
    LAS u16* bidx = (LAS u16*)(F.lds + DSA_BIDX) + w * DSA_BCAP; LAS float* bsc = (LAS float*)(F.lds + DSA_BSC) + w * DSA_BCAP;
    const LAS u16* IQL = (const LAS u16*)(F.lds + DSA_IQ) + w * 256;
    const unsigned long long lt_mask = (1ull << lane) - 1ull;
    int count;
    if (n <= DSA_TOPK) {
        count = n;
        for (int j = lane; j < DSA_TOPK; j += 64) sel[j] = (u16)(j < n ? j : 0);
        *(LAS v4u*)(hist + 4 * lane) = (v4u){0u, 0u, 0u, 0u};
        if (lane == 0) ((LAS unsigned*)(F.lds + DSA_ZC))[w] = 0u;
    } else {
        count = DSA_TOPK;
        const f32x4 wq = *(const LAS f32x4*)((const LAS float*)(F.lds + DSA_IWL) + w * 4);
        typedef unsigned short us2 __attribute__((ext_vector_type(2)));
        const LAS v4u* k8 = (const LAS v4u*)myk;
        LAS unsigned* ZC = (LAS unsigned*)(F.lds + DSA_ZC);
        const int Z = (int)ZC[w]; const int bz = lin_bin(0.f, minv, mc0);
        if (lane == (bz >> 2)) hist[bz] += (unsigned)Z;
        LDS_WAIT();
        if (lane == 0) ZC[w] = 0u;
        unsigned B, above, E; find_bin(hist, DSA_TOPK, lane, B, above, E);
        LDS_WAIT();
        *(LAS v4u*)(hist + 4 * lane) = (v4u){0u, 0u, 0u, 0u};
        LDS_WAIT();
        const int need = DSA_TOPK - (int)above;
        if (dpe & 16) return;
        const int nch = (npad + 511) >> 9;
        auto count_ge = [&](unsigned thr) -> int {
            const unsigned t1 = thr - 1u, t2 = t1 | (t1 << 16); unsigned one2 = 0x00010001u; asm volatile("" : "+v"(one2)); unsigned acc = 0u;
            for (int ch = 0; ch < nch; ch += 2) {
                v4u kv[2];
#pragma unroll
                for (int u2 = 0; u2 < 2; ++u2) kv[u2] = k8[min(ch + u2, nch - 1) * 64 + lane];
#pragma unroll
                for (int u2 = 0; u2 < 2; ++u2) {
                    const bool live = (ch + u2 < nch) && ((ch + u2) * 512 + 8 * lane < npad);
                    unsigned c4 = pk_gt_flags(kv[u2].x, t2, one2);
                    c4 = pk_add16(c4, pk_gt_flags(kv[u2].y, t2, one2)); c4 = pk_add16(c4, pk_gt_flags(kv[u2].z, t2, one2)); c4 = pk_add16(c4, pk_gt_flags(kv[u2].w, t2, one2));
                    acc = pk_add16(acc, live ? c4 : 0u); }
            }
            return (int)(acc & 0xffffu) + (int)(acc >> 16); };
        bool done = false;
        if (minv > 0.f) {
            unsigned kLo, kHi;
            {
                auto first_ge = [&](int tb) -> unsigned {
                    const float bnd = ((float)tb - mc0) / minv; unsigned k = sortable16(bnd); k = k < 0x0404u ? 0x0404u : (k > 0xfbfbu ? 0xfbfbu : k);
                    unsigned r = 0u;
#pragma unroll
                    for (int d = 4; d >= -3; --d) { const unsigned kk = k + (unsigned)d; if (lin_bin(key_float(kk), minv, mc0) >= tb) r = kk; }
                    const bool okw = (r != 0u) && (lin_bin(key_float(r), minv, mc0) >= tb) && (lin_bin(key_float(r - 1u), minv, mc0) < tb) && (r > 0x0400u);
                    if (okw) return r;
                    unsigned lo = 0x0400u, hi = 0xfc00u;
                    while (lo < hi) { const unsigned mid = (lo + hi) >> 1; if (lin_bin(key_float(mid), minv, mc0) >= tb) hi = mid; else lo = mid + 1; }
                    return lo; };
                kLo = first_ge((int)B);
                kHi = (B == 255u) ? 0xffffu : first_ge((int)B + 1) - 1u;
            }
            unsigned cLo = kLo, cHi = kHi; int need_eq = need, extra_zero = 0; bool ok = (E <= (unsigned)DSA_BCAP);
            if ((int)B == bz && Z > 0) {
                const int mine = count_ge(0x8001u); const int P = (int)wave_sum((float)mine) - (int)above;
                if (need <= P) { cLo = 0x8001u; ok = (P <= DSA_BCAP); }
                else if (need <= P + Z) { cLo = 0x8001u; cHi = 0x8000u; need_eq = 0; extra_zero = need - P; ok = true; }
                else { cHi = 0x7fffu; need_eq = need - P - Z; ok = ((int)E - P - Z <= DSA_BCAP) && ((int)above + (int)E <= 512); }
            }
            if (ok) {
                done = true;
                const unsigned lo1 = cLo - 1u, tl2 = lo1 | (lo1 << 16);
                LAS u16* cand = (LAS u16*)hist;
                const int mycnt = count_ge(cLo);
                const int pre = wave_prefix_incl(mycnt, lane);
                const int C = min(__builtin_amdgcn_readlane(pre, 63), 512);
                int pos = pre - mycnt;
                unsigned one2 = 0x00010001u; asm volatile("" : "+v"(one2));
                for (int ch = 0; ch < nch; ch += 2) {
                    v4u kv[2];
#pragma unroll
                    for (int u2 = 0; u2 < 2; ++u2) kv[u2] = k8[min(ch + u2, nch - 1) * 64 + lane];
#pragma unroll
                    for (int u2 = 0; u2 < 2; ++u2) {
                        const int j0 = (ch + u2) * 512 + 8 * lane;
                        const bool live = (ch + u2 < nch) && (j0 < npad);
                        unsigned m = 0u;
#pragma unroll
                        for (int d = 0; d < 4; ++d) { const unsigned wd = d == 0 ? kv[u2].x : (d == 1 ? kv[u2].y : (d == 2 ? kv[u2].z : kv[u2].w));
                            m |= pk_gt_flags(wd, tl2, one2) << d; }
                        if (!live) m = 0u;
                        while (m) { const int x = __builtin_ctz(m); m &= m - 1u; if (pos < 512) cand[pos] = (u16)(j0 + 2 * (x & 15) + (x >> 4)); ++pos; }
                    }
                }
                LDS_WAIT();
                if (dpe & 32) { *(LAS v4u*)(hist + 4 * lane) = (v4u){0u, 0u, 0u, 0u}; return; }
                int nsel = 0, neq = 0;
                {
                    int idx5[5]; unsigned kk5[5];
#pragma unroll
                    for (int r = 0; r < 5; ++r) { const int e = lane + 64 * r; const int v = (int)cand[e]; idx5[r] = (e < C) ? v : 0; }
#pragma unroll
                    for (int r = 0; r < 5; ++r) kk5[r] = (unsigned)myk[idx5[r]];
#pragma unroll
                    for (int r = 0; r < 5; ++r) {
                        const int e = lane + 64 * r; const bool in = e < C; const int idx = idx5[r]; const unsigned kk = in ? kk5[r] : 0u;
                        const bool gt = in && kk > cHi, eq = in && !gt;
                        const unsigned long long tm = __ballot(gt), em = __ballot(eq);
                        if (gt) sel[nsel + __popcll(tm & lt_mask)] = (u16)idx;
                        if (eq) { const int ep = neq + __popcll(em & lt_mask); if (ep < DSA_BCAP) bidx[ep] = (u16)idx; }
                        nsel += __popcll(tm); neq += __popcll(em);
                    }
                }
                for (int r = 5; r * 64 < C; ++r) {
                    const int e = lane + 64 * r; const bool in = e < C; const int idx = in ? (int)cand[e] : 0; const unsigned kk = in ? (unsigned)myk[idx] : 0u;
                    const bool gt = in && kk > cHi, eq = in && !gt;
                    const unsigned long long tm = __ballot(gt), em = __ballot(eq);
                    if (gt) sel[nsel + __popcll(tm & lt_mask)] = (u16)idx;
                    if (eq) { const int ep = neq + __popcll(em & lt_mask); if (ep < DSA_BCAP) bidx[ep] = (u16)idx; }
                    nsel += __popcll(tm); neq += __popcll(em);
                }
                LDS_WAIT();
                *(LAS v4u*)(hist + 4 * lane) = (v4u){0u, 0u, 0u, 0u};
                if (neq == need_eq) { for (int e = lane; e < neq; e += 64) sel[nsel + e] = bidx[e]; nsel += neq; }
                else if (need_eq > 0) {
                    nsel = dsa_rescore_select(F.lds, IKb, wq, bidx, bsc, sel, nsel, min(neq, DSA_BCAP), need_eq, lane, w, lt_mask, dpe);
                }
                if (extra_zero > 0) {
                    int base = 0;
                    for (int c0 = 0; c0 < npad && base < extra_zero; c0 += 512) {
                        const int j0 = c0 + 8 * lane; v4u kv = (v4u){0u, 0u, 0u, 0u}; if (j0 < npad) kv = k8[j0 >> 3];
                        unsigned m8 = 0u;
#pragma unroll
                        for (int x = 0; x < 8; ++x) { const unsigned wd = x < 2 ? kv.x : (x < 4 ? kv.y : (x < 6 ? kv.z : kv.w)); const unsigned kk = (x & 1) ? (wd >> 16) : (wd & 0xffffu); m8 |= (kk == 0x8000u ? 1u : 0u) << x; }
                        const int c = __builtin_popcount(m8);
                        int ex = 0;
#pragma unroll
                        for (int bit = 0; bit < 4; ++bit) ex += __popcll(__ballot((c >> bit) & 1) & lt_mask) << bit;
                        int tot = 0;
#pragma unroll
                        for (int bit = 0; bit < 4; ++bit) tot += __popcll(__ballot((c >> bit) & 1)) << bit;
                        int rk = base + ex;
#pragma unroll
                        for (int x = 0; x < 8; ++x) if ((m8 >> x) & 1u) { if (rk < extra_zero) sel[nsel + rk] = (u16)(j0 + x); ++rk; }
                        base += tot;
                    }
                    nsel += extra_zero;
                }
            }
        }
        if (!done) {
            dsa_select_slow(F.lds, w, myk, hist, sel, bidx, bsc, IKb, wq, npad, lane, lt_mask);
            LDS_WAIT();
            *(LAS v4u*)(hist + 4 * lane) = (v4u){0u, 0u, 0u, 0u};
        }
    }
    LDS_WAIT();
    if (!(dpe & 4)) return;
    {
        LAS float* PF = (LAS float*)myk;
        LAS u16* PB = (LAS u16*)(PF + 1024);
        LAS unsigned char* VS = (LAS unsigned char*)(PB + 1024);
        const int l16 = lane & 15, qt = lane >> 4, r8 = lane >> 3;
        const bf16* gb = KAVAb + 8 * (lane & 7);
        LAS unsigned char* stw = VS + r8 * DSA_VROW + 16 * (lane & 7);
        v4u kk[32];
#pragma unroll
        for (int i = 0; i < 32; ++i) { const int idx = (int)sel[r8 + 8 * i]; kk[i] = *(const v4u*)(gb + (long)idx * 128); }
        v4u vq[4][8];
#pragma unroll
        for (int i = 0; i < 8; ++i) { const int idx = (int)sel[r8 + 8 * i]; vq[0][i] = *(const v4u*)(gb + (long)idx * 128 + 64); }
        bf16x8 aq[2];
#pragma unroll
        for (int ks = 0; ks < 2; ++ks) { v4u z = (v4u){0u, 0u, 0u, 0u}; if (l16 < 4) z = *(const v4u*)(AQ + (rowbase + t) * 256 + l16 * 64 + 32 * ks + 8 * qt); aq[ks] = __builtin_bit_cast(bf16x8, z); }
#pragma unroll
        for (int c = 0; c < 4; ++c) {
#pragma unroll
            for (int i = 0; i < 8; ++i) *(LAS v4u*)(stw + 8 * i * DSA_VROW) = kk[8 * c + i];
#pragma unroll
            for (int t4 = 0; t4 < 4; ++t4) {
                const LAS unsigned char* rp = VS + (16 * t4 + l16) * DSA_VROW + 16 * qt;
                const bf16x8 kA = *(const LAS bf16x8*)rp, kB = *(const LAS bf16x8*)(rp + 64);
                f32x4 acc = {0.f, 0.f, 0.f, 0.f};
                acc = __builtin_amdgcn_mfma_f32_16x16x32_bf16(aq[0], kA, acc, 0, 0, 0);
                acc = __builtin_amdgcn_mfma_f32_16x16x32_bf16(aq[1], kB, acc, 0, 0, 0);
                const int j = 64 * c + 16 * t4 + l16;
                if (qt == 0) *(LAS f32x4*)(PF + j * 4) = (j < count) ? acc * SM_C : (f32x4){-1e30f, -1e30f, -1e30f, -1e30f};
            }
        }
#ifndef TP_DSA_RT
        DSA_PREFETCH_NEXT();
#endif
#pragma unroll
        for (int c = 1; c < 4; ++c)
#pragma unroll
            for (int i = 0; i < 8; ++i) { const int idx = (int)sel[64 * c + r8 + 8 * i]; vq[c][i] = *(const v4u*)(gb + (long)idx * 128 + 64); }
        LDS_WAIT();
        {
            f32x4 z4[4];
#pragma unroll
            for (int jj = 0; jj < 4; ++jj) z4[jj] = *(const LAS f32x4*)(PF + (lane + 64 * jj) * 4);
#pragma unroll
            for (int hd = 0; hd < 4; ++hd) {
                const float m = wave_max(fmaxf(fmaxf(z4[0][hd], z4[1][hd]), fmaxf(z4[2][hd], z4[3][hd])));
                float s = 0.f;
#pragma unroll
                for (int jj = 0; jj < 4; ++jj) { const float p = (lane + 64 * jj < count) ? __builtin_amdgcn_exp2f(z4[jj][hd] - m) : 0.f; z4[jj][hd] = p; s += p; }
                const float inv = 1.0f / wave_sum(s);
#pragma unroll
                for (int jj = 0; jj < 4; ++jj) PB[hd * 256 + lane + 64 * jj] = (u16)f2bf(z4[jj][hd] * inv);
            }
        }
        LDS_WAIT();
        f32x4 o[4];
#pragma unroll
        for (int nt = 0; nt < 4; ++nt) o[nt] = (f32x4){0.f, 0.f, 0.f, 0.f};
        const unsigned VSa = (unsigned)(uintptr_t)VS;
#pragma unroll
        for (int c = 0; c < 4; ++c) {
#pragma unroll
            for (int i = 0; i < 8; ++i) *(LAS v4u*)(stw + 8 * i * DSA_VROW) = vq[c][i];
            LDS_WAIT();
#pragma unroll
            for (int kk2 = 0; kk2 < 2; ++kk2) {
                v4u pz = (v4u){0u, 0u, 0u, 0u}; if (l16 < 4) pz = *(const LAS v4u*)(PB + l16 * 256 + 64 * c + 32 * kk2 + 8 * qt);
                const bf16x8 pf = __builtin_bit_cast(bf16x8, pz);
#pragma unroll
                for (int nt = 0; nt < 4; ++nt) {
                    const unsigned a0 = VSa + (32 * kk2 + 8 * qt + (l16 >> 2)) * DSA_VROW + (16 * nt + 4 * (l16 & 3)) * 2;
                    s16x4 lo = tr_read(a0), hi = tr_read(a0 + 4 * DSA_VROW);
                    asm volatile("s_waitcnt lgkmcnt(0)" : "+v"(lo), "+v"(hi) :: "memory");
                    const bf16x8 vf = (bf16x8){lo[0], lo[1], lo[2], lo[3], hi[0], hi[1], hi[2], hi[3]};
                    o[nt] = __builtin_amdgcn_mfma_f32_16x16x32_bf16(pf, vf, o[nt], 0, 0, 0);
                }
            }
            LDS_WAIT();
        }
        if (qt == 0 && !(dpe & 512)) { bf16* orow = AQ + (rowbase + t) * 256 + l16;
#pragma unroll
            for (int hd = 0; hd < 4; ++hd)
#pragma unroll
                for (int nt = 0; nt < 4; ++nt) orow[hd * 64 + 16 * nt] = (bf16)f2bf(o[nt][hd]); }
    }
#undef DSA_PREFETCH_NEXT
}

template <int PART = 7, int DSAP = 7> __device__ __forceinline__ void phase_attention(Frame& F, int l) {
    if (PART & 2) for (int L = F.vcu; L < 256; L += F.G) { const int b = L >> 6, h = (L >> 4) & 3, p = L & 15; moba_unit2(F, b, h, p); moba_unit2(F, b, h, 31 - p); }
    if (PART & 4) for (int L = F.vcu; L < 512; L += F.G) swa_unit(F, l, L >> 7, (L >> 6) & 1, L & 63);
    if (PART & 1) { __syncthreads(); for (int i = F.tid; i < 2048; i += NTHR) ((LAS unsigned*)(F.lds + DSA_HIST))[i] = 0u; if (F.tid < 8) ((LAS unsigned*)(F.lds + DSA_ZC))[F.tid] = 0u; }
#ifdef TP_DSA_RT
    int npass = 2; asm volatile("" : "+s"(npass));
    for (int pass = 0; pass < npass; ++pass) { int dpr = (pass + 1 < npass) ? (TP_DSA_RT) : 7; asm volatile("" : "+s"(dpr));
#else
    { constexpr int dpr = 7;
#endif
    if (PART & 1) {
        const int ngrp = (F.G == 256) ? 4 : 1, grp = (F.G == 256) ? (F.vcu >> 6) : 0, per = (T / 8) / ngrp;
#ifdef TP_DSA_RT
        gu32* qc = (gu32*)(F_WS + WS_CTL) + CW_DSAQ + 64 * l + 16 * pass + grp;
#else
        gu32* qc = (gu32*)(F_WS + WS_CTL) + CW_DSAQ + 64 * l + grp;
#endif
        LAS int* NXT = (LAS int*)(F.lds + DSA_NXT);
        int pend = 0;
        if (F.tid == 0) { NXT[0] = (int)__hip_atomic_fetch_add(qc, 1u, RLX_AGENT); pend = (int)__hip_atomic_fetch_add(qc, 1u, RLX_AGENT); }
        __syncthreads();
        int b, t0;
        { const int k0 = NXT[0]; if (k0 >= per) { b = 0; t0 = -1; } else if (ngrp == 4) { b = grp; t0 = 8 * (per - 1 - k0); } else { b = k0 & 3; t0 = 8 * ((T / 32) - 1 - (k0 >> 2)); } }
        __syncthreads();
        v2u iqn = (v2u){0u, 0u}; float iwn = 0.f;
        if (t0 >= 0) { const u16* IQ = (const u16*)(F_WS + WS_IQ); const float* IW = (const float*)(F_WS + WS_IW);
            iqn = *(const v2u*)(IQ + ((long)b * SEQ + t0) * 256 + 4 * F.tid); if (F.tid < 32) iwn = IW[((long)b * SEQ + t0) * 4 + F.tid]; }
        while (t0 >= 0) { int nb = 0, nt0 = -1;
            if (F.tid == 0) { NXT[0] = pend; pend = (int)__hip_atomic_fetch_add(qc, 1u, RLX_AGENT); }
#ifdef TP_DSA_RT
            dsa_unit<0x7fffffff>(F, b, t0, nb, nt0, grp, ngrp, iqn, iwn, dpr);
#else
            dsa_unit<DSAP>(F, b, t0, nb, nt0, grp, ngrp, iqn, iwn, dpr);
#endif
            b = nb; t0 = nt0; }
    }
    }
    __syncthreads();
}

struct SchedBranch {
    unsigned char* ws; const char* Bw; int G, vcu;
    __device__ __forceinline__ bool next(int i, pg8::Unit& u) const {
        const int tau = (i / 3) * G + vcu, br = i % 3; if (tau >= 512) return false;
        const int pm = tau >> 2, pn = tau & 3;
        const size_t aoff = br == 0 ? WS_AQ : (br == 1 ? WS_BQ : WS_CQ); const int lda = br == 2 ? 512 : 256; const int kb = br == 0 ? 0 : (br == 1 ? 256 : 512);
        u.A = (const char*)(ws + aoff) + (size_t)pm * 256 * lda * 2; u.B = Bw + (size_t)pn * 256 * 1024 * 2 + kb * 2; u.rowlist = nullptr; u.nvalid = 256; u.lda = lda; u.nt = lda / 64;
        u.ksplit = 1 << 30; u.bdelta = 0; u.p0 = pm; u.p1 = pn; u.p2 = br; u.p3 = 0; return true;
    }
};
struct EpiBranch {
    static constexpr bool PERM = true;
    static __device__ __forceinline__ bool keep_acc(const pg8::Unit& u) { return u.p2 < 2; }
    unsigned char* ws;
    __device__ __forceinline__ void operator()(f32x4 (&acc)[2][2][4][2], const pg8::Unit& u, int wr, int wc, int fr, int fq) const {
        const int pm = u.p0, pn = u.p1, br = u.p2;
        bf16* MG = (bf16*)(ws + WS_MERGED);
        const int row0 = pm * 256 + wr * 64 + fr, col0 = pn * 256 + wc * 32 + 8 * fq;
        const unsigned char* GATES8 = (const unsigned char*)(ws + WS_GATES);
        const unsigned char* gp = GATES8 + (size_t)row0 * 3072 + br * 1024 + col0;
#define GQ(vv_, ee_) ((float)(((ee_) < 4 ? (vv_)[0] >> (8 * ((ee_) & 3)) : (vv_)[1] >> (8 * ((ee_) & 3))) & 0xffu))
        if (br < 2) {
#pragma unroll
            for (int ai = 0; ai < 2; ++ai) {
                v2u g[4][2], gn[4][2];
#pragma unroll
                for (int m = 0; m < 4; ++m)
#pragma unroll
                    for (int bj = 0; bj < 2; ++bj) { const unsigned char* q = gp + (size_t)(ai * 128 + m * 16) * 3072 + bj * 128; g[m][bj] = *(const v2u*)q; gn[m][bj] = *(const v2u*)(q + 1024); }
#pragma unroll
                for (int m = 0; m < 4; ++m)
#pragma unroll
                    for (int bj = 0; bj < 2; ++bj) {
                        const v2u a = g[m][bj], d = gn[m][bj];
#pragma unroll
                        for (int e = 0; e < 4; ++e) { acc[ai][bj][m][0][e] *= GQ(a, e) * __builtin_amdgcn_rcpf(GQ(d, e)); acc[ai][bj][m][1][e] *= GQ(a, 4 + e) * __builtin_amdgcn_rcpf(GQ(d, 4 + e)); }
                    }
            }
        } else {
#pragma unroll
            for (int ai = 0; ai < 2; ++ai) {
                v2u g[4][2];
#pragma unroll
                for (int m = 0; m < 4; ++m)
#pragma unroll
                    for (int bj = 0; bj < 2; ++bj) g[m][bj] = *(const v2u*)(gp + (size_t)(ai * 128 + m * 16) * 3072 + bj * 128);
#pragma unroll
                for (int m = 0; m < 4; ++m)
#pragma unroll
                    for (int bj = 0; bj < 2; ++bj) {
                        const v2u a = g[m][bj];
                        f32x4 x0 = acc[ai][bj][m][0], x1 = acc[ai][bj][m][1];
#pragma unroll
                        for (int e = 0; e < 4; ++e) { x0[e] *= GQ(a, e) * (1.0f / 255.0f); x1[e] *= GQ(a, 4 + e) * (1.0f / 255.0f); }
                        v4u w; w.x = cvt_pk_bf16(x0[0], x0[1]); w.y = cvt_pk_bf16(x0[2], x0[3]); w.z = cvt_pk_bf16(x1[0], x1[1]); w.w = cvt_pk_bf16(x1[2], x1[3]);
                        *(v4u*)(MG + (size_t)(row0 + ai * 128 + m * 16) * 1024 + col0 + bj * 128) = w;
                    }
            }
        }
#undef GQ
    }
};
__device__ __forceinline__ void phase_branch(Frame& F, int l) {
    SchedBranch S{F_WS, (const char*)(F_WS + WS_WBR) + (size_t)l * 1024 * 1024 * 2, F.G, F.vcu};
    EpiBranch E{F_WS};
    pg8::gemm_phase<EpiBranch, SchedBranch, true>(F.lds, F.tid, 1024, S, E);
}

struct EpiY {
    static constexpr bool PERM = true;
    static __device__ __forceinline__ bool keep_acc(const pg8::Unit&) { return false; }
    bf16* Y;
    __device__ __forceinline__ void operator()(const f32x4 (&acc)[2][2][4][2], const pg8::Unit& u, int wr, int wc, int fr, int fq) const {
        const int row0 = u.p0 * 256 + wr * 64 + fr, col0 = u.p1 * 256 + wc * 32 + 8 * fq;
#pragma unroll
        for (int ai = 0; ai < 2; ++ai)
#pragma unroll
            for (int m = 0; m < 4; ++m) { bf16* rp = Y + (size_t)(row0 + ai * 128 + m * 16) * 1024 + col0;
#pragma unroll
                for (int bj = 0; bj < 2; ++bj) { const f32x4 a = acc[ai][bj][m][0], b = acc[ai][bj][m][1];
                    v4u w; w.x = cvt_pk_bf16(a[0], a[1]); w.y = cvt_pk_bf16(a[2], a[3]); w.z = cvt_pk_bf16(b[0], b[1]); w.w = cvt_pk_bf16(b[2], b[3]);
                    *(v4u*)(rp + bj * 128) = w; } }
    }
};
__device__ __forceinline__ void phase_wo(Frame& F, int l) {
    SchedDense S; S.A = (const char*)(F_WS + WS_MERGED); S.B = (const char*)(F_WS + WS_WO) + (size_t)l * 1024 * 1024 * 2; S.lda = 1024; S.lda_b = 256 * 1024 * 2; S.ldb_b = 256 * 1024 * 2; S.nN = 4; S.nt = 16; S.G = F.G; S.vcu = F.vcu; S.ntiles = 512;
    EpiY E{(bf16*)(F_WS + WS_Y)};
    pg8::gemm_phase<EpiY, SchedDense, true>(F.lds, F.tid, 1024, S, E);
}

struct LnIn { f32x4 a[4]; v2u b[4]; };
__device__ __forceinline__ void ln_load(LnIn& R, const float* xin, const bf16* y, int lane) {
#pragma unroll
    for (int j = 0; j < 4; ++j) { R.a[j] = *(const f32x4*)(xin + 4 * lane + 256 * j); R.b[j] = *(const v2u*)(y + 4 * lane + 256 * j); }
}
__device__ __forceinline__ void ln_finish(const LnIn& R, const f32x4 (&gg)[4], const f32x4 (&bb)[4], float* xout, bf16* xb, int lane, f32x4 (&o)[4]) {
    f32x4 v[4]; float s = 0.f;
#pragma unroll
    for (int j = 0; j < 4; ++j) { const f32x4 yv = (f32x4){bflo(R.b[j].x), bfhi(R.b[j].x), bflo(R.b[j].y), bfhi(R.b[j].y)}; v[j] = R.a[j] * DN_ALPHA + yv; s += (v[j].x + v[j].y) + (v[j].z + v[j].w); }
    const float mean = wave_sum(s) * (1.f / D); float s2 = 0.f;
#pragma unroll
    for (int j = 0; j < 4; ++j) { v[j] = v[j] - mean; s2 += (v[j].x * v[j].x + v[j].y * v[j].y) + (v[j].z * v[j].z + v[j].w * v[j].w); }
    const float rstd = 1.0f / sqrtf(wave_sum(s2) * (1.f / D) + LN_EPS);
#pragma unroll
    for (int j = 0; j < 4; ++j) { o[j] = v[j] * rstd * gg[j] + bb[j]; *(f32x4*)(xout + 4 * lane + 256 * j) = o[j];
        v2u w; w.x = pk2(o[j].x, o[j].y); w.y = pk2(o[j].z, o[j].w); *(v2u*)(xb + 4 * lane + 256 * j) = w; }
}
__device__ __forceinline__ void phase_ln1_route(Frame& F, int l) {
    convert_moe_weights(F, l);
    __syncthreads();
    LAS float* RWL = (LAS float*)F.lds;
    LAS int* lcnt = (LAS int*)(F.lds + 140000);
    LAS int* lbase = lcnt + 32;
    LAS int* ent = lcnt + 64;
    LAS float* entw = (LAS float*)(ent + 1024);
    const float* xin = (l == 0) ? F_IN(I_X) : F_OUT; const bf16* Y = (const bf16*)(F_WS + WS_Y);
    const float* g = F_IN(I_LN1G) + l * D; const float* bt = F_IN(I_LN1B) + l * D; const float* RW = F_IN(I_RW); const float* RB = F_IN(I_RB);
    bf16* XB = (bf16*)(F_WS + WS_XB);
    unsigned* gcnt = (unsigned*)(F_WS + WS_CTL) + CW_CNT + l * 24 * 64;
    int* LIST = (int*)(F_WS + WS_LIST); f32x2* CWp = (f32x2*)(F_WS + WS_CW);
    for (int i = F.tid; i < 16384; i += NTHR) RWL[(i & 15) * 1024 + (i >> 4)] = RW[i];
    f32x4 gg[4], bb[4];
#pragma unroll
    for (int j = 0; j < 4; ++j) { gg[j] = *(const f32x4*)(g + 4 * F.lane + 256 * j); bb[j] = *(const f32x4*)(bt + 4 * F.lane + 256 * j); }
    const int rows_per = (T + F.G - 1) / F.G;
    for (int chunk = 0; chunk < rows_per; chunk += 512) {
        if (F.tid < 24) lcnt[F.tid] = 0;
        __syncthreads();
        const int r_lo = F.vcu * rows_per + chunk, r_hi = min(min(r_lo + 512, (F.vcu + 1) * rows_per), T);
        LnIn cur, nxt;
        int row = r_lo + F.wave;
        if (row < r_hi) ln_load(cur, xin + (size_t)row * D, Y + (size_t)row * D, F.lane);
        for (; row < r_hi; row += NWAVES) {
            if (row + NWAVES < r_hi) ln_load(nxt, xin + (size_t)(row + NWAVES) * D, Y + (size_t)(row + NWAVES) * D, F.lane);
            f32x4 o[4];
            ln_finish(cur, gg, bb, F_OUT + (size_t)row * D, XB + (size_t)row * D, F.lane, o);
            float lg[16];
#pragma unroll
            for (int e = 0; e < 16; ++e) { float a = 0.f;
#pragma unroll
                for (int j = 0; j < 4; ++j) { const f32x4 w4 = *(const LAS f32x4*)(RWL + e * 1024 + 4 * F.lane + 256 * j); a = fmaf(o[j].x, w4.x, a); a = fmaf(o[j].y, w4.y, a); a = fmaf(o[j].z, w4.z, a); a = fmaf(o[j].w, w4.w, a); }
                lg[e] = a; }
#pragma unroll
            for (int e = 0; e < 16; ++e) lg[e] = wave_sum(lg[e]);
            if (F.lane == 0) {
                float aff[16], ss[16];
#pragma unroll
                for (int e = 0; e < 16; ++e) { aff[e] = 1.0f / (1.0f + expf(-lg[e])); ss[e] = aff[e] + RB[e]; }
                int gbest = 0; float gs = -INFINITY;
#pragma unroll
                for (int gq = 0; gq < 4; ++gq) { float m1 = -INFINITY, m2 = -INFINITY;
#pragma unroll
                    for (int i = 0; i < 4; ++i) { const float v = ss[4 * gq + i]; if (v > m1) { m2 = m1; m1 = v; } else if (v > m2) m2 = v; }
                    const float sc = m1 + m2; if (sc > gs) { gs = sc; gbest = gq; } }
                float m1 = -INFINITY, m2 = -INFINITY; int i1 = 0, i2 = 0;
#pragma unroll
                for (int gq = 0; gq < 4; ++gq) if (gq == gbest) {
#pragma unroll
                    for (int i = 0; i < 4; ++i) { const float v = ss[4 * gq + i]; if (v > m1) { m2 = m1; i2 = i1; m1 = v; i1 = i; } else if (v > m2) { m2 = v; i2 = i; } } }
                float a1 = 0.f, a2 = 0.f;
#pragma unroll
                for (int e = 0; e < 16; ++e) { if (e == 4 * gbest + i1) a1 = aff[e]; if (e == 4 * gbest + i2) a2 = aff[e]; }
                const float inv = 1.0f / (a1 + a2);
                const int lo_i = min(i1, i2), hi_i = max(i1, i2);
                const float c_lo = (i1 < i2 ? a1 : a2) * inv, c_hi = (i1 < i2 ? a2 : a1) * inv;
                const int pidx = (lo_i == 0) ? (hi_i - 1) : (lo_i == 1 ? 1 + hi_i : 5);
                const int pair = min(max(gbest * 6 + pidx, 0), NPAIR - 1);
                const int lp = __hip_atomic_fetch_add(lcnt + pair, 1, __ATOMIC_RELAXED, __HIP_MEMORY_SCOPE_WORKGROUP);
                const int k = row - r_lo; ent[2 * k] = pair; ent[2 * k + 1] = lp; entw[2 * k] = c_lo; entw[2 * k + 1] = c_hi;
            }
#pragma unroll
            for (int j = 0; j < 4; ++j) { cur.a[j] = nxt.a[j]; cur.b[j] = nxt.b[j]; }
        }
        __syncthreads();
        if (F.tid < 24) lbase[F.tid] = (int)__hip_atomic_fetch_add(gcnt + F.tid * 64, (unsigned)lcnt[F.tid], __ATOMIC_RELAXED, __HIP_MEMORY_SCOPE_AGENT);
        __syncthreads();
        for (int k = F.tid; k < r_hi - r_lo; k += NTHR) { const int pair = ent[2 * k], pos = lbase[pair] + ent[2 * k + 1];
            LIST[(size_t)pair * T + pos] = r_lo + k; CWp[(size_t)pair * T + pos] = (f32x2){entw[2 * k], entw[2 * k + 1]}; }
        __syncthreads();
    }
}
__device__ __forceinline__ void phase_ln2(Frame& F, int l) {
    const bf16* Y = (const bf16*)(F_WS + WS_Y); const float* g = F_IN(I_LN2G) + l * D; const float* bt = F_IN(I_LN2B) + l * D; bf16* XB = (bf16*)(F_WS + WS_XB);
    const int gw = F.vcu * NWAVES + F.wave, NGW = F.G * NWAVES;
    f32x4 gg[4], bb[4];
#pragma unroll
    for (int j = 0; j < 4; ++j) { gg[j] = *(const f32x4*)(g + 4 * F.lane + 256 * j); bb[j] = *(const f32x4*)(bt + 4 * F.lane + 256 * j); }
    LnIn cur, nxt;
    int row = gw;
    if (row < T) ln_load(cur, F_OUT + (size_t)row * D, Y + (size_t)row * D, F.lane);
    for (; row < T; row += NGW) {
        if (row + NGW < T) ln_load(nxt, F_OUT + (size_t)(row + NGW) * D, Y + (size_t)(row + NGW) * D, F.lane);
        f32x4 o[4]; ln_finish(cur, gg, bb, F_OUT + (size_t)row * D, XB + (size_t)row * D, F.lane, o);
#pragma unroll
        for (int j = 0; j < 4; ++j) { cur.a[j] = nxt.a[j]; cur.b[j] = nxt.b[j]; }
    }
}

__device__ __forceinline__ void moe_table(Frame& F, int l, LAS int* tp, LAS int* cn) {
    const unsigned* gcnt = (const unsigned*)(F_WS + WS_CTL) + CW_CNT + l * 24 * 64;
    if (F.tid == 0) { int acc = 0; for (int p = 0; p < 24; ++p) { const int c = (int)__hip_atomic_load(gcnt + p * 64, __ATOMIC_RELAXED, __HIP_MEMORY_SCOPE_AGENT); cn[p] = c; tp[p] = acc; acc += (c + 255) >> 8; } tp[24] = acc; }
    __syncthreads();
}
__device__ __forceinline__ void pair_experts(int p, int& e0, int& e1) { const int gq = p / 6, k = p % 6; const int lo = k < 3 ? 0 : (k < 5 ? 1 : 2); const int hi = k < 3 ? k + 1 : (k < 5 ? k - 1 : 3); e0 = 4 * gq + lo; e1 = 4 * gq + hi; }
struct SchedMoeUp {
    unsigned char* ws; const LAS int* tp; const LAS int* cn; int G, vcu, RT;
    __device__ __forceinline__ bool next(int i, pg8::Unit& u) const {
        const int L = i * G + vcu; if (L >= RT * 8) return false;
        const int rt = L >> 3, ct = L & 7; int p = 0;
        for (int q = 1; q < 24; ++q) if (tp[q] <= rt) p = q;
        int e0, e1; pair_experts(p, e0, e1); const int e = ct < 4 ? e0 : e1; const int lr0 = (rt - tp[p]) * 256;
        u.A = (const char*)(ws + WS_XB); u.B = (const char*)(ws + WS_WGU) + ((size_t)e * 1024 + (ct & 3) * 256) * 1024 * 2;
        u.rowlist = (const int*)(ws + WS_LIST) + (size_t)p * T + lr0; u.nvalid = min(256, cn[p] - lr0); u.lda = 1024; u.nt = 16; u.ksplit = 1 << 30; u.bdelta = 0;
        u.p0 = rt; u.p1 = ct; u.p2 = p; u.p3 = lr0; return true;
    }
};
struct EpiMoeUp {
    static constexpr bool PERM = true;
    static __device__ __forceinline__ bool keep_acc(const pg8::Unit&) { return false; }
    unsigned char* ws;
    __device__ __forceinline__ void operator()(const f32x4 (&acc)[2][2][4][2], const pg8::Unit& u, int wr, int wc, int fr, int fq) const {
        const int rt = u.p0, ct = u.p1, p = u.p2, lr0 = u.p3;
        bf16* H = (bf16*)(ws + WS_H); const f32x2* CWp = (const f32x2*)(ws + WS_CW) + (size_t)p * T + lr0;
        const int slot = ct >> 2;
        float cw1[2][4];
#pragma unroll
        for (int ai = 0; ai < 2; ++ai)
#pragma unroll
            for (int m = 0; m < 4; ++m) cw1[ai][m] = ((const float*)CWp)[2 * min(ai * 128 + wr * 64 + m * 16 + fr, u.nvalid - 1) + slot];
#pragma unroll
        for (int ai = 0; ai < 2; ++ai)
#pragma unroll
            for (int m = 0; m < 4; ++m) { const int r = ai * 128 + wr * 64 + m * 16 + fr; const bool ok = r < u.nvalid;
                const float cw = ok ? cw1[ai][m] : 0.f;
#pragma unroll
                for (int bj = 0; bj < 2; ++bj) { const f32x4 gv = acc[ai][bj][m][0], uv = acc[ai][bj][m][1];
                    float hh[4];
#pragma unroll
                    for (int x = 0; x < 4; ++x) { const float gx = gv[x]; hh[x] = ok ? gx * sigmoidf_(gx) * uv[x] * cw : 0.f; }
                    v2u w; w.x = cvt_pk_bf16(hh[0], hh[1]); w.y = cvt_pk_bf16(hh[2], hh[3]);
                    *(v2u*)(H + (size_t)(rt * 256 + r) * 1024 + slot * 512 + (ct & 3) * 128 + bj * 64 + wc * 16 + 4 * fq) = w; } }
    }
};
struct SchedMoeDown {
    unsigned char* ws; const LAS int* tp; const LAS int* cn; int G, vcu, RT;
    __device__ __forceinline__ bool next(int i, pg8::Unit& u) const {
        const int L = i * G + vcu; if (L >= RT * 4) return false;
        const int rt = L >> 2, ct = L & 3; int p = 0;
        for (int q = 1; q < 24; ++q) if (tp[q] <= rt) p = q;
        int e0, e1; pair_experts(p, e0, e1); const int lr0 = (rt - tp[p]) * 256;
        u.A = (const char*)(ws + WS_H) + (size_t)rt * 256 * 1024 * 2; u.B = (const char*)(ws + WS_WD) + ((size_t)ct * 256 * (NEXP * DE) + e0 * DE) * 2;
        u.rowlist = nullptr; u.nvalid = min(256, cn[p] - lr0); u.lda = 1024; u.nt = 16; u.ksplit = 8; u.bdelta = (long)(e1 - e0 - 1) * DE * 2;
        u.p0 = rt; u.p1 = ct; u.p2 = p; u.p3 = lr0; return true;
    }
};
struct EpiMoeDown {
    static constexpr bool PERM = true;
    static __device__ __forceinline__ bool keep_acc(const pg8::Unit&) { return false; }
    unsigned char* ws;
    __device__ __forceinline__ void operator()(const f32x4 (&acc)[2][2][4][2], const pg8::Unit& u, int wr, int wc, int fr, int fq) const {
        const int ct = u.p1, p = u.p2, lr0 = u.p3;
        bf16* Y = (bf16*)(ws + WS_Y); const int* LIST = (const int*)(ws + WS_LIST) + (size_t)p * T + lr0;
        const int col0 = ct * 256 + wc * 32 + 8 * fq;
#pragma unroll
        for (int ai = 0; ai < 2; ++ai)
#pragma unroll
            for (int m = 0; m < 4; ++m) { const int r = ai * 128 + wr * 64 + m * 16 + fr;
                if (r < u.nvalid) { const int tok = LIST[r]; bf16* rp = Y + (size_t)tok * 1024 + col0;
#pragma unroll
                    for (int bj = 0; bj < 2; ++bj) { const f32x4 a = acc[ai][bj][m][0], b = acc[ai][bj][m][1];
                        v4u w; w.x = cvt_pk_bf16(a[0], a[1]); w.y = cvt_pk_bf16(a[2], a[3]); w.z = cvt_pk_bf16(b[0], b[1]); w.w = cvt_pk_bf16(b[2], b[3]);
                        *(v4u*)(rp + bj * 128) = w; } } }
    }
};
__device__ __forceinline__ void phase_moe_up(Frame& F, int l) {
    LAS int* tp = (LAS int*)(F.lds + LDS_MISC_OFF + 64); LAS int* cn = tp + 32;
    moe_table(F, l, tp, cn);
    SchedMoeUp S{F_WS, tp, cn, F.G, F.vcu, __builtin_amdgcn_readfirstlane(tp[24])}; EpiMoeUp E{F_WS};
    pg8::gemm_phase<EpiMoeUp, SchedMoeUp, true>(F.lds, F.tid, 1024, S, E);
}
__device__ __forceinline__ void phase_moe_down(Frame& F, int l) {
    LAS int* tp = (LAS int*)(F.lds + LDS_MISC_OFF + 64); LAS int* cn = tp + 32;
    moe_table(F, l, tp, cn);
    SchedMoeDown S{F_WS, tp, cn, F.G, F.vcu, __builtin_amdgcn_readfirstlane(tp[24])}; EpiMoeDown E{F_WS};
    pg8::gemm_phase<EpiMoeDown, SchedMoeDown, true>(F.lds, F.tid, NEXP * DE, S, E);
}


#ifndef TP_DSAP
#define TP_DSAP 7
#endif
#ifndef TP_PHASE
#define TP_PHASE -1
#endif
__global__ void __launch_bounds__(NTHR, 2) fwd_kernel(Args args) {
    extern __shared__ __attribute__((aligned(16))) unsigned char lds[];
    Frame F;
    F.lds = (LAS unsigned char*)lds; F.wsg = (gbyte*)args.ws; F.outg = (GAS float*)args.out;
#pragma unroll
    for (int i = 0; i < 16; ++i) F.ing[i] = (GAS const float*)args.in[i];
    const int wave0 = __builtin_amdgcn_readfirstlane((int)threadIdx.x >> 6);
    F.lane = lane_id(); F.tid = wave0 * 64 + F.lane; F.wave = wave0;
    F.G = gridDim.x; { const int bx = blockIdx.x; F.vcu = (F.G % 8 == 0) ? (bx % 8) * (F.G / 8) + bx / 8 : bx; }
    volatile LAS unsigned* MISC = (volatile LAS unsigned*)(F.lds + LDS_MISC_OFF);
    for (int u = F.tid; u < 128; u += NTHR) MISC[u] = 0u;
    __syncthreads();
    XcdBarrier bar = xcd_barrier_post((gu32*)(F.wsg + WS_CTL) + CW_BAR, MISC + 8, F.tid == 0);
    const int lo = args.ph_lo, hi = args.ph_hi;
#define IN(k) (lo <= (k) && (k) < hi)
#define PB() do { gbyte* w_ = (gbyte*)args.ws; asm volatile("" : "+s"(w_)); F.wsg = w_; int t_ = wave0 * 64 + lane_id(); asm volatile("" : "+v"(t_)); F.tid = t_; F.lane = t_ & 63; F.wave = wave0; } while (0)
#define XBAR() xcd_barrier(bar, wave0 == 0 && lane_id() == 0)
#define SEAM(k) do { if (IN(k) && IN((k) + 1)) xcd_barrier(bar, wave0 == 0 && lane_id() == 0); } while (0)
    if (IN(0)) { PB(); phase_prologue_a(F); XBAR(); PB(); phase_prologue(F); } SEAM(0);
    if (TP_PHASE == 20) { PB(); phase_prologue_a(F); XBAR(); PB(); phase_prologue(F); XBAR(); }
    if (TP_PHASE == 21) { PB(); convert_moe_weights(F, 0); XBAR(); }
    if (TP_PHASE == 40) { XBAR(); XBAR(); XBAR(); XBAR(); XBAR(); XBAR(); XBAR(); XBAR(); XBAR(); XBAR(); XBAR(); XBAR(); XBAR(); XBAR(); XBAR(); XBAR(); }
#define LAYER(l) do { const int pb = 1 + 8 * (l); \
        if (IN(pb + 0)) { PB(); phase_inproj(F, (l)); } SEAM(pb + 0); \
        if (TP_PHASE == 0 && (l) == 0) { PB(); phase_inproj(F, (l)); XBAR(); } \
        if (TP_PHASE == 30 && (l) == 0) { PB(); phase_inproj_probe(F, (l)); XBAR(); } \
        if (TP_PHASE == 31 && (l) == 0) { PB(); phase_inproj_mode<1>(F, (l)); XBAR(); PB(); phase_inproj(F, (l)); XBAR(); } \
        if (TP_PHASE == 32 && (l) == 0) { PB(); phase_inproj_mode<2>(F, (l)); XBAR(); PB(); phase_inproj(F, (l)); XBAR(); } \
        if (TP_PHASE >= 11 && TP_PHASE <= 13 && (l) == 0) { PB(); phase_attention<((TP_PHASE >= 11 && TP_PHASE <= 13) ? (1 << ((TP_PHASE >= 11 ? TP_PHASE : 11) - 11)) : 7), TP_DSAP>(F, (l)); XBAR(); PB(); phase_inproj(F, (l)); XBAR(); } \
        if (IN(pb + 1)) { PB(); phase_attention(F, (l)); } SEAM(pb + 1); \
        if (TP_PHASE == 1 && (l) == 0) { PB(); phase_inproj(F, (l)); XBAR(); PB(); phase_attention(F, (l)); XBAR(); } \
        if (IN(pb + 2)) { PB(); phase_branch(F, (l)); } SEAM(pb + 2); \
        if (TP_PHASE == 2 && (l) == 0) { PB(); phase_branch(F, (l)); XBAR(); } \
        if (IN(pb + 3)) { PB(); phase_wo(F, (l)); } SEAM(pb + 3); \
        if (TP_PHASE == 3 && (l) == 0) { PB(); phase_wo(F, (l)); XBAR(); } \
        if (IN(pb + 4)) { PB(); phase_ln1_route(F, (l)); } SEAM(pb + 4); \
        if (IN(pb + 5)) { PB(); phase_moe_up(F, (l)); } SEAM(pb + 5); \
        if (TP_PHASE == 5 && (l) == 0) { PB(); phase_moe_up(F, (l)); XBAR(); } \
        if (IN(pb + 6)) { PB(); phase_moe_down(F, (l)); } SEAM(pb + 6); \
        if (TP_PHASE == 6 && (l) == 0) { PB(); phase_moe_down(F, (l)); XBAR(); } \
        if (IN(pb + 7)) { PB(); phase_ln2(F, (l)); } SEAM(pb + 7); \
    } while (0)
    LAYER(0);
    LAYER(1);
#undef LAYER
#undef IN
#undef SEAM
}

extern "C" void kernel_launch(void* const* d_in, const int* in_sizes, int n_in, void* d_out, int out_size, void* d_ws, size_t ws_size, hipStream_t stream) {
    static int grid = 0;
    if (grid == 0) {
        if (n_in != 16 || out_size != T * D || ws_size < WS_END) { fprintf(stderr, "kernel_launch: unexpected shapes (n_in %d out %d ws %zu)\n", n_in, out_size, ws_size); grid = -1; return; }
        int dev = 0, cus = 0, per_cu = 0;
        if (hipGetDevice(&dev) != hipSuccess || hipDeviceGetAttribute(&cus, hipDeviceAttributeMultiprocessorCount, dev) != hipSuccess) { grid = -1; return; }
        if (hipFuncSetAttribute((const void*)fwd_kernel, hipFuncAttributeMaxDynamicSharedMemorySize, LDS_BYTES) != hipSuccess) { fprintf(stderr, "kernel_launch: hipFuncSetAttribute failed\n"); grid = -1; return; }
        if (hipOccupancyMaxActiveBlocksPerMultiprocessor(&per_cu, (const void*)fwd_kernel, NTHR, LDS_BYTES) != hipSuccess || per_cu < 1) { fprintf(stderr, "kernel_launch: occupancy query says %d\n", per_cu); }
        (void)hipGetLastError();
        grid = cus;
    }
    if (grid < 0) return;
    (void)hipMemsetAsync((char*)d_ws + WS_CTL, 0, CTL_ZERO_BYTES, stream);
    Args a{};
    for (int i = 0; i < 16; ++i) a.in[i] = (const float*)d_in[i];
    a.out = (float*)d_out; a.ws = (unsigned char*)d_ws; a.ph_lo = 0; a.ph_hi = 1000;
    hipLaunchKernelGGL(fwd_kernel, dim3(grid), dim3(NTHR), LDS_BYTES, stream, a);
}
```

```cpp
#include <hip/hip_runtime.h>
#include <cstdio>
#include <cstdint>

#define GAS __attribute__((address_space(1)))
#define LAS __attribute__((address_space(3)))
typedef unsigned short bf16;
typedef unsigned short u16;
typedef unsigned v4u __attribute__((ext_vector_type(4)));
typedef unsigned v2u __attribute__((ext_vector_type(2)));
typedef float f32x4 __attribute__((ext_vector_type(4)));
typedef float f32x2 __attribute__((ext_vector_type(2)));
typedef float f32x16 __attribute__((ext_vector_type(16)));
typedef short bf16x8 __attribute__((ext_vector_type(8)));
typedef _Float16 f16x8 __attribute__((ext_vector_type(8)));
typedef _Float16 f16x2 __attribute__((ext_vector_type(2)));
typedef short s16x4 __attribute__((ext_vector_type(4)));
typedef GAS unsigned gu32;
#define RLX_AGENT __ATOMIC_RELAXED, __HIP_MEMORY_SCOPE_AGENT
#define LDS_WAIT() asm volatile("s_waitcnt lgkmcnt(0)" ::: "memory")
#define VM_WAIT() asm volatile("s_waitcnt vmcnt(0)" ::: "memory")

constexpr int T = 32768, SEQ = 8192, NB = 4, D = 1024, DEPTH = 2;
constexpr int N_IN = 5316, N_INP = 5376;
constexpr int C_AQ = 0, C_AC = 256, C_IQ = 384, C_IK = 640, C_IW = 704, C_BQ = 708, C_BK = 964, C_BV = 1220, C_CQ = 1476, C_CK = 1988, C_CV = 2116, C_G = 2244;
constexpr int NEXP = 16, DE = 512, NPAIR = 24;
constexpr float LN_EPS = 1e-5f;
constexpr float DN_ALPHA = 1.41421356237309515f;
constexpr float LOG2E = 1.4426950408889634f;
constexpr float SM_C = 0.125f * LOG2E;
constexpr int NWAVES = 8, NTHR = 512;

constexpr size_t MiB = 1u << 20;
constexpr size_t WS_CTL = 0, CTL_ZERO_BYTES = 1 * MiB;
constexpr size_t WS_ROPE = 1 * MiB;
constexpr size_t WS_WIN = 3 * MiB;
constexpr size_t WS_WBR = 24 * MiB;
constexpr size_t WS_WO = 28 * MiB;
constexpr size_t WS_XB = 32 * MiB;
constexpr size_t WS_ATT = 96 * MiB;
constexpr size_t WS_AQ = WS_ATT, WS_BQ = WS_AQ + 16 * MiB, WS_CQ = WS_BQ + 16 * MiB;
constexpr size_t WS_IQ = WS_CQ + 32 * MiB;
constexpr size_t WS_KAVA = WS_IQ + 16 * MiB;
constexpr size_t WS_IK = WS_KAVA + 8 * MiB;
constexpr size_t WS_BK = WS_IK + 4 * MiB, WS_BV = WS_BK + 16 * MiB;
constexpr size_t WS_CKV = WS_BV + 16 * MiB;
constexpr size_t WS_MERGED = WS_IQ;
constexpr size_t WS_H = WS_ATT;
constexpr size_t WS_GATES = 236 * MiB;
constexpr size_t WS_Y = WS_GATES;
constexpr size_t WS_MISC = 428 * MiB;
constexpr size_t WS_IW = WS_MISC;
constexpr size_t WS_KMP = WS_MISC + 1 * MiB;
constexpr size_t WS_LIST = WS_MISC + 2 * MiB;
constexpr size_t WS_CW = WS_MISC + 5 * MiB;
constexpr size_t WS_WF = WS_MISC + 11 * MiB;
constexpr size_t WS_WGU = 440 * MiB;
constexpr size_t WS_WD = 472 * MiB;
constexpr size_t WS_END = 488 * MiB;
static_assert(WS_CKV + 16 * MiB == WS_GATES && WS_MERGED + 64 * MiB <= WS_CKV + 16 * MiB && WS_CW + 6 * MiB <= WS_WGU, "ws map");
constexpr int CW_TMO = 0;
constexpr int CW_BAR = 4096;
constexpr int CW_CNT = 16384;

constexpr int RING_BYTES = 131072;
constexpr int LDS_MISC_OFF = 155648 - 512;
constexpr int LDS_BYTES = 155648;

__device__ __forceinline__ unsigned f2bf(float f) { unsigned u = __builtin_bit_cast(unsigned, f); return (u + 0x7fffu + ((u >> 16) & 1u)) >> 16; }
__device__ __forceinline__ unsigned pk2(float lo, float hi) { return f2bf(lo) | (f2bf(hi) << 16); }
typedef __bf16 bf16x2_t __attribute__((ext_vector_type(2)));
__device__ __forceinline__ unsigned cvt_pk_bf16(float lo, float hi) { f32x2 v = {lo, hi}; bf16x2_t b = __builtin_convertvector(v, bf16x2_t); return __builtin_bit_cast(unsigned, b); }
__device__ __forceinline__ unsigned pk2h(float lo, float hi) { f16x2 v; v.x = (_Float16)lo; v.y = (_Float16)hi; return __builtin_bit_cast(unsigned, v); }
__device__ __forceinline__ float bf2f(unsigned short b) { return __builtin_bit_cast(float, (unsigned)b << 16); }
__device__ __forceinline__ float bflo(unsigned w) { return __builtin_bit_cast(float, w << 16); }
__device__ __forceinline__ float bfhi(unsigned w) { return __builtin_bit_cast(float, w & 0xffff0000u); }
template <int M> __device__ __forceinline__ float xor_f(float v) { return __builtin_bit_cast(float, __builtin_amdgcn_ds_swizzle(__builtin_bit_cast(int, v), (M << 10) | 0x1f)); }
template <int M> __device__ __forceinline__ unsigned xor_u(unsigned v) { return (unsigned)__builtin_amdgcn_ds_swizzle((int)v, (M << 10) | 0x1f); }
__device__ __forceinline__ void half_swap(unsigned& a, unsigned& b) { asm volatile("v_nop\n\tv_nop\n\tv_permlane32_swap_b32 %0, %1\n\tv_nop" : "+v"(a), "+v"(b)); }
__device__ __forceinline__ float half_sum(float v) { unsigned a = __builtin_bit_cast(unsigned, v), b = a; half_swap(a, b); return __builtin_bit_cast(float, a) + __builtin_bit_cast(float, b); }
__device__ __forceinline__ float half_max(float v) { unsigned a = __builtin_bit_cast(unsigned, v), b = a; half_swap(a, b); return fmaxf(__builtin_bit_cast(float, a), __builtin_bit_cast(float, b)); }
template <int CTRL> __device__ __forceinline__ float dpp_f(float v) { return __builtin_bit_cast(float, __builtin_amdgcn_update_dpp(0, __builtin_bit_cast(int, v), CTRL, 0xf, 0xf, false)); }
__device__ __forceinline__ float row_sum(float v) { v += dpp_f<0xB1>(v); v += dpp_f<0x4E>(v); v += dpp_f<0x141>(v); v += dpp_f<0x140>(v); return v; }
__device__ __forceinline__ float row_max(float v) { v = fmaxf(v, dpp_f<0xB1>(v)); v = fmaxf(v, dpp_f<0x4E>(v)); v = fmaxf(v, dpp_f<0x141>(v)); v = fmaxf(v, dpp_f<0x140>(v)); return v; }
__device__ __forceinline__ float wave_sum(float v) { v = row_sum(v); v += xor_f<16>(v); return half_sum(v); }
__device__ __forceinline__ float wave_max(float v) { v = row_max(v); v = fmaxf(v, xor_f<16>(v)); return half_max(v); }
__device__ __forceinline__ long ik_off(int key, int piece) { return ((long)(key >> 5) * 8 + piece) * 256 + (key & 31) * 8; }
__device__ __forceinline__ long bk_off(int h, long row, int piece) { return (((long)h * (T / 32) + (row >> 5)) * 8 + piece) * 256 + (row & 31) * 8; }
__device__ __forceinline__ int lane_id() { int r; asm volatile("v_mbcnt_lo_u32_b32 %0, -1, 0\n\tv_mbcnt_hi_u32_b32 %0, -1, %0" : "=v"(r)); return r; }
__device__ __forceinline__ float sigmoidf_(float x) { return __builtin_amdgcn_rcpf(1.0f + __builtin_amdgcn_exp2f(-LOG2E * x)); }

namespace pg8 {
constexpr int BM = 256, BK = 64, HALF = 128, HTB = HALF * BK * 2, STAGE_BYTES = 8 * HTB;
__host__ __device__ __forceinline__ int lds_byte(int r, int c) { const int st = (r >> 4) * 2 + (c >> 5), rr = r & 15, cc = c & 31, ob = rr * 64 + cc * 2; return st * 1024 + (ob ^ (((ob >> 9) & 1) << 5)); }
__host__ __device__ __forceinline__ void stage_rc(int b, int& R, int& C) { const int st = b / 1024, sb = b % 1024, swz = sb ^ (((sb >> 9) & 1) << 5); R = (st >> 1) * 16 + swz / 64; C = (st & 1) * 32 + (swz % 64) / 2; }
__host__ __device__ __forceinline__ int perm32(int rho) { const int n = rho >> 4, i = rho & 15; return 8 * (i >> 2) + 4 * n + (i & 3); }

struct Unit { const char* A; const char* B; const int* rowlist; int nvalid; int lda; int nt; int ksplit; long bdelta; int p0, p1, p2, p3; };

template <class Epi, class Sched, bool ALIGN_EPI>
__device__ __forceinline__ void gemm_phase(LAS unsigned char* lds, int tid, int ldb, const Sched& S, const Epi& E) {
    const int wid = __builtin_amdgcn_readfirstlane(tid >> 6), lane = tid & 63, wr = wid >> 2, wc = wid & 3, fr = lane & 15, fq = lane >> 4;
    int R0, C0; stage_rc(tid * 16, R0, C0);
    const int Rb0 = Epi::PERM ? ((R0 & ~31) + perm32(R0 & 31)) : R0;
    unsigned voffB[2];
    voffB[0] = (unsigned)(Rb0 * ldb + C0) * 2u; voffB[1] = (unsigned)((Rb0 + 64) * ldb + C0) * 2u;
    const size_t kstep = (size_t)(BK * 2);
    const size_t hstepB = (size_t)HALF * ldb * 2;
    const unsigned ldsw = (unsigned)wid * 1024u;
    const int aoff = lds_byte(wr * 64 + fr, fq * 8), boff = lds_byte(wc * 32 + fr, fq * 8);
#define PG8_SA(b, h) (((b) * 2 + (h)) * HTB)
#define PG8_SB(b, h) ((4 + (b) * 2 + (h)) * HTB)
#define PG8_STAGEB(bufoff, gbase) do { _Pragma("unroll") for (int _i = 0; _i < 2; ++_i) \
        __builtin_amdgcn_global_load_lds((const unsigned*)((const char*)(gbase) + voffB[_i]), (LAS unsigned*)(lds + (bufoff) + ldsw + _i * 8192), 16, 0, 0); } while (0)
#define PG8_STAGEA(bufoff, gbase, vo, h) do { \
        __builtin_amdgcn_global_load_lds((const unsigned*)((const char*)(gbase) + vo##h##0), (LAS unsigned*)(lds + (bufoff) + ldsw), 16, 0, 0); \
        __builtin_amdgcn_global_load_lds((const unsigned*)((const char*)(gbase) + vo##h##1), (LAS unsigned*)(lds + (bufoff) + ldsw + 8192), 16, 0, 0); } while (0)
#define PG8_LDA(dst, b, h) do { _Pragma("unroll") for (int m = 0; m < 4; ++m) _Pragma("unroll") for (int k = 0; k < 2; ++k) dst[m][k] = *(const LAS bf16x8*)(lds + PG8_SA(b, h) + aoff + m * 2048 + k * 1024); } while (0)
#define PG8_LDB(dst, b, h) do { _Pragma("unroll") for (int n = 0; n < 2; ++n) _Pragma("unroll") for (int k = 0; k < 2; ++k) dst[n][k] = *(const LAS bf16x8*)(lds + PG8_SB(b, h) + boff + n * 2048 + k * 1024); } while (0)
#define PG8_MMA(ai, bj, At, Bt) do { __builtin_amdgcn_s_setprio(1); _Pragma("unroll") for (int m = 0; m < 4; ++m) _Pragma("unroll") for (int n = 0; n < 2; ++n) _Pragma("unroll") for (int k = 0; k < 2; ++k) \
        acc[ai][bj][m][n] = __builtin_amdgcn_mfma_f32_16x16x32_bf16(Bt[n][k], At[m][k], acc[ai][bj][m][n], 0, 0, 0); __builtin_amdgcn_s_setprio(0); } while (0)
#define PG8_WAIT_V(n) asm volatile("s_waitcnt vmcnt(" #n ")" ::: "memory")
#define PG8_WAIT_L(n) asm volatile("s_waitcnt lgkmcnt(" #n ")" ::: "memory")
#define PG8_BAR __builtin_amdgcn_s_barrier()
#define PG8_SCHED __builtin_amdgcn_sched_barrier(0)
#define PG8_BK(u, tt) ((u).B + (size_t)(tt) * kstep + (((tt) >= (u).ksplit) ? (u).bdelta : 0))
#define PG8_VOFF1(u, dst, rr) do { const int _r = (rr) + R0; int _g = _r; if ((u).rowlist) { _g = (u).rowlist[(_r < (u).nvalid) ? _r : 0]; } dst = (unsigned)(_g * (u).lda + C0) * 2u; } while (0)
#define PG8_VOFFA(u, vo) do { PG8_VOFF1(u, vo##00, 0); PG8_VOFF1(u, vo##01, 64); PG8_VOFF1(u, vo##10, 128); PG8_VOFF1(u, vo##11, 192); } while (0)
    Unit cur, nxt; int ui = 0;
    if (!S.next(0, cur)) return;
    f32x4 acc[2][2][4][2];
#pragma unroll
    for (int a = 0; a < 2; ++a)
#pragma unroll
        for (int b = 0; b < 2; ++b)
#pragma unroll
            for (int m = 0; m < 4; ++m)
#pragma unroll
                for (int n = 0; n < 2; ++n) acc[a][b][m][n] = (f32x4){0.f, 0.f, 0.f, 0.f};
    bf16x8 At[4][2], B0[2][2], B1[2][2];
    unsigned cvo00, cvo01, cvo10, cvo11;
    LAS v4u* park = (LAS v4u*)(lds + STAGE_BYTES) + tid;
    PG8_VOFFA(cur, cvo);
    {
        const char* cA = cur.A; const char* b0 = PG8_BK(cur, 0); const char* b1 = PG8_BK(cur, 1);
        PG8_STAGEB(PG8_SB(0, 0), b0); PG8_STAGEB(PG8_SB(0, 1), b0 + hstepB); PG8_STAGEA(PG8_SA(0, 0), cA, cvo, 0); PG8_STAGEA(PG8_SA(0, 1), cA, cvo, 1);
        if (wr == 1) PG8_BAR;
        PG8_WAIT_V(2); PG8_BAR;
        PG8_STAGEB(PG8_SB(1, 0), b1); PG8_STAGEA(PG8_SA(1, 0), cA + kstep, cvo, 0); PG8_STAGEB(PG8_SB(1, 1), b1 + hstepB);
        PG8_WAIT_V(6); PG8_BAR;
    }
    for (;;) {
        const bool has_next = S.next(ui + 1, nxt);
        if (!has_next) nxt = cur;
        { unsigned nvo00, nvo01, nvo10, nvo11; PG8_VOFFA(nxt, nvo); *park = (v4u){nvo00, nvo01, nvo10, nvo11}; }
        const int nt = cur.nt;
        const char* cA = cur.A;
        for (int t = 0; t < nt; t += 2) {
            const bool last = (t == nt - 2);
            const char* a1 = cA + (size_t)(t + 1) * kstep;
            const char* a2 = last ? nxt.A : cA + (size_t)(t + 2) * kstep;
            const char* a3 = a2 + kstep;
            const char* b2 = last ? PG8_BK(nxt, 0) : PG8_BK(cur, t + 2);
            const char* b3 = last ? PG8_BK(nxt, 1) : PG8_BK(cur, t + 3);
            unsigned vo200 = cvo00, vo201 = cvo01, vo210 = cvo10, vo211 = cvo11;
            if (last) { const v4u nv = *park; vo200 = nv.x; vo201 = nv.y; vo210 = nv.z; vo211 = nv.w; }
            PG8_LDB(B0, 0, 0); PG8_LDB(B1, 0, 1); PG8_SCHED; PG8_LDA(At, 0, 0); PG8_STAGEA(PG8_SA(1, 1), a1, cvo, 1);
            PG8_WAIT_V(8); PG8_WAIT_L(0); PG8_BAR; PG8_MMA(0, 0, At, B0); PG8_MMA(0, 1, At, B1); PG8_BAR; PG8_SCHED;
            PG8_LDA(At, 0, 1); PG8_STAGEB(PG8_SB(0, 0), b2); PG8_STAGEB(PG8_SB(0, 1), b2 + hstepB); PG8_STAGEA(PG8_SA(0, 0), a2, vo2, 0);
            PG8_WAIT_V(8); PG8_WAIT_L(0); PG8_BAR; PG8_MMA(1, 0, At, B0); PG8_MMA(1, 1, At, B1); PG8_BAR; PG8_SCHED;
            PG8_LDB(B0, 1, 0); PG8_LDB(B1, 1, 1); PG8_SCHED; PG8_LDA(At, 1, 0); PG8_STAGEA(PG8_SA(0, 1), a2, vo2, 1);
            PG8_WAIT_V(8); PG8_WAIT_L(0); PG8_BAR; PG8_MMA(0, 0, At, B0); PG8_MMA(0, 1, At, B1); PG8_BAR; PG8_SCHED;
            PG8_LDA(At, 1, 1); PG8_STAGEB(PG8_SB(1, 0), b3); PG8_STAGEB(PG8_SB(1, 1), b3 + hstepB); PG8_STAGEA(PG8_SA(1, 0), a3, vo2, 0);
            PG8_WAIT_V(8); PG8_WAIT_L(0); PG8_BAR; PG8_MMA(1, 0, At, B0); PG8_MMA(1, 1, At, B1); PG8_BAR; PG8_SCHED;
        }
        if constexpr (ALIGN_EPI) { if (wr == 0) PG8_BAR; }
        E(acc, cur, wr, wc, fr, fq);
        if (!has_next) break;
        if (!Epi::keep_acc(cur))
#pragma unroll
        for (int a = 0; a < 2; ++a)
#pragma unroll
            for (int b = 0; b < 2; ++b)
#pragma unroll
                for (int m = 0; m < 4; ++m)
#pragma unroll
                    for (int n = 0; n < 2; ++n) acc[a][b][m][n] = (f32x4){0.f, 0.f, 0.f, 0.f};
        cur = nxt; ++ui;
        { const v4u nv = *park; cvo00 = nv.x; cvo01 = nv.y; cvo10 = nv.z; cvo11 = nv.w; }
        if constexpr (ALIGN_EPI) { if (wr == 1) PG8_BAR; }
    }
    PG8_WAIT_V(0);
    if constexpr (!ALIGN_EPI) { if (wr == 0) PG8_BAR; }
    PG8_BAR;
#undef PG8_SA
#undef PG8_SB
#undef PG8_STAGEA
#undef PG8_STAGEB
#undef PG8_LDA
#undef PG8_LDB
#undef PG8_MMA
#undef PG8_WAIT_V
#undef PG8_WAIT_L
#undef PG8_BAR
#undef PG8_SCHED
#undef PG8_BK
#undef PG8_VOFFA
}
}

#define XB_TMO      128
#define XB_XCNT(j)  (256  + 64 * (j))
#define XB_XSUB(j)  (1280 + 64 * (j))
#define XB_XGEN(j)  (2304 + 64 * (j))
#define XB_TOP      3328
#define XB_TOPGEN   3392
#define XCD_BAR_WORDS 3456
#define XB_SPIN_CAP (1u << 20)
__device__ __forceinline__ unsigned xb_ld(gu32* p)              { return __hip_atomic_load(p, __ATOMIC_RELAXED, __HIP_MEMORY_SCOPE_AGENT); }
__device__ __forceinline__ unsigned xb_add(gu32* p, unsigned v) { return __hip_atomic_fetch_add(p, v, __ATOMIC_RELAXED, __HIP_MEMORY_SCOPE_AGENT); }
__device__ __forceinline__ unsigned xb_xcc_id() { return (unsigned)__builtin_amdgcn_s_getreg((3 << 11) | 20) & 0xFu; }
#define XB_SPIN(cond, bar) do { unsigned _sp = 0; while (cond) { __builtin_amdgcn_s_sleep(1); \
    if ((++_sp & 255u) == 0u) { if (xb_ld(&(bar)[XB_TMO])) break; if (_sp > XB_SPIN_CAP) { (void)xb_add(&(bar)[XB_TMO], 1u); break; } } } } while (0)
struct XcdBarrier { gu32* bar; unsigned x; volatile LAS unsigned* st; };
__device__ __forceinline__ XcdBarrier xcd_barrier_post(gu32* bar, volatile LAS unsigned* st, bool leader) {
    XcdBarrier b; b.bar = bar; b.x = xb_xcc_id(); b.st = st;
    if (leader) (void)xb_add(&bar[XB_XCNT(b.x)], 1u);
    return b;
}
__device__ __forceinline__ void xcd_barrier_complete(gu32* bar, unsigned x, unsigned& nloc, unsigned& nx) {
    const unsigned G = gridDim.x * gridDim.y * gridDim.z;
    unsigned sum, cnt, mine, sp = 0u;
    for (;;) {
        sum = 0u; cnt = 0u; mine = 0u;
#pragma unroll
        for (unsigned j = 0; j < 16; ++j) { const unsigned c = xb_ld(&bar[XB_XCNT(j)]); sum += c; cnt += (c > 0u) ? 1u : 0u; mine = (j == x) ? c : mine; }
        if (sum == G) break;
        __builtin_amdgcn_s_sleep(1);
        if ((++sp & 255u) == 0u) { if (xb_ld(&bar[XB_TMO])) break; if (sp > XB_SPIN_CAP) { (void)xb_add(&bar[XB_TMO], 1u); break; } }
    }
    nloc = mine > 0u ? mine : 1u; nx = cnt > 0u ? cnt : 1u;
}
__device__ __forceinline__ void xcd_barrier(const XcdBarrier& b, bool leader) {
    asm volatile("s_waitcnt vmcnt(0)" ::: "memory");
    __syncthreads();
    if (leader) {
        gu32* bar = b.bar; asm volatile("" : "+s"(bar));
        __builtin_amdgcn_s_waitcnt(0);
        unsigned nloc = b.st[0], nx = b.st[1];
        if (nloc == 0u) { xcd_barrier_complete(bar, b.x, nloc, nx); b.st[0] = nloc; b.st[1] = nx; }
        const unsigned old = xb_add(&bar[XB_XSUB(b.x)], 1u);
        const unsigned gen = old / nloc;
        if (old + 1u == (gen + 1u) * nloc) {
            __builtin_amdgcn_fence(__ATOMIC_RELEASE, "agent");
            asm volatile("s_waitcnt vmcnt(0)" ::: "memory");
            const unsigned og = xb_add(&bar[XB_TOP], 1u);
            const unsigned tg = og / nx;
            if (og + 1u == (tg + 1u) * nx) xb_add(&bar[XB_TOPGEN], 1u);
            else XB_SPIN(xb_ld(&bar[XB_TOPGEN]) == tg, bar);
            __builtin_amdgcn_fence(__ATOMIC_ACQUIRE, "agent");
            xb_add(&bar[XB_XGEN(b.x)], 1u);
            asm volatile("s_waitcnt vmcnt(0)" ::: "memory");
        } else {
            XB_SPIN(xb_ld(&bar[XB_XGEN(b.x)]) == gen, bar);
            __builtin_amdgcn_fence(__ATOMIC_ACQUIRE, "agent");
            asm volatile("s_waitcnt vmcnt(0)" ::: "memory");
        }
    }
    __syncthreads();
}

struct Args { const float* in[16]; float* out; unsigned char* ws; int ph_lo, ph_hi; };
enum { I_X = 0, I_WIN, I_UK, I_UV, I_SINK, I_WBR, I_WO, I_LN1G, I_LN1B, I_RW, I_RB, I_MG, I_MU, I_MD, I_LN2G, I_LN2B };

typedef GAS unsigned char gbyte;
struct Frame {
    LAS unsigned char* lds;
    gbyte* wsg;
    GAS const float* ing[16];
    GAS float* outg;
    int tid, lane, wave, vcu, G;
};
#define F_WS ((unsigned char*)F.wsg)
#define F_IN(i) ((const float*)F.ing[i])
#define F_OUT ((float*)F.outg)

template <class F>
__device__ __forceinline__ void transpose_item(bf16* WT, int ldk, int row0, int k0, LAS float* scr, int lane, const F& val) {
    float tv[32];
#pragma unroll
    for (int i = 0; i < 32; ++i) tv[i] = val(k0 + 2 * i + (lane >> 5), row0 + (lane & 31));
#pragma unroll
    for (int i = 0; i < 32; ++i) scr[(2 * i + (lane >> 5)) * 33 + (lane & 31)] = tv[i];
    LDS_WAIT(); asm volatile("" ::: "memory");
    const int c = lane & 7;
#pragma unroll
    for (int j = 0; j < 4; ++j) { const int n = (lane >> 3) + 8 * j; const LAS float* s = scr + (8 * c) * 33 + n;
        v4u o; o.x = pk2(s[0 * 33], s[1 * 33]); o.y = pk2(s[2 * 33], s[3 * 33]); o.z = pk2(s[4 * 33], s[5 * 33]); o.w = pk2(s[6 * 33], s[7 * 33]);
        *(GAS v4u*)(WT + (size_t)(row0 + n) * ldk + k0 + 8 * c) = o; }
    LDS_WAIT(); asm volatile("" ::: "memory");
}
__device__ __forceinline__ int rope_dim(int p) { return (p >> 1) + 32 * (p & 1); }

__device__ __forceinline__ int win_src(int s) {
    const int tile = s >> 8, u = s & 255;
    switch (tile) {
        case 0: return C_AQ + (u & ~63) + rope_dim(u & 63);
        case 1: return C_IQ + (u & ~63) + rope_dim(u & 63);
        case 2: if (u < 64) return -2 - rope_dim(u); if (u < 128) return -100 - (u - 64); if (u < 192) return C_IK + rope_dim(u - 128); if (u < 196) return C_IW + (u - 192); return -1;
        case 3: return C_BQ + (u & ~63) + rope_dim(u & 63);
        case 4: return C_BK + (u & ~63) + rope_dim(u & 63);
        case 5: return C_BV + u;
        case 6: return C_CQ + (u & ~63) + rope_dim(u & 63);
        case 7: return C_CQ + 256 + (u & ~63) + rope_dim(u & 63);
        case 8: if (u < 128) return C_CK + (u & ~63) + rope_dim(u & 63); return C_CV + (u - 128);
        default: return C_G + (s - 2304);
    }
}

__device__ __forceinline__ void phase_prologue_a(Frame& F) {
    const int gw = F.vcu * NWAVES + F.wave, NGW = F.G * NWAVES;
    {
        float* WFp = (float*)(F_WS + WS_WF);
        for (int i = gw * 64 + F.lane; i < DEPTH * 1024 * 128; i += NGW * 64) {
            const int l = i >> 17, k = (i >> 7) & 1023, c = i & 127;
            const float* W = F_IN(I_WIN) + (size_t)l * D * N_IN + (size_t)k * N_IN + C_AC;
            const float* U = (c < 64 ? F_IN(I_UK) : F_IN(I_UV)) + (size_t)l * 128 * 64 + (c & 63);
            float a = 0.f;
#pragma unroll 32
            for (int r = 0; r < 128; ++r) a = fmaf(W[r], U[r * 64], a);
            WFp[i] = a;
        }
    }
    {
        float* COS = (float*)(F_WS + WS_ROPE); float* SIN = COS + SEQ * 32;
        const float inv = 1.0f / (float)pow(10000.0, (double)(2 * (F.lane & 31)) / 64.0);
        for (int i = gw * 64 + F.lane; i < SEQ * 32; i += NGW * 64) {
            const int pos = i >> 5;
            const float ang = (float)pos * inv;
            COS[i] = (float)cos((double)ang); SIN[i] = (float)sin((double)ang);
        }
    }
    {
        const f32x4* x4 = (const f32x4*)F_IN(I_X); v2u* xb = (v2u*)(F_WS + WS_XB);
        const size_t n4 = (size_t)T * D / 4, st = (size_t)NGW * 64; size_t i = (size_t)gw * 64 + F.lane;
        for (; i + 7 * st < n4; i += 8 * st) {
            f32x4 v[8];
#pragma unroll
            for (int u = 0; u < 8; ++u) v[u] = x4[i + u * st];
#pragma unroll
            for (int u = 0; u < 8; ++u) { v2u o; o.x = pk2(v[u].x, v[u].y); o.y = pk2(v[u].z, v[u].w); xb[i + u * st] = o; }
        }
        for (; i < n4; i += st) { const f32x4 v = x4[i]; v2u o; o.x = pk2(v.x, v.y); o.y = pk2(v.z, v.w); xb[i] = o; }
    }
}
__device__ __forceinline__ void phase_prologue(Frame& F) {
    LAS float* scr = (LAS float*)(F.lds + F.wave * 16384);
    const int gw = F.vcu * NWAVES + F.wave, NGW = F.G * NWAVES;
    constexpr int I_WINL = (N_INP / 32) * (D / 64);
    constexpr int I_BRL = (1024 / 32) * (1024 / 64);
    constexpr int I_WOL = (1024 / 32) * (1024 / 64);
    constexpr int NITEMS = DEPTH * (I_WINL + I_BRL + I_WOL);
    for (int it = gw; it < NITEMS; it += NGW) {
        int r = it; const int l = r / (I_WINL + I_BRL + I_WOL); r -= l * (I_WINL + I_BRL + I_WOL);
        if (r < I_WINL) {
            const float* W = F_IN(I_WIN) + (size_t)l * D * N_IN; const float* WFp = (const float*)(F_WS + WS_WF);
            bf16* WT = (bf16*)(F_WS + WS_WIN) + (size_t)l * N_INP * D;
            const int rg = r / 16, kc = r % 16;
            const int c = win_src(rg * 32 + (F.lane & 31));
            const int cc = (c > -100) ? (-2 - c) : (64 + (-100 - c));
            const float* sb = (c >= 0) ? (W + c) : (WFp + (size_t)l * 1024 * 128 + (c == -1 ? 0 : cc));
            const long sst = (c >= 0) ? (long)N_IN : 128L; const float sm = (c == -1) ? 0.f : 1.f;
            transpose_item(WT, D, rg * 32, kc * 64, scr, F.lane, [&](int k, int row) -> float { return sb[(size_t)k * sst] * sm; });
            continue; }
        r -= I_WINL;
        if (r < I_BRL) {
            const float* W = F_IN(I_WBR) + (size_t)l * 1024 * 1024; bf16* WT = (bf16*)(F_WS + WS_WBR) + (size_t)l * 1024 * 1024;
            const int rg = r / 16, kc = r % 16;
            transpose_item(WT, 1024, rg * 32, kc * 64, scr, F.lane, [&](int k, int row) -> float { return W[(size_t)k * 1024 + row]; });
            continue; }
        r -= I_BRL;
        {
            const float* W = F_IN(I_WO) + (size_t)l * 1024 * 1024; bf16* WT = (bf16*)(F_WS + WS_WO) + (size_t)l * 1024 * 1024;
            const int rg = r / 16, kc = r % 16;
            transpose_item(WT, 1024, rg * 32, kc * 64, scr, F.lane, [&](int k, int row) -> float { return W[(size_t)k * 1024 + row]; });
        }
    }
}

__device__ __forceinline__ void convert_moe_weights(Frame& F, int l) {
    LAS float* scr = (LAS float*)(F.lds + F.wave * 16384);
    const int gw = F.vcu * NWAVES + F.wave, NGW = F.G * NWAVES;
    constexpr int I_GU = NEXP * (1024 / 32) * (1024 / 64);
    constexpr int I_D = NEXP * (1024 / 32) * (512 / 64);
    const float* WG = F_IN(I_MG) + (size_t)l * NEXP * D * DE; const float* WU = F_IN(I_MU) + (size_t)l * NEXP * D * DE; const float* WD = F_IN(I_MD) + (size_t)l * NEXP * DE * D;
    for (int it = gw; it < I_GU + I_D; it += NGW) {
        if (it < I_GU) {
            const int e = it / 512, r = it % 512, rg = r / 16, kc = r % 16;
            bf16* WT = (bf16*)(F_WS + WS_WGU) + (size_t)e * 1024 * 1024;
            const float* g = WG + (size_t)e * D * DE; const float* u = WU + (size_t)e * D * DE;
            transpose_item(WT, 1024, rg * 32, kc * 64, scr, F.lane, [&](int k, int row) -> float { const int j = 4 * (row >> 3) + (row & 3); return (row & 4) ? u[(size_t)k * DE + j] : g[(size_t)k * DE + j]; });
        } else {
            const int r0 = it - I_GU, e = r0 / 256, r = r0 % 256, rg = r / 8, kc = r % 8;
            bf16* WT = (bf16*)(F_WS + WS_WD) + (size_t)e * DE;
            const float* w = WD + (size_t)e * DE * D;
            transpose_item(WT, NEXP * DE, rg * 32, kc * 64, scr, F.lane, [&](int k, int row) -> float { return w[(size_t)k * D + row]; });
        }
    }
}

struct SchedDense {
    const char* A; const char* B; int lda, lda_b, ldb_b, nN, nt, G, vcu, ntiles;
    __device__ __forceinline__ bool next(int i, pg8::Unit& u) const {
        const int L = i * G + vcu; if (L >= ntiles) return false;
        const int per_grp = 8 * nN, grp = L / per_grp, w = L % per_grp, pn = w / 8, pm = grp * 8 + (w % 8);
        u.A = A + (size_t)pm * lda_b; u.B = B + (size_t)pn * ldb_b; u.rowlist = nullptr; u.nvalid = 256; u.lda = lda; u.nt = nt; u.ksplit = 1 << 30; u.bdelta = 0; u.p0 = pm; u.p1 = pn; u.p2 = 0; u.p3 = 0; return true;
    }
};

template <int EMODE = 0> struct EpiInProjT {
    static constexpr bool PERM = true;
    static __device__ __forceinline__ bool keep_acc(const pg8::Unit&) { return false; }
    unsigned char* ws;
    __device__ __forceinline__ void operator()(const f32x4 (&acc)[2][2][4][2], const pg8::Unit& u, int wr, int wc, int fr, int fq) const {
        const int pm = u.p0, pn = u.p1;
        const float* COS = (const float*)(ws + WS_ROPE); const float* SIN = COS + SEQ * 32;
        const int row0 = pm * 256 + wr * 64 + fr;
        float ksum[2][8];
#pragma unroll
        for (int bj = 0; bj < 2; ++bj)
#pragma unroll
            for (int e = 0; e < 8; ++e) ksum[bj][e] = 0.f;
        f32x4 rcs[2][4], rsn[2][4];
        if (pn <= 8) {
            const int j0 = ((wc * 32 + 8 * fq) & 63) >> 1;
#pragma unroll
            for (int ai = 0; ai < 2; ++ai)
#pragma unroll
                for (int m = 0; m < 4; ++m) { const int pos = (row0 + ai * 128 + m * 16) & (SEQ - 1); rcs[ai][m] = *(const f32x4*)(COS + pos * 32 + j0); rsn[ai][m] = *(const f32x4*)(SIN + pos * 32 + j0); }
        }
#pragma unroll
        for (int ai = 0; ai < 2; ++ai)
#pragma unroll
            for (int m = 0; m < 4; ++m) {
                const int row = row0 + ai * 128 + m * 16; const int pos = row & (SEQ - 1);
#pragma unroll
                for (int bj = 0; bj < 2; ++bj) {
                    const int cl = bj * 128 + wc * 32 + 8 * fq;
                    float v[8];
#pragma unroll
                    for (int e = 0; e < 4; ++e) { v[e] = acc[ai][bj][m][0][e]; v[4 + e] = acc[ai][bj][m][1][e]; }
                    int kind;
                    unsigned char* obase; int pitch, ocol;
                    if (pn == 0) { kind = 1; obase = ws + WS_AQ; pitch = 256; ocol = cl; }
                    else if (pn == 1) { kind = 2; obase = ws + WS_IQ; pitch = 256; ocol = cl; }
                    else if (pn == 2) {
                        if (cl < 64) { kind = 1; obase = ws + WS_KAVA; pitch = 128; ocol = cl; }
                        else if (cl < 128) { kind = 0; obase = ws + WS_KAVA; pitch = 128; ocol = cl; }
                        else if (cl < 192) { kind = 2; obase = ws + WS_IK; pitch = 64; ocol = cl - 128; }
                        else if (cl == 192) { kind = 4; obase = ws + WS_IW; pitch = 4; ocol = 0; }
                        else { kind = 5; obase = ws; pitch = 0; ocol = 0; }
                    }
                    else if (pn == 3) { kind = 1; obase = ws + WS_BQ; pitch = 256; ocol = cl; }
                    else if (pn == 4) { kind = 1; obase = ws + WS_BK; pitch = 256; ocol = cl; }
                    else if (pn == 5) { kind = 0; obase = ws + WS_BV; pitch = 256; ocol = cl; }
                    else if (pn == 6) { kind = 1; obase = ws + WS_CQ; pitch = 512; ocol = cl; }
                    else if (pn == 7) { kind = 1; obase = ws + WS_CQ; pitch = 512; ocol = 256 + cl; }
                    else if (pn == 8) { kind = (cl < 128) ? 1 : 0; obase = ws + WS_CKV; pitch = 256; ocol = cl; }
                    else { kind = 3; obase = ws + WS_GATES; pitch = 3072; ocol = (pn - 9) * 256 + cl; }
                    if ((kind == 1 || kind == 2) && !(EMODE & 1)) {
                        const f32x4 cs = rcs[ai][m], sn = rsn[ai][m];
#pragma unroll
                        for (int e = 0; e < 4; ++e) { const float t1 = v[2 * e], t2 = v[2 * e + 1]; v[2 * e] = t1 * cs[e] - t2 * sn[e]; v[2 * e + 1] = t2 * cs[e] + t1 * sn[e]; }
                    }
                    if (kind == 3) {
                        unsigned q0 = 0u, q1 = 0u;
#pragma unroll
                        for (int e = 0; e < 4; ++e) {
                            q0 = __builtin_amdgcn_cvt_pk_u8_f32(__builtin_amdgcn_fmed3f(sigmoidf_(v[e]) * 255.0f, 1.0f, 255.0f), e, q0);
                            q1 = __builtin_amdgcn_cvt_pk_u8_f32(__builtin_amdgcn_fmed3f(sigmoidf_(v[4 + e]) * 255.0f, 1.0f, 255.0f), e, q1); }
                        *(v2u*)(obase + (size_t)row * pitch + ocol) = (v2u){q0, q1};
                    }
                    if (pn == 4) {
#pragma unroll
                        for (int e = 0; e < 8; ++e) ksum[bj][e] += v[e];
                    }
                    if (kind == 0 || kind == 1) {
                        v4u w; w.x = cvt_pk_bf16(v[0], v[1]); w.y = cvt_pk_bf16(v[2], v[3]); w.z = cvt_pk_bf16(v[4], v[5]); w.w = cvt_pk_bf16(v[6], v[7]);
                        if (pn == 4) *(v4u*)((bf16*)obase + bk_off(cl >> 6, row, (cl & 63) >> 3)) = w;
                        else *(v4u*)((bf16*)obase + (size_t)row * pitch + ocol) = w;
                    } else if (kind == 2) {
                        v4u w; w.x = pk2h(v[0], v[1]); w.y = pk2h(v[2], v[3]); w.z = pk2h(v[4], v[5]); w.w = pk2h(v[6], v[7]);
                        if (pn == 2) *(v4u*)((u16*)obase + ik_off(row, ocol >> 3)) = w;
                        else *(v4u*)((u16*)obase + (size_t)row * pitch + ocol) = w;
                    } else if (kind == 4) {
                        *(f32x4*)((float*)obase + (size_t)row * 4) = (f32x4){v[0], v[1], v[2], v[3]};
                    }
                }
            }
        if (pn == 4) {
            float* KMP = (float*)(ws + WS_KMP) + (size_t)(pm * 2 + wr) * 256;
#pragma unroll
            for (int bj = 0; bj < 2; ++bj)
#pragma unroll
                for (int e = 0; e < 8; ++e) { float s = ksum[bj][e]; s += xor_f<1>(s); s += xor_f<2>(s); s += xor_f<4>(s); s += xor_f<8>(s); ksum[bj][e] = s; }
            if (fr == 0) {
#pragma unroll
                for (int bj = 0; bj < 2; ++bj) { float* o = KMP + bj * 128 + wc * 32 + 8 * fq;
                    *(f32x4*)o = (f32x4){ksum[bj][0], ksum[bj][1], ksum[bj][2], ksum[bj][3]}; *(f32x4*)(o + 4) = (f32x4){ksum[bj][4], ksum[bj][5], ksum[bj][6], ksum[bj][7]}; }
            }
        }
    }
};

typedef EpiInProjT<0> EpiInProj;
struct EpiNone { static constexpr bool PERM = true; static __device__ __forceinline__ bool keep_acc(const pg8::Unit&) { return false; }
    float* sink; __device__ __forceinline__ void operator()(const f32x4 (&acc)[2][2][4][2], const pg8::Unit& u, int wr, int wc, int fr, int fq) const { float s = 0.f;
#pragma unroll
        for (int a = 0; a < 2; ++a)
#pragma unroll
            for (int b = 0; b < 2; ++b)
#pragma unroll
                for (int m = 0; m < 4; ++m)
#pragma unroll
                    for (int n = 0; n < 2; ++n) s += (acc[a][b][m][n][0] + acc[a][b][m][n][1]) + (acc[a][b][m][n][2] + acc[a][b][m][n][3]);
        if (s == 1.2345e-30f) sink[0] = 1.f; } };
__device__ __forceinline__ void phase_inproj_probe(Frame& F, int l) {
    SchedDense S; S.A = (const char*)(F_WS + WS_XB); S.B = (const char*)(F_WS + WS_WIN) + (size_t)l * N_INP * D * 2; S.lda = D; S.lda_b = 256 * D * 2; S.ldb_b = 256 * D * 2; S.nN = N_INP / 256; S.nt = D / 64; S.G = F.G; S.vcu = F.vcu; S.ntiles = (T / 256) * (N_INP / 256);
    EpiNone E{(float*)(F_WS + WS_CTL) + 8};
    pg8::gemm_phase<EpiNone, SchedDense, true>(F.lds, F.tid, D, S, E);
}
template <int EMODE> __device__ __forceinline__ void phase_inproj_mode(Frame& F, int l) {
    SchedDense S; S.A = (const char*)(F_WS + WS_XB); S.B = (const char*)(F_WS + WS_WIN) + (size_t)l * N_INP * D * 2; S.lda = D; S.lda_b = 256 * D * 2; S.ldb_b = 256 * D * 2; S.nN = N_INP / 256; S.nt = D / 64; S.G = F.G; S.vcu = F.vcu; S.ntiles = (T / 256) * (N_INP / 256);
    EpiInProjT<EMODE> E{F_WS};
    pg8::gemm_phase<EpiInProjT<EMODE>, SchedDense, true>(F.lds, F.tid, D, S, E);
}
__device__ __forceinline__ void phase_inproj(Frame& F, int l) {
    SchedDense S; S.A = (const char*)(F_WS + WS_XB); S.B = (const char*)(F_WS + WS_WIN) + (size_t)l * N_INP * D * 2; S.lda = D; S.lda_b = 256 * D * 2; S.ldb_b = 256 * D * 2; S.nN = N_INP / 256; S.nt = D / 64; S.G = F.G; S.vcu = F.vcu; S.ntiles = (T / 256) * (N_INP / 256);
    EpiInProj E{F_WS};
    pg8::gemm_phase<EpiInProj, SchedDense, true>(F.lds, F.tid, D, S, E);
}

constexpr int KROW = 144;
struct FlashState { float m, l; f32x16 o0, o1; };
__device__ __forceinline__ s16x4 tr_read(unsigned addr) { s16x4 r; asm volatile("ds_read_b64_tr_b16 %0, %1" : "=v"(r) : "v"(addr) : "memory"); return r; }
__device__ __forceinline__ void flash_core(FlashState& st, const bf16x8 (&qf)[4], const bf16x8 (&kfr)[4], unsigned Vt, unsigned vmask, int lane);
__device__ __forceinline__ void flash_tile(FlashState& st, const bf16x8 (&qf)[4], unsigned Kt, unsigned Vt, unsigned vmask, int lane) {
    const int r32 = lane & 31, half = lane >> 5;
    bf16x8 kfr[4];
#pragma unroll
    for (int ks = 0; ks < 4; ++ks) kfr[ks] = *(const LAS bf16x8*)(uintptr_t)(Kt + r32 * KROW + (16 * ks + 8 * half) * 2);
    flash_core(st, qf, kfr, Vt, vmask, lane);
}
__device__ __forceinline__ void flash_core(FlashState& st, const bf16x8 (&qf)[4], const bf16x8 (&kfr)[4], unsigned Vt, unsigned vmask, int lane) {
    const int half = lane >> 5;
    f32x16 s = {};
#pragma unroll
    for (int ks = 0; ks < 4; ++ks) s = __builtin_amdgcn_mfma_f32_32x32x16_bf16(kfr[ks], qf[ks], s, 0, 0, 0);
    const bool full = __ballot(vmask != 0xffffu) == 0ull;
    float mx = -1e30f;
    if (full) {
#pragma unroll
        for (int i = 0; i < 16; ++i) mx = fmaxf(mx, s[i]);
        mx *= SM_C;
    } else {
#pragma unroll
        for (int i = 0; i < 16; ++i) { const float v = ((vmask >> i) & 1u) ? s[i] : -1e30f; mx = fmaxf(mx, v); }
        mx = fmaxf(mx * SM_C, -1e30f);
    }
    mx = half_max(mx);
    const float mn = fmaxf(st.m, mx), alpha = __builtin_amdgcn_exp2f(st.m - mn);
    float ls = 0.f; float p[16];
    if (full) {
#pragma unroll
        for (int i = 0; i < 16; ++i) { p[i] = __builtin_amdgcn_exp2f(fmaf(s[i], SM_C, -mn)); ls += p[i]; }
    } else {
#pragma unroll
        for (int i = 0; i < 16; ++i) { p[i] = ((vmask >> i) & 1u) ? __builtin_amdgcn_exp2f(fmaf(s[i], SM_C, -mn)) : 0.f; ls += p[i]; }
    }
    st.l = st.l * alpha + ls; st.m = mn;
    if (__ballot(alpha != 1.0f) != 0ull) {
#pragma unroll
        for (int i = 0; i < 16; ++i) { st.o0[i] *= alpha; st.o1[i] *= alpha; }
    }
#pragma unroll
    for (int sx = 0; sx < 2; ++sx) {
        v4u pw; pw.x = cvt_pk_bf16(p[8 * sx + 0], p[8 * sx + 1]); pw.y = cvt_pk_bf16(p[8 * sx + 2], p[8 * sx + 3]); pw.z = cvt_pk_bf16(p[8 * sx + 4], p[8 * sx + 5]); pw.w = cvt_pk_bf16(p[8 * sx + 6], p[8 * sx + 7]);
        const bf16x8 pf = __builtin_bit_cast(bf16x8, pw);
        const int g = lane >> 4, i16 = lane & 15, q_ = i16 >> 2, pp = i16 & 3;
#pragma unroll
        for (int dt = 0; dt < 2; ++dt) {
            const unsigned a0 = Vt + (16 * sx + 4 * (g >> 1) + q_) * KROW + (32 * dt + 16 * (g & 1) + 4 * pp) * 2;
            s16x4 lo = tr_read(a0), hi = tr_read(a0 + 8 * KROW);
            asm volatile("s_waitcnt lgkmcnt(0)" : "+v"(lo), "+v"(hi) :: "memory");
            const bf16x8 vf = (bf16x8){lo[0], lo[1], lo[2], lo[3], hi[0], hi[1], hi[2], hi[3]};
            if (dt == 0) st.o0 = __builtin_amdgcn_mfma_f32_32x32x16_bf16(vf, pf, st.o0, 0, 0, 0);
            else st.o1 = __builtin_amdgcn_mfma_f32_32x32x16_bf16(vf, pf, st.o1, 0, 0, 0);
        }
    }
}
__device__ __forceinline__ void flash_store(const FlashState& st, float scale, bf16* orow, int lane) {
    const int half = lane >> 5;
#pragma unroll
    for (int dt = 0; dt < 2; ++dt)
#pragma unroll
        for (int g = 0; g < 4; ++g) {
            const f32x16& o = dt ? st.o1 : st.o0;
            v2u w; w.x = cvt_pk_bf16(o[4 * g] * scale, o[4 * g + 1] * scale); w.y = cvt_pk_bf16(o[4 * g + 2] * scale, o[4 * g + 3] * scale);
            *(v2u*)(orow + 32 * dt + 8 * g + 4 * half) = w;
        }
}
__device__ __forceinline__ void stage_rows(LAS unsigned char* dst, const bf16* src, long pitch, int first_valid, int tid) {
#pragma unroll
    for (int i = 0; i < 4; ++i) { const int pid = tid + 512 * i, r = pid >> 3, pc = pid & 7;
        v4u v = (v4u){0u, 0u, 0u, 0u};
        if (r >= first_valid) v = *(const v4u*)(src + (long)r * pitch + pc * 8);
        *(LAS v4u*)(dst + r * KROW + pc * 16) = v; }
}

__device__ __forceinline__ void moba_unit(Frame& F, int b, int h, int c) {
    LAS unsigned char* KS = F.lds; LAS unsigned char* VS = F.lds + 256 * KROW; LAS float* KM = (LAS float*)(F.lds + 2 * 256 * KROW);
    const int lane = F.lane, w = F.wave, r32 = lane & 31, half = lane >> 5;
    const long rowbase = (long)b * SEQ;
    bf16* BQ = (bf16*)(F_WS + WS_BQ); const bf16* BKp = (const bf16*)(F_WS + WS_BK); const bf16* BVp = (const bf16*)(F_WS + WS_BV);
    const float* KMP = (const float*)(F_WS + WS_KMP);
    __syncthreads();
    for (int i = F.tid; i < c * 64; i += NTHR) { const int n = i >> 6, d = i & 63; const float* p0 = KMP + (size_t)((b * 32 + n) * 2) * 256 + h * 64 + d; KM[i] = (p0[0] + p0[256]) * (1.0f / 256.0f); }
    const int tq = 256 * c + 32 * w + r32;
    const bf16* qrow = BQ + (rowbase + tq) * 256 + h * 64;
    bf16x8 qf[4];
#pragma unroll
    for (int ks = 0; ks < 4; ++ks) qf[ks] = *(const bf16x8*)(qrow + 16 * ks + 8 * half);
    __syncthreads();
    unsigned selmask = 0u;
    {
        v4u qp[8];
#pragma unroll
        for (int i = 0; i < 8; ++i) qp[i] = *(const v4u*)(qrow + 8 * i);
        float v1 = -INFINITY, v2 = -INFINITY, v3 = -INFINITY; int i1 = -1, i2 = -1, i3 = -1;
        for (int n = 0; n < c; ++n) {
            float a = 0.f;
#pragma unroll
            for (int i = 0; i < 8; ++i) {
                const f32x4 k0 = *(const LAS f32x4*)(KM + n * 64 + 8 * i), k1 = *(const LAS f32x4*)(KM + n * 64 + 8 * i + 4);
                a = fmaf(bflo(qp[i].x), k0[0], a); a = fmaf(bfhi(qp[i].x), k0[1], a); a = fmaf(bflo(qp[i].y), k0[2], a); a = fmaf(bfhi(qp[i].y), k0[3], a);
                a = fmaf(bflo(qp[i].z), k1[0], a); a = fmaf(bfhi(qp[i].z), k1[1], a); a = fmaf(bflo(qp[i].w), k1[2], a); a = fmaf(bfhi(qp[i].w), k1[3], a);
            }
            if (a > v1) { v3 = v2; i3 = i2; v2 = v1; i2 = i1; v1 = a; i1 = n; }
            else if (a > v2) { v3 = v2; i3 = i2; v2 = a; i2 = n; }
            else if (a > v3) { v3 = a; i3 = n; }
        }
        if (i1 >= 0) selmask |= 1u << i1; if (i2 >= 0) selmask |= 1u << i2; if (i3 >= 0) selmask |= 1u << i3;
    }
    FlashState st; st.m = -1e30f; st.l = 0.f; st.o0 = (f32x16){}; st.o1 = (f32x16){};
    const unsigned KSa = (unsigned)(uintptr_t)KS, VSa = (unsigned)(uintptr_t)VS;
    for (int n = 0; n <= c; ++n) {
        __syncthreads();
        stage_rows(KS, BKp + (rowbase + 256 * n) * 256 + h * 64, 256, 0, F.tid);
        stage_rows(VS, BVp + (rowbase + 256 * n) * 256 + h * 64, 256, 0, F.tid);
        __syncthreads();
        const bool own = (n == c);
        const bool mine = own || ((selmask >> n) & 1u);
        if (__ballot(mine) == 0ull) continue;
        const int ktmax = own ? w : 7;
        for (int kt = 0; kt <= ktmax; ++kt) {
            unsigned vm = 0u;
            if (mine) {
                if (!own || kt < w) vm = 0xffffu;
                else {
#pragma unroll
                    for (int i = 0; i < 16; ++i) { const int kl = (i & 3) + 8 * (i >> 2) + 4 * half; if (kl <= r32) vm |= 1u << i; }
                }
            }
            flash_tile(st, qf, KSa + kt * 32 * KROW, VSa + kt * 32 * KROW, vm, lane);
        }
    }
    const float lt = half_sum(st.l);
    flash_store(st, 1.0f / lt, BQ + (rowbase + tq) * 256 + h * 64, lane);
}


constexpr int MB_ST = 0, MB_VST = 73728, MB_KM = 110592, MB_SELB = 118784, MB_ITQ = 119808  , MB_ITB = 126720  , MB_NIT = 126944;
constexpr int MB_STW = 36;
__device__ __forceinline__ void moba_item(Frame& F, FlashState& st, const bf16x8 (&qf)[4], const bf16* Kt, int hh, long krow0, const bf16* Vg, int ktiles, int lane, int w, unsigned vm_full, bool causal, int qloc) {
    const int r32 = lane & 31, half = lane >> 5;
    LAS unsigned char* VT = F.lds + MB_VST + w * (32 * KROW);
    const unsigned VTa = (unsigned)(uintptr_t)VT;
    bf16x8 kc[4], kn[4], kf2[4]; v4u vc[4], vn[4], vf2[4];
    const bf16* kp = Kt + bk_off(hh, krow0 + r32, half);
    const bf16* vpa = Vg + (long)((lane >> 3) + 8) * 256 + 8 * (lane & 7); const bf16* vpb = vpa + 16 * 256;
#define MB_LD(kd, vd, kt_) do { const int kq_ = min((kt_), ktiles - 1); const bf16* kq = kp + (long)kq_ * 2048; \
        _Pragma("unroll") for (int ks = 0; ks < 4; ++ks) kd[ks] = *(const bf16x8*)(kq + ks * 512); \
        const bf16* va_ = vpa + (long)kq_ * 8192; const bf16* vb_ = vpb + (long)kq_ * 8192; \
        vd[0] = *(const v4u*)(va_ - 2048); vd[1] = *(const v4u*)va_; vd[2] = *(const v4u*)(vb_ - 2048); vd[3] = *(const v4u*)vb_; } while (0)
#define MB_PIN() asm volatile("" ::: "memory")
#define MB_STEP(kd, vd, kt_) do { \
        _Pragma("unroll") for (int i = 0; i < 4; ++i) { const int p = lane + 64 * i; *(LAS v4u*)(VT + (p >> 3) * KROW + 16 * (p & 7)) = vd[i]; } \
        LDS_WAIT(); \
        unsigned vm = vm_full; \
        if (causal && (kt_) == ktiles - 1) { vm = 0u;                  \
            _Pragma("unroll") for (int g = 0; g < 4; ++g) { const int nb = min(max(qloc - 4 * half - 8 * g + 1, 0), 4); vm |= ((1u << nb) - 1u) << (4 * g); } \
            vm &= vm_full; } \
        flash_core(st, qf, kd, VTa, vm, lane); } while (0)
    MB_LD(kc, vc, 0); MB_PIN(); MB_LD(kn, vn, 1); MB_PIN(); MB_LD(kf2, vf2, 2); MB_PIN();
    for (int kt = 0; kt < ktiles; kt += 3) {
        MB_STEP(kc, vc, kt);
        MB_PIN(); MB_LD(kc, vc, kt + 3); MB_PIN();
        if (kt + 1 < ktiles) MB_STEP(kn, vn, kt + 1);
        MB_PIN(); MB_LD(kn, vn, kt + 4); MB_PIN();
        if (kt + 2 < ktiles) MB_STEP(kf2, vf2, kt + 2);
        MB_PIN(); MB_LD(kf2, vf2, kt + 5); MB_PIN();
    }
#undef MB_STEP
#undef MB_PIN
#undef MB_LD
}
__device__ __forceinline__ void moba_unit2(Frame& F, int b, int h, int c) {
    int lane_ = F.lane; asm volatile("" : "+v"(lane_));
    const int lane = lane_, w = F.wave, r32 = lane & 31, half = lane >> 5;
    const long rowbase = (long)b * SEQ;
    bf16* BQ = (bf16*)(F_WS + WS_BQ); const bf16* BKt = (const bf16*)(F_WS + WS_BK); const bf16* BVp = (const bf16*)(F_WS + WS_BV) + rowbase * 256 + h * 64;
    const float* KMP = (const float*)(F_WS + WS_KMP);
    LAS float* ST = (LAS float*)(F.lds + MB_ST); LAS float* KM = (LAS float*)(F.lds + MB_KM);
    LAS unsigned char* SELB = F.lds + MB_SELB; LAS unsigned char* ITQ = F.lds + MB_ITQ; LAS unsigned char* ITB = F.lds + MB_ITB; LAS int* NIT = (LAS int*)(F.lds + MB_NIT);
    __syncthreads();
    for (int i = F.tid; i < c * 64; i += NTHR) { const int n = i >> 6, d = i & 63; const float* p0 = KMP + (size_t)((b * 32 + n) * 2) * 256 + h * 64 + d; KM[i] = (p0[0] + p0[256]) * (1.0f / 256.0f); }
    for (int i = F.tid; i < 256 * 2 * MB_STW; i += NTHR) { const int f = i % MB_STW; ST[i] = (f == 32) ? -1e30f : 0.f; }
    __syncthreads();
    {
        const int tq = 256 * c + 32 * w + r32;
        const bf16* qrow = BQ + (rowbase + tq) * 256 + h * 64;
        v4u qp[8];
#pragma unroll
        for (int i = 0; i < 8; ++i) qp[i] = *(const v4u*)(qrow + 8 * i);
        float v1 = -INFINITY, v2 = -INFINITY, v3 = -INFINITY; int i1 = -1, i2 = -1, i3 = -1;
        for (int n = 0; n < c; ++n) {
            float a = 0.f;
#pragma unroll
            for (int i = 0; i < 8; ++i) {
                const f32x4 k0 = *(const LAS f32x4*)(KM + n * 64 + 8 * i), k1 = *(const LAS f32x4*)(KM + n * 64 + 8 * i + 4);
                a = fmaf(bflo(qp[i].x), k0[0], a); a = fmaf(bfhi(qp[i].x), k0[1], a); a = fmaf(bflo(qp[i].y), k0[2], a); a = fmaf(bfhi(qp[i].y), k0[3], a);
                a = fmaf(bflo(qp[i].z), k1[0], a); a = fmaf(bfhi(qp[i].z), k1[1], a); a = fmaf(bflo(qp[i].w), k1[2], a); a = fmaf(bfhi(qp[i].w), k1[3], a);
            }
            if (a > v1) { v3 = v2; i3 = i2; v2 = v1; i2 = i1; v1 = a; i1 = n; }
            else if (a > v2) { v3 = v2; i3 = i2; v2 = a; i2 = n; }
            else if (a > v3) { v3 = a; i3 = n; }
        }
        unsigned selmask = 0u;
        if (i1 >= 0) selmask |= 1u << i1; if (i2 >= 0) selmask |= 1u << i2; if (i3 >= 0) selmask |= 1u << i3;
        if (half == 0) { unsigned m = selmask; unsigned rec = 0u; int cnt = 0;
#pragma unroll
            for (int r = 0; r < 3; ++r) if (m) { const int n = __builtin_ctz(m); m &= m - 1u; rec |= (unsigned)n << (8 * r); ++cnt; }
            rec |= (unsigned)cnt << 24;
            *(LAS unsigned*)(SELB + 4 * (32 * w + r32)) = rec; }
    }
    __syncthreads();
    const unsigned long long lt_mask = (1ull << lane) - 1ull;
    if (w < 3) {
        const int r = w; LAS unsigned char* itq = ITQ + r * 2304; LAS unsigned char* itb = ITB + r * 72;
        unsigned rec[4];
#pragma unroll
        for (int ch = 0; ch < 4; ++ch) rec[ch] = *(const LAS unsigned*)(SELB + 4 * (64 * ch + lane));
        int nit = 0;
        for (int n = 0; n < c; ++n) {
            int pos = 0;
#pragma unroll
            for (int ch = 0; ch < 4; ++ch) {
                const bool hit = ((int)(rec[ch] >> 24) > r) && ((int)((rec[ch] >> (8 * r)) & 0xffu) == n);
                const unsigned long long bm = __ballot(hit);
                if (hit) { const int p = pos + __popcll(bm & lt_mask); itq[(nit + (p >> 5)) * 32 + (p & 31)] = (unsigned char)(64 * ch + lane); }
                pos += __popcll(bm);
            }
            const int ni = (pos + 31) >> 5;
            if (ni > 0) { const int tail = pos & 31; if (tail && lane >= tail && lane < 32) itq[(nit + ni - 1) * 32 + lane] = 0xffu;
                if (lane < ni) itb[nit + lane] = (unsigned char)n; }
            nit += ni;
        }
        if (lane == 0) NIT[r] = nit;
    }
    __syncthreads();
    for (int r = 0; r < 3; ++r) {
        LAS unsigned char* itq = ITQ + r * 2304; LAS unsigned char* itb = ITB + r * 72;
        const int nit = NIT[r];
        for (int it = w; it < nit; it += NWAVES) {
            const int n = itb[it]; const int q = itq[it * 32 + r32]; const bool valid = q != 0xff; const int qq = valid ? q : 0;
            const bf16* qrow = BQ + (rowbase + 256 * c + qq) * 256 + h * 64;
            bf16x8 qf[4];
#pragma unroll
            for (int ks = 0; ks < 4; ++ks) qf[ks] = *(const bf16x8*)(qrow + 16 * ks + 8 * half);
            FlashState st; LAS float* sp = ST + (qq * 2 + half) * MB_STW;
#pragma unroll
            for (int i = 0; i < 16; i += 4) { const f32x4 a = *(const LAS f32x4*)(sp + i), bq = *(const LAS f32x4*)(sp + 16 + i); st.o0[i] = a.x; st.o0[i + 1] = a.y; st.o0[i + 2] = a.z; st.o0[i + 3] = a.w; st.o1[i] = bq.x; st.o1[i + 1] = bq.y; st.o1[i + 2] = bq.z; st.o1[i + 3] = bq.w; }
            { const f32x2 ml = *(const LAS f32x2*)(sp + 32); st.m = ml.x; st.l = ml.y; }
            moba_item(F, st, qf, BKt, h, rowbase + 256 * n, BVp + (long)(256 * n) * 256, 8, lane, w, valid ? 0xffffu : 0u, false, 0);
            if (valid) {
#pragma unroll
                for (int i = 0; i < 16; i += 4) { *(LAS f32x4*)(sp + i) = (f32x4){st.o0[i], st.o0[i + 1], st.o0[i + 2], st.o0[i + 3]}; *(LAS f32x4*)(sp + 16 + i) = (f32x4){st.o1[i], st.o1[i + 1], st.o1[i + 2], st.o1[i + 3]}; }
                *(LAS f32x2*)(sp + 32) = (f32x2){st.m, st.l}; }
        }
        __syncthreads();
    }
    {
        const int qloc = 32 * w + r32; const int tq = 256 * c + qloc;
        bf16* qrow = BQ + (rowbase + tq) * 256 + h * 64;
        bf16x8 qf[4];
#pragma unroll
        for (int ks = 0; ks < 4; ++ks) qf[ks] = *(const bf16x8*)(qrow + 16 * ks + 8 * half);
        FlashState st; LAS float* sp = ST + (qloc * 2 + half) * MB_STW;
#pragma unroll
        for (int i = 0; i < 16; i += 4) { const f32x4 a = *(const LAS f32x4*)(sp + i), bq = *(const LAS f32x4*)(sp + 16 + i); st.o0[i] = a.x; st.o0[i + 1] = a.y; st.o0[i + 2] = a.z; st.o0[i + 3] = a.w; st.o1[i] = bq.x; st.o1[i + 1] = bq.y; st.o1[i + 2] = bq.z; st.o1[i + 3] = bq.w; }
        { const f32x2 ml = *(const LAS f32x2*)(sp + 32); st.m = ml.x; st.l = ml.y; }
        moba_item(F, st, qf, BKt, h, rowbase + 256 * c, BVp + (long)(256 * c) * 256, w + 1, lane, w, 0xffffu, true, r32);
        const float lt = half_sum(st.l);
        flash_store(st, 1.0f / lt, qrow, lane);
    }
}

__device__ __forceinline__ void swa_unit(Frame& F, int l, int b, int kvh, int nb) {
    LAS unsigned char* KS = F.lds; LAS unsigned char* VS = F.lds + 256 * KROW;
    const int lane = F.lane, w = F.wave, r32 = lane & 31, half = lane >> 5;
    const long rowbase = (long)b * SEQ;
    bf16* CQ = (bf16*)(F_WS + WS_CQ); const bf16* CKV = (const bf16*)(F_WS + WS_CKV);
    __syncthreads();
    const long band0 = rowbase + 128 * nb - 128;
    stage_rows(KS, CKV + band0 * 256 + kvh * 64, 256, nb == 0 ? 128 : 0, F.tid);
    stage_rows(VS, CKV + band0 * 256 + 128 + kvh * 64, 256, nb == 0 ? 128 : 0, F.tid);
    __syncthreads();
    const int hq = kvh * 4 + (w >> 1);
    const float zs = F_IN(I_SINK)[l * 8 + hq] * LOG2E;
    const unsigned KSa = (unsigned)(uintptr_t)KS, VSa = (unsigned)(uintptr_t)VS;
    for (int gi = 0; gi < 2; ++gi) {
        const int i0 = (w & 1) * 64 + 32 * gi, iq = i0 + r32;
        bf16* qrow = CQ + (rowbase + 128 * nb + iq) * 512 + hq * 64;
        bf16x8 qf[4];
#pragma unroll
        for (int ks = 0; ks < 4; ++ks) qf[ks] = *(const bf16x8*)(qrow + 16 * ks + 8 * half);
        FlashState st; st.m = -1e30f; st.l = 0.f; st.o0 = (f32x16){}; st.o1 = (f32x16){};
        const int kt0 = (i0 + 1) >> 5, kt1 = (i0 + 159) >> 5;
        for (int kt = kt0; kt <= kt1; ++kt) {
            unsigned vm = 0u;
#pragma unroll
            for (int i = 0; i < 16; ++i) { const int kk = kt * 32 + (i & 3) + 8 * (i >> 2) + 4 * half; const bool ok = (kk > iq) && (kk <= iq + 128) && (nb > 0 || kk >= 128); if (ok) vm |= 1u << i; }
            flash_tile(st, qf, KSa + kt * 32 * KROW, VSa + kt * 32 * KROW, vm, lane);
        }
        const float lt = half_sum(st.l);
        const float m2 = fmaxf(st.m, zs), f = __builtin_amdgcn_exp2f(st.m - m2);
        const float lf = lt * f + __builtin_amdgcn_exp2f(zs - m2);
        flash_store(st, f / lf, qrow, lane);
    }
}

constexpr int DSA_KEYS = 0, DSA_HIST = 131072, DSA_SEL = 139264, DSA_BIDX = 143360, DSA_BSC = 145408, DSA_IQ = 149504;
constexpr int DSA_TOPK = 256, DSA_BCAP = 128;
constexpr int DSA_ZC = 153600;
constexpr int DSA_NXT = 153632;
constexpr int CW_DSAQ = 200000;
constexpr int DSA_IWL = 153664;
constexpr int DSA_VROW = 144;
__device__ __forceinline__ unsigned sortable16(float s) { const unsigned b = (unsigned)__builtin_bit_cast(unsigned short, (_Float16)s); return (b ^ ((unsigned)((int)(b << 16) >> 31) | 0x8000u)) & 0xffffu; }
__device__ __forceinline__ float key_float(unsigned k16) { const unsigned b = (k16 & 0x8000u) ? (k16 ^ 0x8000u) : (~k16 & 0xffffu); return (float)__builtin_bit_cast(_Float16, (unsigned short)b); }
__device__ __forceinline__ int lin_bin(float sT, float inv, float c0) { return (int)__builtin_amdgcn_fmed3f(fmaf(sT, inv, c0), 0.f, 255.f); }
__device__ __forceinline__ int wave_prefix_incl(int v, int lane) {
    v += __builtin_amdgcn_update_dpp(0, v, 0x111, 0xf, 0xf, true); v += __builtin_amdgcn_update_dpp(0, v, 0x112, 0xf, 0xf, true);
    v += __builtin_amdgcn_update_dpp(0, v, 0x114, 0xf, 0xf, true); v += __builtin_amdgcn_update_dpp(0, v, 0x118, 0xf, 0xf, true);
    const int t0 = __builtin_amdgcn_readlane(v, 15), t1 = __builtin_amdgcn_readlane(v, 31), t2 = __builtin_amdgcn_readlane(v, 47);
    return v + (lane >= 48 ? t0 + t1 + t2 : (lane >= 32 ? t0 + t1 : (lane >= 16 ? t0 : 0)));
}
__device__ __forceinline__ unsigned pk_gt_flags(unsigned keys, unsigned t2, unsigned one2) { unsigned r; asm("v_pk_sub_u16 %0, %1, %2 clamp\n\tv_pk_min_u16 %0, %0, %3" : "=&v"(r) : "v"(keys), "v"(t2), "v"(one2)); return r; }
__device__ __forceinline__ unsigned pk_add16(unsigned a, unsigned b) { unsigned r; asm("v_pk_add_u16 %0, %1, %2" : "=v"(r) : "v"(a), "v"(b)); return r; }
__device__ __forceinline__ void find_bin(const LAS unsigned* hist, unsigned target, int lane, unsigned& bin, unsigned& above, unsigned& cnt) {
    const v4u hv = *(const LAS v4u*)(hist + 4 * lane);
    const unsigned tl = hv.x + hv.y + hv.z + hv.w;
    const int pin = wave_prefix_incl((int)tl, lane);
    const unsigned suf = (unsigned)(__builtin_amdgcn_readlane(pin, 63) - pin) + tl;
    const unsigned s4 = suf - tl;
    const unsigned S3 = s4 + hv.w, S2 = S3 + hv.z, S1 = S2 + hv.y, S0 = S1 + hv.x;
    int which = -1; unsigned ab = 0, cn = 0;
    if (S3 >= target && s4 < target) { which = 3; ab = s4; cn = hv.w; }
    else if (S2 >= target && S3 < target) { which = 2; ab = S3; cn = hv.z; }
    else if (S1 >= target && S2 < target) { which = 1; ab = S2; cn = hv.y; }
    else if (S0 >= target && S1 < target) { which = 0; ab = S1; cn = hv.x; }
    const unsigned long long bm = __ballot(which >= 0);
    const int src = bm ? (int)__builtin_ctzll(bm) : 0;
    bin = (unsigned)__builtin_amdgcn_readlane(4 * lane + which, src); above = __builtin_amdgcn_readlane(ab, src); cnt = __builtin_amdgcn_readlane(cn, src);
}
__device__ __forceinline__ void dsa_exact_boundary(const LAS u16* IQL, const u16* IKb, f32x4 wq, LAS u16* bidx, LAS float* bsc, LAS u16* sel, int nsel, int E, int need, int lane, unsigned long long lt_mask) {
    float sc[2]; int ki[2];
#pragma unroll
    for (int r = 0; r < 2; ++r) { const int e = lane + 64 * r; sc[r] = -INFINITY; ki[r] = 0x7fffffff;
        if (e < E) { const int key = bidx[e]; ki[r] = key; float s = 0.f;
            for (int hd = 0; hd < 4; ++hd) { float a = 0.f;
                for (int d = 0; d < 64; d += 8) { const f16x8 kv = *(const f16x8*)(IKb + ik_off(key, d >> 3)); const f16x8 qv = *(const LAS f16x8*)(IQL + hd * 64 + d);
#pragma unroll
                    for (int x = 0; x < 8; ++x) a = fmaf((float)qv[x], (float)kv[x], a); }
                s = fmaf(wq[hd], fmaxf(a, 0.f), s); }
            sc[r] = s; bsc[e] = s; } }
    LDS_WAIT();
#pragma unroll
    for (int r = 0; r < 2; ++r) { const int e = lane + 64 * r; int rank = 0;
        if (e < E) { for (int o = 0; o < E; ++o) { const float so = bsc[o]; const int io = bidx[o]; rank += (so > sc[r] || (so == sc[r] && io < ki[r])) ? 1 : 0; } }
        const bool take = (e < E) && rank < need;
        const unsigned long long tm = __ballot(take);
        if (take) sel[nsel + __popcll(tm & lt_mask)] = (u16)ki[r];
        nsel += __popcll(tm); }
}
__device__ __forceinline__ int dsa_rescore_select(LAS unsigned char* lds, const u16* IKb, f32x4 wq, LAS u16* bidx, LAS float* bsc, LAS u16* sel, int nsel, int En, int need_eq, int lane, int w, unsigned long long lt_mask, int dpe) {
    const int r32 = lane & 31, half = lane >> 5;
    f16x8 aop[4];
    { const int q = r32 >> 2, hd = r32 & 3; const LAS u16* pl = (const LAS u16*)(lds + DSA_IQ) + q * 256 + hd * 64 + 8 * half;
#pragma unroll
      for (int ks = 0; ks < 4; ++ks) aop[ks] = *(const LAS f16x8*)(pl + 16 * ks); }
    for (int r0 = 0; r0 < En; r0 += 32) {
        const int c = r0 + r32; const int key = (c < En) ? (int)bidx[c] : 0;
        f32x16 dacc = {};
#pragma unroll
        for (int ks = 0; ks < 4; ++ks) { const f16x8 bop = *(const f16x8*)(IKb + ik_off(key, 2 * ks + half)); dacc = __builtin_amdgcn_mfma_f32_32x32x16_f16(aop[ks], bop, dacc, 0, 0, 0); }
        const int g = w >> 1; float s = 0.f;
#pragma unroll
        for (int hd = 0; hd < 4; ++hd) { const float dv = g == 0 ? dacc[hd] : (g == 1 ? dacc[4 + hd] : (g == 2 ? dacc[8 + hd] : dacc[12 + hd])); s = fmaf(wq[hd], fmaxf(dv, 0.f), s); }
        if (half == (w & 1) && c < En) bsc[c] = s;
    }
    LDS_WAIT();
    {
        const bool v0 = lane < En, v1 = lane + 64 < En;
        unsigned k0 = 0u, k1 = 0u; int i0 = 0, i1 = 0;
        { const int e0 = v0 ? lane : 0, e1 = v1 ? lane + 64 : 0;
          unsigned u0 = __builtin_bit_cast(unsigned, bsc[e0]), u1 = __builtin_bit_cast(unsigned, bsc[e1]); i0 = (int)bidx[e0]; i1 = (int)bidx[e1];
          u0 ^= (unsigned)((int)u0 >> 31) | 0x80000000u; u1 ^= (unsigned)((int)u1 >> 31) | 0x80000000u; k0 = u0; k1 = u1; }
        unsigned prefix = 0u; int remaining = need_eq;
#pragma unroll 4
        for (int bit = 31; bit >= 0; --bit) {
            const unsigned test = prefix | (1u << bit), hm = ~((1u << bit) - 1u);
            const int c = __popcll(__ballot(v0 && (k0 & hm) == test)) + __popcll(__ballot(v1 && (k1 & hm) == test));
            if (c >= remaining) prefix = test; else remaining -= c;
        }
        const bool t0 = v0 && k0 == prefix, t1 = v1 && k1 == prefix;
        bool take0 = v0 && k0 > prefix, take1 = v1 && k1 > prefix;
        const unsigned long long tm0 = __ballot(t0), tm1 = __ballot(t1);
        if (__popcll(tm0) + __popcll(tm1) == remaining) { take0 = take0 || t0; take1 = take1 || t1; }
        else {
            int r0 = 0, r1 = 0;
            for (unsigned long long m = tm0; m; m &= m - 1ull) { const int ib = __builtin_amdgcn_readlane(i0, (int)__builtin_ctzll(m)); r0 += (ib < i0) ? 1 : 0; r1 += (ib < i1) ? 1 : 0; }
            for (unsigned long long m = tm1; m; m &= m - 1ull) { const int ib = __builtin_amdgcn_readlane(i1, (int)__builtin_ctzll(m)); r0 += (ib < i0) ? 1 : 0; r1 += (ib < i1) ? 1 : 0; }
            take0 = take0 || (t0 && r0 < remaining); take1 = take1 || (t1 && r1 < remaining);
        }
        const unsigned long long w0 = __ballot(take0);
        if (take0) sel[nsel + __popcll(w0 & lt_mask)] = (u16)i0;
        nsel += __popcll(w0);
        const unsigned long long w1 = __ballot(take1);
        if (take1) sel[nsel + __popcll(w1 & lt_mask)] = (u16)i1;
        nsel += __popcll(w1);
    }
    return nsel;
}
__device__ __forceinline__ void dsa_select_slow(LAS unsigned char* lds, int w, const LAS u16* myk, LAS unsigned* hist, LAS u16* sel, LAS u16* bidx, LAS float* bsc, const u16* IKb, f32x4 wq, int npad, int lane, unsigned long long lt_mask) {
    const LAS unsigned* k2 = (const LAS unsigned*)myk;
    for (int i = lane; i < npad / 2; i += 64) { const unsigned kk = k2[i]; __hip_atomic_fetch_add(hist + ((kk >> 8) & 0xffu), 1u, __ATOMIC_RELAXED, __HIP_MEMORY_SCOPE_WORKGROUP); __hip_atomic_fetch_add(hist + (kk >> 24), 1u, __ATOMIC_RELAXED, __HIP_MEMORY_SCOPE_WORKGROUP); }
    LDS_WAIT();
    unsigned B1, above1, c1; find_bin(hist, DSA_TOPK, lane, B1, above1, c1);
    LDS_WAIT();
    *(LAS v4u*)(hist + 4 * lane) = (v4u){0u, 0u, 0u, 0u};
    LDS_WAIT();
    for (int i = lane; i < npad / 2; i += 64) { const unsigned kk = k2[i];
        if (((kk >> 8) & 0xffu) == B1) __hip_atomic_fetch_add(hist + (kk & 0xffu), 1u, __ATOMIC_RELAXED, __HIP_MEMORY_SCOPE_WORKGROUP);
        if ((kk >> 24) == B1) __hip_atomic_fetch_add(hist + ((kk >> 16) & 0xffu), 1u, __ATOMIC_RELAXED, __HIP_MEMORY_SCOPE_WORKGROUP); }
    LDS_WAIT();
    unsigned B2, above2, E; find_bin(hist, DSA_TOPK - above1, lane, B2, above2, E);
    const unsigned bstar = (B1 << 8) | B2; const int need = DSA_TOPK - (int)(above1 + above2);
    const bool index_mode = ((int)E == need) || (E > (unsigned)DSA_BCAP) || (bstar == 0x8000u);
    int nsel = 0, neq = 0;
    for (int c0 = 0; c0 < npad; c0 += 64) {
        const int j = c0 + lane; const unsigned kk = (j < npad) ? myk[j] : 0u;
        const bool gt = kk > bstar, eq = (kk == bstar);
        const unsigned long long em = __ballot(eq);
        const int epos = neq + __popcll(em & lt_mask);
        const bool take = gt || (index_mode && eq && epos < need);
        const unsigned long long tm = __ballot(take);
        if (take) sel[nsel + __popcll(tm & lt_mask)] = (u16)j;
        if (!index_mode && eq) bidx[epos] = (u16)j;
        nsel += __popcll(tm); neq += __popcll(em);
    }
    if (!index_mode) { LDS_WAIT(); dsa_rescore_select(lds, IKb, wq, bidx, bsc, sel, nsel, (int)E, need, lane, w, lt_mask, 7); }
}

template <int DP = 7> __device__ __forceinline__ void dsa_unit(Frame& F, int b, int t0, int& nb, int& nt0, int grp, int ngrp, v2u& iqn, float& iwn, int dpr = 7) {
    const int dpe = DP & dpr;
    LAS u16* KEYS = (LAS u16*)(F.lds + DSA_KEYS);
    int lane_ = F.lane; asm volatile("" : "+v"(lane_));
    const int lane = lane_, w = F.wave, r32 = lane & 31, half = lane >> 5;
    const long rowbase = (long)b * SEQ;
    const u16* IQ = (const u16*)(F_WS + WS_IQ); const u16* IKb = (const u16*)(F_WS + WS_IK) + rowbase * 64; const float* IW = (const float*)(F_WS + WS_IW);
    const bf16* KAVAb = (const bf16*)(F_WS + WS_KAVA) + rowbase * 128; bf16* AQ = (bf16*)(F_WS + WS_AQ);
    const int nkeys = t0 + 8, ntiles = (nkeys + 31) >> 5, npad = ntiles * 32;
    LAS unsigned* HISTALL = (LAS unsigned*)(F.lds + DSA_HIST);
    __syncthreads();
    { const int nk = *(const LAS int*)(F.lds + DSA_NXT); const int per = (T / 8) / ngrp;
      if (nk >= per) { nb = 0; nt0 = -1; } else if (ngrp == 4) { nb = grp; nt0 = 8 * (per - 1 - nk); } else { nb = nk & 3; nt0 = 8 * ((T / 32) - 1 - (nk >> 2)); } }
    { LAS u16* IQLw = (LAS u16*)(F.lds + DSA_IQ); *(LAS v2u*)(IQLw + 4 * F.tid) = iqn; if (F.tid < 32) ((LAS float*)(F.lds + DSA_IWL))[F.tid] = iwn; }
#define DSA_PREFETCH_NEXT() do { if (nt0 >= 0) { iqn = *(const v2u*)(IQ + ((long)nb * SEQ + nt0) * 256 + 4 * F.tid); if (F.tid < 32) iwn = IW[((long)nb * SEQ + nt0) * 4 + F.tid]; } } while (0)
    float minv, mc0;
    {
        float binv[4], bc0[4];
        f16x8 bt0[4];
        f16x8 b0[4], b1[4], b2[4];
#define DSA_LDT(dst, ktile) do { const int kb_ = min((ktile), ntiles - 1) * 32 + r32; _Pragma("unroll") for (int ks = 0; ks < 4; ++ks) dst[ks] = *(const f16x8*)(IKb + ik_off(kb_, 2 * ks + half)); } while (0)
#define DSA_PIN() asm volatile("" ::: "memory")
#pragma unroll
        for (int ks = 0; ks < 4; ++ks) bt0[ks] = *(const f16x8*)(IKb + ik_off(r32, 2 * ks + half));
        DSA_PIN(); DSA_LDT(b0, w); DSA_PIN(); DSA_LDT(b1, w + NWAVES); DSA_PIN(); DSA_LDT(b2, w + 2 * NWAVES); DSA_PIN();
        __syncthreads();
        f16x8 aop[4];
        { const int q = r32 >> 2, hd = r32 & 3; const LAS u16* pl = (const LAS u16*)(F.lds + DSA_IQ) + q * 256 + hd * 64 + 8 * half;
#pragma unroll
          for (int ks = 0; ks < 4; ++ks) aop[ks] = *(const LAS f16x8*)(pl + 16 * ks); }
        f32x4 wv[4];
#pragma unroll
        for (int g = 0; g < 4; ++g) wv[g] = *(const LAS f32x4*)((const LAS float*)(F.lds + DSA_IWL) + (2 * g + half) * 4);
        float finf = INFINITY; asm volatile("" : "+s"(finf));
        {
            f32x16 dacc = {};
#pragma unroll
            for (int ks = 0; ks < 4; ++ks) dacc = __builtin_amdgcn_mfma_f32_32x32x16_f16(aop[ks], bt0[ks], dacc, 0, 0, 0);
#pragma unroll
            for (int g = 0; g < 4; ++g) {
                float s = 0.f;
#pragma unroll
                for (int hd = 0; hd < 4; ++hd) s = fmaf(wv[g][hd], fmaxf(dacc[4 * g + hd], 0.f), s);
                float m = row_sum(s); m += xor_f<16>(m); m *= (1.0f / 32.0f);
                float v = row_sum((s - m) * (s - m)); v += xor_f<16>(v);
                const float sg = sqrtf(v * (1.0f / 32.0f));
                const bool okf = (sg > 1e-20f) && (sg < 1e20f);
                binv[g] = okf ? 25.6f / sg : 0.f; bc0[g] = okf ? -(m - 1.5f * sg) * binv[g] : 0.f;
            }
        }
        { const int g = w >> 1; const float a = g == 0 ? binv[0] : (g == 1 ? binv[1] : (g == 2 ? binv[2] : binv[3])), c = g == 0 ? bc0[0] : (g == 1 ? bc0[1] : (g == 2 ? bc0[2] : bc0[3]));
          minv = __builtin_bit_cast(float, __builtin_amdgcn_readlane(__builtin_bit_cast(int, a), (w & 1) * 32)); mc0 = __builtin_bit_cast(float, __builtin_amdgcn_readlane(__builtin_bit_cast(int, c), (w & 1) * 32)); }
#define DSA_SCORE(g_) (fmaf(wv[g_][3], __builtin_amdgcn_fmed3f(dacc[4 * (g_) + 3], 0.f, finf), fmaf(wv[g_][2], __builtin_amdgcn_fmed3f(dacc[4 * (g_) + 2], 0.f, finf), \
            fmaf(wv[g_][1], __builtin_amdgcn_fmed3f(dacc[4 * (g_) + 1], 0.f, finf), fmaf(wv[g_][0], __builtin_amdgcn_fmed3f(dacc[4 * (g_)], 0.f, finf), 0.f)))))
#define DSA_PROC(bb, ktile) do { const int key = (ktile) * 32 + r32; \
            f32x16 dacc = {}; \
            _Pragma("unroll") for (int ks = 0; ks < 4; ++ks) dacc = __builtin_amdgcn_mfma_f32_32x32x16_f16(aop[ks], bb[ks], dacc, 0, 0, 0); \
            if ((ktile) * 32 + 31 <= t0) {                         \
                _Pragma("unroll") for (int g = 0; g < 4; ++g) { \
                    const float s = DSA_SCORE(g); const int q = 2 * g + half; const unsigned k16 = sortable16(s); \
                    if (!(dpe & 128)) KEYS[q * 8192 + key] = (u16)k16; \
                    if (!(dpe & 64)) { const float sT = (float)(_Float16)s;                         \
                          \
                        LAS unsigned* cnt = (k16 == 0x8000u) ? ((LAS unsigned*)(F.lds + DSA_ZC) + q) : (HISTALL + q * 256 + lin_bin(sT, binv[g], bc0[g])); \
                        __hip_atomic_fetch_add(cnt, 1u, __ATOMIC_RELAXED, __HIP_MEMORY_SCOPE_WORKGROUP); } \
                } \
            } else { \
                _Pragma("unroll") for (int g = 0; g < 4; ++g) { \
                    const float s = DSA_SCORE(g); const int q = 2 * g + half; \
                    const bool valid = key <= t0 + q; \
                    const unsigned k16 = valid ? sortable16(s) : 0u; \
                    if (!(dpe & 128)) KEYS[q * 8192 + key] = (u16)k16; \
                    if (!(dpe & 64)) if (valid) { const float sT = (float)(_Float16)s;                         \
                        LAS unsigned* cnt = (k16 == 0x8000u) ? ((LAS unsigned*)(F.lds + DSA_ZC) + q) : (HISTALL + q * 256 + lin_bin(sT, binv[g], bc0[g])); \
                        __hip_atomic_fetch_add(cnt, 1u, __ATOMIC_RELAXED, __HIP_MEMORY_SCOPE_WORKGROUP); } \
                } \
            } } while (0)
        for (int kt = (dpe & 256) ? ntiles : w; kt < ntiles; kt += 3 * NWAVES) {
            DSA_PROC(b0, kt);
            DSA_PIN(); DSA_LDT(b0, kt + 3 * NWAVES); DSA_PIN();
            if (kt + NWAVES < ntiles) DSA_PROC(b1, kt + NWAVES);
            DSA_PIN(); DSA_LDT(b1, kt + 4 * NWAVES); DSA_PIN();
            if (kt + 2 * NWAVES < ntiles) DSA_PROC(b2, kt + 2 * NWAVES);
            DSA_PIN(); DSA_LDT(b2, kt + 5 * NWAVES); DSA_PIN();
        }
#undef DSA_PROC
#undef DSA_SCORE
#undef DSA_LDT
#undef DSA_PIN
    }
#ifdef TP_DSA_RT
    DSA_PREFETCH_NEXT();
#endif
    __syncthreads();
    if (!(dpe & 2)) { *(LAS v4u*)(HISTALL + F.wave * 256 + 4 * lane) = (v4u){0u, 0u, 0u, 0u}; if (lane == 0) ((LAS unsigned*)(F.lds + DSA_ZC))[F.wave] = 0u; return; }
    const int t = t0 + w, n = t + 1;
    LAS u16* myk = KEYS + w * 8192; LAS unsigned* hist = HISTALL + w * 256; LAS u16* sel = (LAS u16*)(F.lds + DSA_SEL) + w * 256;
    LAS u16* bidx = (LAS u16*)(F.lds + DSA_BIDX) + w * DSA_BCAP; LAS float* bsc = (LAS float*)(F.lds + DSA_BSC) + w * DSA_BCAP;
    const LAS u16* IQL = (const LAS u16*)(F.lds + DSA_IQ) + w * 256;
    const unsigned long long lt_mask = (1ull << lane) - 1ull;
    int count;
    if (n <= DSA_TOPK) {
        count = n;
        for (int j = lane; j < DSA_TOPK; j += 64) sel[j] = (u16)(j < n ? j : 0);
        *(LAS v4u*)(hist + 4 * lane) = (v4u){0u, 0u, 0u, 0u};
        if (lane == 0) ((LAS unsigned*)(F.lds + DSA_ZC))[w] = 0u;
    } else {
        count = DSA_TOPK;
        const f32x4 wq = *(const LAS f32x4*)((const LAS float*)(F.lds + DSA_IWL) + w * 4);
        typedef unsigned short us2 __attribute__((ext_vector_type(2)));
        const LAS v4u* k8 = (const LAS v4u*)myk;
        LAS unsigned* ZC = (LAS unsigned*)(F.lds + DSA_ZC);
        const int Z = (int)ZC[w]; const int bz = lin_bin(0.f, minv, mc0);
        if (lane == (bz >> 2)) hist[bz] += (unsigned)Z;
        LDS_WAIT();
        if (lane == 0) ZC[w] = 0u;
        unsigned B, above, E; find_bin(hist, DSA_TOPK, lane, B, above, E);
        LDS_WAIT();
        *(LAS v4u*)(hist + 4 * lane) = (v4u){0u, 0u, 0u, 0u};
        LDS_WAIT();
        const int need = DSA_TOPK - (int)above;
        if (dpe & 16) return;
        const int nch = (npad + 511) >> 9;
        auto count_ge = [&](unsigned thr) -> int {
            const unsigned t1 = thr - 1u, t2 = t1 | (t1 << 16); unsigned one2 = 0x00010001u; asm volatile("" : "+v"(one2)); unsigned acc = 0u;
            for (int ch = 0; ch < nch; ch += 2) {
                v4u kv[2];
#pragma unroll
                for (int u2 = 0; u2 < 2; ++u2) kv[u2] = k8[min(ch + u2, nch - 1) * 64 + lane];
#pragma unroll
                for (int u2 = 0; u2 < 2; ++u2) {
                    const bool live = (ch + u2 < nch) && ((ch + u2) * 512 + 8 * lane < npad);
                    unsigned c4 = pk_gt_flags(kv[u2].x, t2, one2);
                    c4 = pk_add16(c4, pk_gt_flags(kv[u2].y, t2, one2)); c4 = pk_add16(c4, pk_gt_flags(kv[u2].z, t2, one2)); c4 = pk_add16(c4, pk_gt_flags(kv[u2].w, t2, one2));
                    acc = pk_add16(acc, live ? c4 : 0u); }
            }
            return (int)(acc & 0xffffu) + (int)(acc >> 16); };
        bool done = false;
        if (minv > 0.f) {
            unsigned kLo, kHi;
            {
                auto first_ge = [&](int tb) -> unsigned {
                    const float bnd = ((float)tb - mc0) / minv; unsigned k = sortable16(bnd); k = k < 0x0404u ? 0x0404u : (k > 0xfbfbu ? 0xfbfbu : k);
                    unsigned r = 0u;
#pragma unroll
                    for (int d = 4; d >= -3; --d) { const unsigned kk = k + (unsigned)d; if (lin_bin(key_float(kk), minv, mc0) >= tb) r = kk; }
                    const bool okw = (r != 0u) && (lin_bin(key_float(r), minv, mc0) >= tb) && (lin_bin(key_float(r - 1u), minv, mc0) < tb) && (r > 0x0400u);
                    if (okw) return r;
                    unsigned lo = 0x0400u, hi = 0xfc00u;
                    while (lo < hi) { const unsigned mid = (lo + hi) >> 1; if (lin_bin(key_float(mid), minv, mc0) >= tb) hi = mid; else lo = mid + 1; }
                    return lo; };
                kLo = first_ge((int)B);
                kHi = (B == 255u) ? 0xffffu : first_ge((int)B + 1) - 1u;
            }
            unsigned cLo = kLo, cHi = kHi; int need_eq = need, extra_zero = 0; bool ok = (E <= (unsigned)DSA_BCAP);
            if ((int)B == bz && Z > 0) {
                const int mine = count_ge(0x8001u); const int P = (int)wave_sum((float)mine) - (int)above;
                if (need <= P) { cLo = 0x8001u; ok = (P <= DSA_BCAP); }
                else if (need <= P + Z) { cLo = 0x8001u; cHi = 0x8000u; need_eq = 0; extra_zero = need - P; ok = true; }
                else { cHi = 0x7fffu; need_eq = need - P - Z; ok = ((int)E - P - Z <= DSA_BCAP) && ((int)above + (int)E <= 512); }
            }
            if (ok) {
                done = true;
                const unsigned lo1 = cLo - 1u, tl2 = lo1 | (lo1 << 16);
                LAS u16* cand = (LAS u16*)hist;
                const int mycnt = count_ge(cLo);
                const int pre = wave_prefix_incl(mycnt, lane);
                const int C = min(__builtin_amdgcn_readlane(pre, 63), 512);
                int pos = pre - mycnt;
                unsigned one2 = 0x00010001u; asm volatile("" : "+v"(one2));
                for (int ch = 0; ch < nch; ch += 2) {
                    v4u kv[2];
#pragma unroll
                    for (int u2 = 0; u2 < 2; ++u2) kv[u2] = k8[min(ch + u2, nch - 1) * 64 + lane];
#pragma unroll
                    for (int u2 = 0; u2 < 2; ++u2) {
                        const int j0 = (ch + u2) * 512 + 8 * lane;
                        const bool live = (ch + u2 < nch) && (j0 < npad);
                        unsigned m = 0u;
#pragma unroll
                        for (int d = 0; d < 4; ++d) { const unsigned wd = d == 0 ? kv[u2].x : (d == 1 ? kv[u2].y : (d == 2 ? kv[u2].z : kv[u2].w));
                            m |= pk_gt_flags(wd, tl2, one2) << d; }
                        if (!live) m = 0u;
                        while (m) { const int x = __builtin_ctz(m); m &= m - 1u; if (pos < 512) cand[pos] = (u16)(j0 + 2 * (x & 15) + (x >> 4)); ++pos; }
                    }
                }
                LDS_WAIT();
                if (dpe & 32) { *(LAS v4u*)(hist + 4 * lane) = (v4u){0u, 0u, 0u, 0u}; return; }
                int nsel = 0, neq = 0;
                {
                    int idx5[5]; unsigned kk5[5];
#pragma unroll
                    for (int r = 0; r < 5; ++r) { const int e = lane + 64 * r; const int v = (int)cand[e]; idx5[r] = (e < C) ? v : 0; }
#pragma unroll
                    for (int r = 0; r < 5; ++r) kk5[r] = (unsigned)myk[idx5[r]];
#pragma unroll
                    for (int r = 0; r < 5; ++r) {
                        const int e = lane + 64 * r; const bool in = e < C; const int idx = idx5[r]; const unsigned kk = in ? kk5[r] : 0u;
                        const bool gt = in && kk > cHi, eq = in && !gt;
                        const unsigned long long tm = __ballot(gt), em = __ballot(eq);
                        if (gt) sel[nsel + __popcll(tm & lt_mask)] = (u16)idx;
                        if (eq) { const int ep = neq + __popcll(em & lt_mask); if (ep < DSA_BCAP) bidx[ep] = (u16)idx; }
                        nsel += __popcll(tm); neq += __popcll(em);
                    }
                }
                for (int r = 5; r * 64 < C; ++r) {
                    const int e = lane + 64 * r; const bool in = e < C; const int idx = in ? (int)cand[e] : 0; const unsigned kk = in ? (unsigned)myk[idx] : 0u;
                    const bool gt = in && kk > cHi, eq = in && !gt;
                    const unsigned long long tm = __ballot(gt), em = __ballot(eq);
                    if (gt) sel[nsel + __popcll(tm & lt_mask)] = (u16)idx;
                    if (eq) { const int ep = neq + __popcll(em & lt_mask); if (ep < DSA_BCAP) bidx[ep] = (u16)idx; }
                    nsel += __popcll(tm); neq += __popcll(em);
                }
                LDS_WAIT();
                *(LAS v4u*)(hist + 4 * lane) = (v4u){0u, 0u, 0u, 0u};
                if (neq == need_eq) { for (int e = lane; e < neq; e += 64) sel[nsel + e] = bidx[e]; nsel += neq; }
                else if (need_eq > 0) {
                    nsel = dsa_rescore_select(F.lds, IKb, wq, bidx, bsc, sel, nsel, min(neq, DSA_BCAP), need_eq, lane, w, lt_mask, dpe);
                }
                if (extra_zero > 0) {
                    int base = 0;
                    for (int c0 = 0; c0 < npad && base < extra_zero; c0 += 512) {
                        const int j0 = c0 + 8 * lane; v4u kv = (v4u){0u, 0u, 0u, 0u}; if (j0 < npad) kv = k8[j0 >> 3];
                        unsigned m8 = 0u;
#pragma unroll
                        for (int x = 0; x < 8; ++x) { const unsigned wd = x < 2 ? kv.x : (x < 4 ? kv.y : (x < 6 ? kv.z : kv.w)); const unsigned kk = (x & 1) ? (wd >> 16) : (wd & 0xffffu); m8 |= (kk == 0x8000u ? 1u : 0u) << x; }
                        const int c = __builtin_popcount(m8);
                        int ex = 0;
#pragma unroll
                        for (int bit = 0; bit < 4; ++bit) ex += __popcll(__ballot((c >> bit) & 1) & lt_mask) << bit;
                        int tot = 0;
#pragma unroll
                        for (int bit = 0; bit < 4; ++bit) tot += __popcll(__ballot((c >> bit) & 1)) << bit;
                        int rk = base + ex;
#pragma unroll
                        for (int x = 0; x < 8; ++x) if ((m8 >> x) & 1u) { if (rk < extra_zero) sel[nsel + rk] = (u16)(j0 + x); ++rk; }
                        base += tot;
                    }
                    nsel += extra_zero;
                }
            }
        }
        if (!done) {
            dsa_select_slow(F.lds, w, myk, hist, sel, bidx, bsc, IKb, wq, npad, lane, lt_mask);
            LDS_WAIT();
            *(LAS v4u*)(hist + 4 * lane) = (v4u){0u, 0u, 0u, 0u};
        }
    }
    LDS_WAIT();
    if (!(dpe & 4)) return;
    {
        LAS float* PF = (LAS float*)myk;
        LAS u16* PB = (LAS u16*)(PF + 1024);
        LAS unsigned char* VS = (LAS unsigned char*)(PB + 1024);
        const int l16 = lane & 15, qt = lane >> 4, r8 = lane >> 3;
        const bf16* gb = KAVAb + 8 * (lane & 7);
        LAS unsigned char* stw = VS + r8 * DSA_VROW + 16 * (lane & 7);
        v4u kk[32];
#pragma unroll
        for (int i = 0; i < 32; ++i) { const int idx = (int)sel[r8 + 8 * i]; kk[i] = *(const v4u*)(gb + (long)idx * 128); }
        v4u vq[4][8];
#pragma unroll
        for (int i = 0; i < 8; ++i) { const int idx = (int)sel[r8 + 8 * i]; vq[0][i] = *(const v4u*)(gb + (long)idx * 128 + 64); }
        bf16x8 aq[2];
#pragma unroll
        for (int ks = 0; ks < 2; ++ks) { v4u z = (v4u){0u, 0u, 0u, 0u}; if (l16 < 4) z = *(const v4u*)(AQ + (rowbase + t) * 256 + l16 * 64 + 32 * ks + 8 * qt); aq[ks] = __builtin_bit_cast(bf16x8, z); }
#pragma unroll
        for (int c = 0; c < 4; ++c) {
#pragma unroll
            for (int i = 0; i < 8; ++i) *(LAS v4u*)(stw + 8 * i * DSA_VROW) = kk[8 * c + i];
#pragma unroll
            for (int t4 = 0; t4 < 4; ++t4) {
                const LAS unsigned char* rp = VS + (16 * t4 + l16) * DSA_VROW + 16 * qt;
                const bf16x8 kA = *(const LAS bf16x8*)rp, kB = *(const LAS bf16x8*)(rp + 64);
                f32x4 acc = {0.f, 0.f, 0.f, 0.f};
                acc = __builtin_amdgcn_mfma_f32_16x16x32_bf16(aq[0], kA, acc, 0, 0, 0);
                acc = __builtin_amdgcn_mfma_f32_16x16x32_bf16(aq[1], kB, acc, 0, 0, 0);
                const int j = 64 * c + 16 * t4 + l16;
                if (qt == 0) *(LAS f32x4*)(PF + j * 4) = (j < count) ? acc * SM_C : (f32x4){-1e30f, -1e30f, -1e30f, -1e30f};
            }
        }
#ifndef TP_DSA_RT
        DSA_PREFETCH_NEXT();
#endif
#pragma unroll
        for (int c = 1; c < 4; ++c)
#pragma unroll
            for (int i = 0; i < 8; ++i) { const int idx = (int)sel[64 * c + r8 + 8 * i]; vq[c][i] = *(const v4u*)(gb + (long)idx * 128 + 64); }
        LDS_WAIT();
        {
            f32x4 z4[4];
#pragma unroll
            for (int jj = 0; jj < 4; ++jj) z4[jj] = *(const LAS f32x4*)(PF + (lane + 64 * jj) * 4);
#pragma unroll
            for (int hd = 0; hd < 4; ++hd) {
                const float m = wave_max(fmaxf(fmaxf(z4[0][hd], z4[1][hd]), fmaxf(z4[2][hd], z4[3][hd])));
                float s = 0.f;
#pragma unroll
                for (int jj = 0; jj < 4; ++jj) { const float p = (lane + 64 * jj < count) ? __builtin_amdgcn_exp2f(z4[jj][hd] - m) : 0.f; z4[jj][hd] = p; s += p; }
                const float inv = 1.0f / wave_sum(s);
#pragma unroll
                for (int jj = 0; jj < 4; ++jj) PB[hd * 256 + lane + 64 * jj] = (u16)f2bf(z4[jj][hd] * inv);
            }
        }
        LDS_WAIT();
        f32x4 o[4];
#pragma unroll
        for (int nt = 0; nt < 4; ++nt) o[nt] = (f32x4){0.f, 0.f, 0.f, 0.f};
        const unsigned VSa = (unsigned)(uintptr_t)VS;
#pragma unroll
        for (int c = 0; c < 4; ++c) {
#pragma unroll
            for (int i = 0; i < 8; ++i) *(LAS v4u*)(stw + 8 * i * DSA_VROW) = vq[c][i];
            LDS_WAIT();
#pragma unroll
            for (int kk2 = 0; kk2 < 2; ++kk2) {
                v4u pz = (v4u){0u, 0u, 0u, 0u}; if (l16 < 4) pz = *(const LAS v4u*)(PB + l16 * 256 + 64 * c + 32 * kk2 + 8 * qt);
                const bf16x8 pf = __builtin_bit_cast(bf16x8, pz);
#pragma unroll
                for (int nt = 0; nt < 4; ++nt) {
                    const unsigned a0 = VSa + (32 * kk2 + 8 * qt + (l16 >> 2)) * DSA_VROW + (16 * nt + 4 * (l16 & 3)) * 2;
                    s16x4 lo = tr_read(a0), hi = tr_read(a0 + 4 * DSA_VROW);
                    asm volatile("s_waitcnt lgkmcnt(0)" : "+v"(lo), "+v"(hi) :: "memory");
                    const bf16x8 vf = (bf16x8){lo[0], lo[1], lo[2], lo[3], hi[0], hi[1], hi[2], hi[3]};
                    o[nt] = __builtin_amdgcn_mfma_f32_16x16x32_bf16(pf, vf, o[nt], 0, 0, 0);
                }
            }
            LDS_WAIT();
        }
        if (qt == 0 && !(dpe & 512)) { bf16* orow = AQ + (rowbase + t) * 256 + l16;
#pragma unroll
            for (int hd = 0; hd < 4; ++hd)
#pragma unroll
                for (int nt = 0; nt < 4; ++nt) orow[hd * 64 + 16 * nt] = (bf16)f2bf(o[nt][hd]); }
    }
#undef DSA_PREFETCH_NEXT
}

template <int PART = 7, int DSAP = 7> __device__ __forceinline__ void phase_attention(Frame& F, int l) {
    if (PART & 2) for (int L = F.vcu; L < 256; L += F.G) { const int b = L >> 6, h = (L >> 4) & 3, p = L & 15; moba_unit2(F, b, h, p); moba_unit2(F, b, h, 31 - p); }
    if (PART & 4) for (int L = F.vcu; L < 512; L += F.G) swa_unit(F, l, L >> 7, (L >> 6) & 1, L & 63);
    if (PART & 1) { __syncthreads(); for (int i = F.tid; i < 2048; i += NTHR) ((LAS unsigned*)(F.lds + DSA_HIST))[i] = 0u; if (F.tid < 8) ((LAS unsigned*)(F.lds + DSA_ZC))[F.tid] = 0u; }
#ifdef TP_DSA_RT
    int npass = 2; asm volatile("" : "+s"(npass));
    for (int pass = 0; pass < npass; ++pass) { int dpr = (pass + 1 < npass) ? (TP_DSA_RT) : 7; asm volatile("" : "+s"(dpr));
#else
    { constexpr int dpr = 7;
#endif
    if (PART & 1) {
        const int ngrp = (F.G == 256) ? 4 : 1, grp = (F.G == 256) ? (F.vcu >> 6) : 0, per = (T / 8) / ngrp;
#ifdef TP_DSA_RT
        gu32* qc = (gu32*)(F_WS + WS_CTL) + CW_DSAQ + 64 * l + 16 * pass + grp;
#else
        gu32* qc = (gu32*)(F_WS + WS_CTL) + CW_DSAQ + 64 * l + grp;
#endif
        LAS int* NXT = (LAS int*)(F.lds + DSA_NXT);
        int pend = 0;
        if (F.tid == 0) { NXT[0] = (int)__hip_atomic_fetch_add(qc, 1u, RLX_AGENT); pend = (int)__hip_atomic_fetch_add(qc, 1u, RLX_AGENT); }
        __syncthreads();
        int b, t0;
        { const int k0 = NXT[0]; if (k0 >= per) { b = 0; t0 = -1; } else if (ngrp == 4) { b = grp; t0 = 8 * (per - 1 - k0); } else { b = k0 & 3; t0 = 8 * ((T / 32) - 1 - (k0 >> 2)); } }
        __syncthreads();
        v2u iqn = (v2u){0u, 0u}; float iwn = 0.f;
        if (t0 >= 0) { const u16* IQ = (const u16*)(F_WS + WS_IQ); const float* IW = (const float*)(F_WS + WS_IW);
            iqn = *(const v2u*)(IQ + ((long)b * SEQ + t0) * 256 + 4 * F.tid); if (F.tid < 32) iwn = IW[((long)b * SEQ + t0) * 4 + F.tid]; }
        while (t0 >= 0) { int nb = 0, nt0 = -1;
            if (F.tid == 0) { NXT[0] = pend; pend = (int)__hip_atomic_fetch_add(qc, 1u, RLX_AGENT); }
#ifdef TP_DSA_RT
            dsa_unit<0x7fffffff>(F, b, t0, nb, nt0, grp, ngrp, iqn, iwn, dpr);
#else
            dsa_unit<DSAP>(F, b, t0, nb, nt0, grp, ngrp, iqn, iwn, dpr);
#endif
            b = nb; t0 = nt0; }
    }
    }
    __syncthreads();
}

struct SchedBranch {
    unsigned char* ws; const char* Bw; int G, vcu;
    __device__ __forceinline__ bool next(int i, pg8::Unit& u) const {
        const int tau = (i / 3) * G + vcu, br = i % 3; if (tau >= 512) return false;
        const int pm = tau >> 2, pn = tau & 3;
        const size_t aoff = br == 0 ? WS_AQ : (br == 1 ? WS_BQ : WS_CQ); const int lda = br == 2 ? 512 : 256; const int kb = br == 0 ? 0 : (br == 1 ? 256 : 512);
        u.A = (const char*)(ws + aoff) + (size_t)pm * 256 * lda * 2; u.B = Bw + (size_t)pn * 256 * 1024 * 2 + kb * 2; u.rowlist = nullptr; u.nvalid = 256; u.lda = lda; u.nt = lda / 64;
        u.ksplit = 1 << 30; u.bdelta = 0; u.p0 = pm; u.p1 = pn; u.p2 = br; u.p3 = 0; return true;
    }
};
struct EpiBranch {
    static constexpr bool PERM = true;
    static __device__ __forceinline__ bool keep_acc(const pg8::Unit& u) { return u.p2 < 2; }
    unsigned char* ws;
    __device__ __forceinline__ void operator()(f32x4 (&acc)[2][2][4][2], const pg8::Unit& u, int wr, int wc, int fr, int fq) const {
        const int pm = u.p0, pn = u.p1, br = u.p2;
        bf16* MG = (bf16*)(ws + WS_MERGED);
        const int row0 = pm * 256 + wr * 64 + fr, col0 = pn * 256 + wc * 32 + 8 * fq;
        const unsigned char* GATES8 = (const unsigned char*)(ws + WS_GATES);
        const unsigned char* gp = GATES8 + (size_t)row0 * 3072 + br * 1024 + col0;
#define GQ(vv_, ee_) ((float)(((ee_) < 4 ? (vv_)[0] >> (8 * ((ee_) & 3)) : (vv_)[1] >> (8 * ((ee_) & 3))) & 0xffu))
        if (br < 2) {
#pragma unroll
            for (int ai = 0; ai < 2; ++ai) {
                v2u g[4][2], gn[4][2];
#pragma unroll
                for (int m = 0; m < 4; ++m)
#pragma unroll
                    for (int bj = 0; bj < 2; ++bj) { const unsigned char* q = gp + (size_t)(ai * 128 + m * 16) * 3072 + bj * 128; g[m][bj] = *(const v2u*)q; gn[m][bj] = *(const v2u*)(q + 1024); }
#pragma unroll
                for (int m = 0; m < 4; ++m)
#pragma unroll
                    for (int bj = 0; bj < 2; ++bj) {
                        const v2u a = g[m][bj], d = gn[m][bj];
#pragma unroll
                        for (int e = 0; e < 4; ++e) { acc[ai][bj][m][0][e] *= GQ(a, e) * __builtin_amdgcn_rcpf(GQ(d, e)); acc[ai][bj][m][1][e] *= GQ(a, 4 + e) * __builtin_amdgcn_rcpf(GQ(d, 4 + e)); }
                    }
            }
        } else {
#pragma unroll
            for (int ai = 0; ai < 2; ++ai) {
                v2u g[4][2];
#pragma unroll
                for (int m = 0; m < 4; ++m)
#pragma unroll
                    for (int bj = 0; bj < 2; ++bj) g[m][bj] = *(const v2u*)(gp + (size_t)(ai * 128 + m * 16) * 3072 + bj * 128);
#pragma unroll
                for (int m = 0; m < 4; ++m)
#pragma unroll
                    for (int bj = 0; bj < 2; ++bj) {
                        const v2u a = g[m][bj];
                        f32x4 x0 = acc[ai][bj][m][0], x1 = acc[ai][bj][m][1];
#pragma unroll
                        for (int e = 0; e < 4; ++e) { x0[e] *= GQ(a, e) * (1.0f / 255.0f); x1[e] *= GQ(a, 4 + e) * (1.0f / 255.0f); }
                        v4u w; w.x = cvt_pk_bf16(x0[0], x0[1]); w.y = cvt_pk_bf16(x0[2], x0[3]); w.z = cvt_pk_bf16(x1[0], x1[1]); w.w = cvt_pk_bf16(x1[2], x1[3]);
                        *(v4u*)(MG + (size_t)(row0 + ai * 128 + m * 16) * 1024 + col0 + bj * 128) = w;
                    }
            }
        }
#undef GQ
    }
};
__device__ __forceinline__ void phase_branch(Frame& F, int l) {
    SchedBranch S{F_WS, (const char*)(F_WS + WS_WBR) + (size_t)l * 1024 * 1024 * 2, F.G, F.vcu};
    EpiBranch E{F_WS};
    pg8::gemm_phase<EpiBranch, SchedBranch, true>(F.lds, F.tid, 1024, S, E);
}

struct EpiY {
    static constexpr bool PERM = true;
    static __device__ __forceinline__ bool keep_acc(const pg8::Unit&) { return false; }
    bf16* Y;
    __device__ __forceinline__ void operator()(const f32x4 (&acc)[2][2][4][2], const pg8::Unit& u, int wr, int wc, int fr, int fq) const {
        const int row0 = u.p0 * 256 + wr * 64 + fr, col0 = u.p1 * 256 + wc * 32 + 8 * fq;
#pragma unroll
        for (int ai = 0; ai < 2; ++ai)
#pragma unroll
            for (int m = 0; m < 4; ++m) { bf16* rp = Y + (size_t)(row0 + ai * 128 + m * 16) * 1024 + col0;
#pragma unroll
                for (int bj = 0; bj < 2; ++bj) { const f32x4 a = acc[ai][bj][m][0], b = acc[ai][bj][m][1];
                    v4u w; w.x = cvt_pk_bf16(a[0], a[1]); w.y = cvt_pk_bf16(a[2], a[3]); w.z = cvt_pk_bf16(b[0], b[1]); w.w = cvt_pk_bf16(b[2], b[3]);
                    *(v4u*)(rp + bj * 128) = w; } }
    }
};
__device__ __forceinline__ void phase_wo(Frame& F, int l) {
    SchedDense S; S.A = (const char*)(F_WS + WS_MERGED); S.B = (const char*)(F_WS + WS_WO) + (size_t)l * 1024 * 1024 * 2; S.lda = 1024; S.lda_b = 256 * 1024 * 2; S.ldb_b = 256 * 1024 * 2; S.nN = 4; S.nt = 16; S.G = F.G; S.vcu = F.vcu; S.ntiles = 512;
    EpiY E{(bf16*)(F_WS + WS_Y)};
    pg8::gemm_phase<EpiY, SchedDense, true>(F.lds, F.tid, 1024, S, E);
}

struct LnIn { f32x4 a[4]; v2u b[4]; };
__device__ __forceinline__ void ln_load(LnIn& R, const float* xin, const bf16* y, int lane) {
#pragma unroll
    for (int j = 0; j < 4; ++j) { R.a[j] = *(const f32x4*)(xin + 4 * lane + 256 * j); R.b[j] = *(const v2u*)(y + 4 * lane + 256 * j); }
}
__device__ __forceinline__ void ln_finish(const LnIn& R, const f32x4 (&gg)[4], const f32x4 (&bb)[4], float* xout, bf16* xb, int lane, f32x4 (&o)[4]) {
    f32x4 v[4]; float s = 0.f;
#pragma unroll
    for (int j = 0; j < 4; ++j) { const f32x4 yv = (f32x4){bflo(R.b[j].x), bfhi(R.b[j].x), bflo(R.b[j].y), bfhi(R.b[j].y)}; v[j] = R.a[j] * DN_ALPHA + yv; s += (v[j].x + v[j].y) + (v[j].z + v[j].w); }
    const float mean = wave_sum(s) * (1.f / D); float s2 = 0.f;
#pragma unroll
    for (int j = 0; j < 4; ++j) { v[j] = v[j] - mean; s2 += (v[j].x * v[j].x + v[j].y * v[j].y) + (v[j].z * v[j].z + v[j].w * v[j].w); }
    const float rstd = 1.0f / sqrtf(wave_sum(s2) * (1.f / D) + LN_EPS);
#pragma unroll
    for (int j = 0; j < 4; ++j) { o[j] = v[j] * rstd * gg[j] + bb[j]; *(f32x4*)(xout + 4 * lane + 256 * j) = o[j];
        v2u w; w.x = pk2(o[j].x, o[j].y); w.y = pk2(o[j].z, o[j].w); *(v2u*)(xb + 4 * lane + 256 * j) = w; }
}
__device__ __forceinline__ void phase_ln1_route(Frame& F, int l) {
    convert_moe_weights(F, l);
    __syncthreads();
    LAS float* RWL = (LAS float*)F.lds;
    LAS int* lcnt = (LAS int*)(F.lds + 140000);
    LAS int* lbase = lcnt + 32;
    LAS int* ent = lcnt + 64;
    LAS float* entw = (LAS float*)(ent + 1024);
    const float* xin = (l == 0) ? F_IN(I_X) : F_OUT; const bf16* Y = (const bf16*)(F_WS + WS_Y);
    const float* g = F_IN(I_LN1G) + l * D; const float* bt = F_IN(I_LN1B) + l * D; const float* RW = F_IN(I_RW); const float* RB = F_IN(I_RB);
    bf16* XB = (bf16*)(F_WS + WS_XB);
    unsigned* gcnt = (unsigned*)(F_WS + WS_CTL) + CW_CNT + l * 24 * 64;
    int* LIST = (int*)(F_WS + WS_LIST); f32x2* CWp = (f32x2*)(F_WS + WS_CW);
    for (int i = F.tid; i < 16384; i += NTHR) RWL[(i & 15) * 1024 + (i >> 4)] = RW[i];
    f32x4 gg[4], bb[4];
#pragma unroll
    for (int j = 0; j < 4; ++j) { gg[j] = *(const f32x4*)(g + 4 * F.lane + 256 * j); bb[j] = *(const f32x4*)(bt + 4 * F.lane + 256 * j); }
    const int rows_per = (T + F.G - 1) / F.G;
    for (int chunk = 0; chunk < rows_per; chunk += 512) {
        if (F.tid < 24) lcnt[F.tid] = 0;
        __syncthreads();
        const int r_lo = F.vcu * rows_per + chunk, r_hi = min(min(r_lo + 512, (F.vcu + 1) * rows_per), T);
        LnIn cur, nxt;
        int row = r_lo + F.wave;
        if (row < r_hi) ln_load(cur, xin + (size_t)row * D, Y + (size_t)row * D, F.lane);
        for (; row < r_hi; row += NWAVES) {
            if (row + NWAVES < r_hi) ln_load(nxt, xin + (size_t)(row + NWAVES) * D, Y + (size_t)(row + NWAVES) * D, F.lane);
            f32x4 o[4];
            ln_finish(cur, gg, bb, F_OUT + (size_t)row * D, XB + (size_t)row * D, F.lane, o);
            float lg[16];
#pragma unroll
            for (int e = 0; e < 16; ++e) { float a = 0.f;
#pragma unroll
                for (int j = 0; j < 4; ++j) { const f32x4 w4 = *(const LAS f32x4*)(RWL + e * 1024 + 4 * F.lane + 256 * j); a = fmaf(o[j].x, w4.x, a); a = fmaf(o[j].y, w4.y, a); a = fmaf(o[j].z, w4.z, a); a = fmaf(o[j].w, w4.w, a); }
                lg[e] = a; }
#pragma unroll
            for (int e = 0; e < 16; ++e) lg[e] = wave_sum(lg[e]);
            if (F.lane == 0) {
                float aff[16], ss[16];
#pragma unroll
                for (int e = 0; e < 16; ++e) { aff[e] = 1.0f / (1.0f + expf(-lg[e])); ss[e] = aff[e] + RB[e]; }
                int gbest = 0; float gs = -INFINITY;
#pragma unroll
                for (int gq = 0; gq < 4; ++gq) { float m1 = -INFINITY, m2 = -INFINITY;
#pragma unroll
                    for (int i = 0; i < 4; ++i) { const float v = ss[4 * gq + i]; if (v > m1) { m2 = m1; m1 = v; } else if (v > m2) m2 = v; }
                    const float sc = m1 + m2; if (sc > gs) { gs = sc; gbest = gq; } }
                float m1 = -INFINITY, m2 = -INFINITY; int i1 = 0, i2 = 0;
#pragma unroll
                for (int gq = 0; gq < 4; ++gq) if (gq == gbest) {
#pragma unroll
                    for (int i = 0; i < 4; ++i) { const float v = ss[4 * gq + i]; if (v > m1) { m2 = m1; i2 = i1; m1 = v; i1 = i; } else if (v > m2) { m2 = v; i2 = i; } } }
                float a1 = 0.f, a2 = 0.f;
#pragma unroll
                for (int e = 0; e < 16; ++e) { if (e == 4 * gbest + i1) a1 = aff[e]; if (e == 4 * gbest + i2) a2 = aff[e]; }
                const float inv = 1.0f / (a1 + a2);
                const int lo_i = min(i1, i2), hi_i = max(i1, i2);
                const float c_lo = (i1 < i2 ? a1 : a2) * inv, c_hi = (i1 < i2 ? a2 : a1) * inv;
                const int pidx = (lo_i == 0) ? (hi_i - 1) : (lo_i == 1 ? 1 + hi_i : 5);
                const int pair = min(max(gbest * 6 + pidx, 0), NPAIR - 1);
                const int lp = __hip_atomic_fetch_add(lcnt + pair, 1, __ATOMIC_RELAXED, __HIP_MEMORY_SCOPE_WORKGROUP);
                const int k = row - r_lo; ent[2 * k] = pair; ent[2 * k + 1] = lp; entw[2 * k] = c_lo; entw[2 * k + 1] = c_hi;
            }
#pragma unroll
            for (int j = 0; j < 4; ++j) { cur.a[j] = nxt.a[j]; cur.b[j] = nxt.b[j]; }
        }
        __syncthreads();
        if (F.tid < 24) lbase[F.tid] = (int)__hip_atomic_fetch_add(gcnt + F.tid * 64, (unsigned)lcnt[F.tid], __ATOMIC_RELAXED, __HIP_MEMORY_SCOPE_AGENT);
        __syncthreads();
        for (int k = F.tid; k < r_hi - r_lo; k += NTHR) { const int pair = ent[2 * k], pos = lbase[pair] + ent[2 * k + 1];
            LIST[(size_t)pair * T + pos] = r_lo + k; CWp[(size_t)pair * T + pos] = (f32x2){entw[2 * k], entw[2 * k + 1]}; }
        __syncthreads();
    }
}
__device__ __forceinline__ void phase_ln2(Frame& F, int l) {
    const bf16* Y = (const bf16*)(F_WS + WS_Y); const float* g = F_IN(I_LN2G) + l * D; const float* bt = F_IN(I_LN2B) + l * D; bf16* XB = (bf16*)(F_WS + WS_XB);
    const int gw = F.vcu * NWAVES + F.wave, NGW = F.G * NWAVES;
    f32x4 gg[4], bb[4];
#pragma unroll
    for (int j = 0; j < 4; ++j) { gg[j] = *(const f32x4*)(g + 4 * F.lane + 256 * j); bb[j] = *(const f32x4*)(bt + 4 * F.lane + 256 * j); }
    LnIn cur, nxt;
    int row = gw;
    if (row < T) ln_load(cur, F_OUT + (size_t)row * D, Y + (size_t)row * D, F.lane);
    for (; row < T; row += NGW) {
        if (row + NGW < T) ln_load(nxt, F_OUT + (size_t)(row + NGW) * D, Y + (size_t)(row + NGW) * D, F.lane);
        f32x4 o[4]; ln_finish(cur, gg, bb, F_OUT + (size_t)row * D, XB + (size_t)row * D, F.lane, o);
#pragma unroll
        for (int j = 0; j < 4; ++j) { cur.a[j] = nxt.a[j]; cur.b[j] = nxt.b[j]; }
    }
}

__device__ __forceinline__ void moe_table(Frame& F, int l, LAS int* tp, LAS int* cn) {
    const unsigned* gcnt = (const unsigned*)(F_WS + WS_CTL) + CW_CNT + l * 24 * 64;
    if (F.tid == 0) { int acc = 0; for (int p = 0; p < 24; ++p) { const int c = (int)__hip_atomic_load(gcnt + p * 64, __ATOMIC_RELAXED, __HIP_MEMORY_SCOPE_AGENT); cn[p] = c; tp[p] = acc; acc += (c + 255) >> 8; } tp[24] = acc; }
    __syncthreads();
}
__device__ __forceinline__ void pair_experts(int p, int& e0, int& e1) { const int gq = p / 6, k = p % 6; const int lo = k < 3 ? 0 : (k < 5 ? 1 : 2); const int hi = k < 3 ? k + 1 : (k < 5 ? k - 1 : 3); e0 = 4 * gq + lo; e1 = 4 * gq + hi; }
struct SchedMoeUp {
    unsigned char* ws; const LAS int* tp; const LAS int* cn; int G, vcu, RT;
    __device__ __forceinline__ bool next(int i, pg8::Unit& u) const {
        const int L = i * G + vcu; if (L >= RT * 8) return false;
        const int rt = L >> 3, ct = L & 7; int p = 0;
        for (int q = 1; q < 24; ++q) if (tp[q] <= rt) p = q;
        int e0, e1; pair_experts(p, e0, e1); const int e = ct < 4 ? e0 : e1; const int lr0 = (rt - tp[p]) * 256;
        u.A = (const char*)(ws + WS_XB); u.B = (const char*)(ws + WS_WGU) + ((size_t)e * 1024 + (ct & 3) * 256) * 1024 * 2;
        u.rowlist = (const int*)(ws + WS_LIST) + (size_t)p * T + lr0; u.nvalid = min(256, cn[p] - lr0); u.lda = 1024; u.nt = 16; u.ksplit = 1 << 30; u.bdelta = 0;
        u.p0 = rt; u.p1 = ct; u.p2 = p; u.p3 = lr0; return true;
    }
};
struct EpiMoeUp {
    static constexpr bool PERM = true;
    static __device__ __forceinline__ bool keep_acc(const pg8::Unit&) { return false; }
    unsigned char* ws;
    __device__ __forceinline__ void operator()(const f32x4 (&acc)[2][2][4][2], const pg8::Unit& u, int wr, int wc, int fr, int fq) const {
        const int rt = u.p0, ct = u.p1, p = u.p2, lr0 = u.p3;
        bf16* H = (bf16*)(ws + WS_H); const f32x2* CWp = (const f32x2*)(ws + WS_CW) + (size_t)p * T + lr0;
        const int slot = ct >> 2;
        float cw1[2][4];
#pragma unroll
        for (int ai = 0; ai < 2; ++ai)
#pragma unroll
            for (int m = 0; m < 4; ++m) cw1[ai][m] = ((const float*)CWp)[2 * min(ai * 128 + wr * 64 + m * 16 + fr, u.nvalid - 1) + slot];
#pragma unroll
        for (int ai = 0; ai < 2; ++ai)
#pragma unroll
            for (int m = 0; m < 4; ++m) { const int r = ai * 128 + wr * 64 + m * 16 + fr; const bool ok = r < u.nvalid;
                const float cw = ok ? cw1[ai][m] : 0.f;
#pragma unroll
                for (int bj = 0; bj < 2; ++bj) { const f32x4 gv = acc[ai][bj][m][0], uv = acc[ai][bj][m][1];
                    float hh[4];
#pragma unroll
                    for (int x = 0; x < 4; ++x) { const float gx = gv[x]; hh[x] = ok ? gx * sigmoidf_(gx) * uv[x] * cw : 0.f; }
                    v2u w; w.x = cvt_pk_bf16(hh[0], hh[1]); w.y = cvt_pk_bf16(hh[2], hh[3]);
                    *(v2u*)(H + (size_t)(rt * 256 + r) * 1024 + slot * 512 + (ct & 3) * 128 + bj * 64 + wc * 16 + 4 * fq) = w; } }
    }
};
struct SchedMoeDown {
    unsigned char* ws; const LAS int* tp; const LAS int* cn; int G, vcu, RT;
    __device__ __forceinline__ bool next(int i, pg8::Unit& u) const {
        const int L = i * G + vcu; if (L >= RT * 4) return false;
        const int rt = L >> 2, ct = L & 3; int p = 0;
        for (int q = 1; q < 24; ++q) if (tp[q] <= rt) p = q;
        int e0, e1; pair_experts(p, e0, e1); const int lr0 = (rt - tp[p]) * 256;
        u.A = (const char*)(ws + WS_H) + (size_t)rt * 256 * 1024 * 2; u.B = (const char*)(ws + WS_WD) + ((size_t)ct * 256 * (NEXP * DE) + e0 * DE) * 2;
        u.rowlist = nullptr; u.nvalid = min(256, cn[p] - lr0); u.lda = 1024; u.nt = 16; u.ksplit = 8; u.bdelta = (long)(e1 - e0 - 1) * DE * 2;
        u.p0 = rt; u.p1 = ct; u.p2 = p; u.p3 = lr0; return true;
    }
};
struct EpiMoeDown {
    static constexpr bool PERM = true;
    static __device__ __forceinline__ bool keep_acc(const pg8::Unit&) { return false; }
    unsigned char* ws;
    __device__ __forceinline__ void operator()(const f32x4 (&acc)[2][2][4][2], const pg8::Unit& u, int wr, int wc, int fr, int fq) const {
        const int ct = u.p1, p = u.p2, lr0 = u.p3;
        bf16* Y = (bf16*)(ws + WS_Y); const int* LIST = (const int*)(ws + WS_LIST) + (size_t)p * T + lr0;
        const int col0 = ct * 256 + wc * 32 + 8 * fq;
#pragma unroll
        for (int ai = 0; ai < 2; ++ai)
#pragma unroll
            for (int m = 0; m < 4; ++m) { const int r = ai * 128 + wr * 64 + m * 16 + fr;
                if (r < u.nvalid) { const int tok = LIST[r]; bf16* rp = Y + (size_t)tok * 1024 + col0;
#pragma unroll
                    for (int bj = 0; bj < 2; ++bj) { const f32x4 a = acc[ai][bj][m][0], b = acc[ai][bj][m][1];
                        v4u w; w.x = cvt_pk_bf16(a[0], a[1]); w.y = cvt_pk_bf16(a[2], a[3]); w.z = cvt_pk_bf16(b[0], b[1]); w.w = cvt_pk_bf16(b[2], b[3]);
                        *(v4u*)(rp + bj * 128) = w; } } }
    }
};
__device__ __forceinline__ void phase_moe_up(Frame& F, int l) {
    LAS int* tp = (LAS int*)(F.lds + LDS_MISC_OFF + 64); LAS int* cn = tp + 32;
    moe_table(F, l, tp, cn);
    SchedMoeUp S{F_WS, tp, cn, F.G, F.vcu, __builtin_amdgcn_readfirstlane(tp[24])}; EpiMoeUp E{F_WS};
    pg8::gemm_phase<EpiMoeUp, SchedMoeUp, true>(F.lds, F.tid, 1024, S, E);
}
__device__ __forceinline__ void phase_moe_down(Frame& F, int l) {
    LAS int* tp = (LAS int*)(F.lds + LDS_MISC_OFF + 64); LAS int* cn = tp + 32;
    moe_table(F, l, tp, cn);
    SchedMoeDown S{F_WS, tp, cn, F.G, F.vcu, __builtin_amdgcn_readfirstlane(tp[24])}; EpiMoeDown E{F_WS};
    pg8::gemm_phase<EpiMoeDown, SchedMoeDown, true>(F.lds, F.tid, NEXP * DE, S, E);
}


#ifndef TP_DSAP
#define TP_DSAP 7
#endif
#ifndef TP_PHASE
#define TP_PHASE -1
#endif
__global__ void __launch_bounds__(NTHR, 2) fwd_kernel(Args args) {
    extern __shared__ __attribute__((aligned(16))) unsigned char lds[];
    Frame F;
    F.lds = (LAS unsigned char*)lds; F.wsg = (gbyte*)args.ws; F.outg = (GAS float*)args.out;
#pragma unroll
    for (int i = 0; i < 16; ++i) F.ing[i] = (GAS const float*)args.in[i];
    const int wave0 = __builtin_amdgcn_readfirstlane((int)threadIdx.x >> 6);
    F.lane = lane_id(); F.tid = wave0 * 64 + F.lane; F.wave = wave0;
    F.G = gridDim.x; { const int bx = blockIdx.x; F.vcu = (F.G % 8 == 0) ? (bx % 8) * (F.G / 8) + bx / 8 : bx; }
    volatile LAS unsigned* MISC = (volatile LAS unsigned*)(F.lds + LDS_MISC_OFF);
    for (int u = F.tid; u < 128; u += NTHR) MISC[u] = 0u;
    __syncthreads();
    XcdBarrier bar = xcd_barrier_post((gu32*)(F.wsg + WS_CTL) + CW_BAR, MISC + 8, F.tid == 0);
    const int lo = args.ph_lo, hi = args.ph_hi;
#define IN(k) (lo <= (k) && (k) < hi)
#define PB() do { gbyte* w_ = (gbyte*)args.ws; asm volatile("" : "+s"(w_)); F.wsg = w_; int t_ = wave0 * 64 + lane_id(); asm volatile("" : "+v"(t_)); F.tid = t_; F.lane = t_ & 63; F.wave = wave0; } while (0)
#define XBAR() xcd_barrier(bar, wave0 == 0 && lane_id() == 0)
#define SEAM(k) do { if (IN(k) && IN((k) + 1)) xcd_barrier(bar, wave0 == 0 && lane_id() == 0); } while (0)
    if (IN(0)) { PB(); phase_prologue_a(F); XBAR(); PB(); phase_prologue(F); } SEAM(0);
    if (TP_PHASE == 20) { PB(); phase_prologue_a(F); XBAR(); PB(); phase_prologue(F); XBAR(); }
    if (TP_PHASE == 21) { PB(); convert_moe_weights(F, 0); XBAR(); }
    if (TP_PHASE == 40) { XBAR(); XBAR(); XBAR(); XBAR(); XBAR(); XBAR(); XBAR(); XBAR(); XBAR(); XBAR(); XBAR(); XBAR(); XBAR(); XBAR(); XBAR(); XBAR(); }
#define LAYER(l) do { const int pb = 1 + 8 * (l); \
        if (IN(pb + 0)) { PB(); phase_inproj(F, (l)); } SEAM(pb + 0); \
        if (TP_PHASE == 0 && (l) == 0) { PB(); phase_inproj(F, (l)); XBAR(); } \
        if (TP_PHASE == 30 && (l) == 0) { PB(); phase_inproj_probe(F, (l)); XBAR(); } \
        if (TP_PHASE == 31 && (l) == 0) { PB(); phase_inproj_mode<1>(F, (l)); XBAR(); PB(); phase_inproj(F, (l)); XBAR(); } \
        if (TP_PHASE == 32 && (l) == 0) { PB(); phase_inproj_mode<2>(F, (l)); XBAR(); PB(); phase_inproj(F, (l)); XBAR(); } \
        if (TP_PHASE >= 11 && TP_PHASE <= 13 && (l) == 0) { PB(); phase_attention<((TP_PHASE >= 11 && TP_PHASE <= 13) ? (1 << ((TP_PHASE >= 11 ? TP_PHASE : 11) - 11)) : 7), TP_DSAP>(F, (l)); XBAR(); PB(); phase_inproj(F, (l)); XBAR(); } \
        if (IN(pb + 1)) { PB(); phase_attention(F, (l)); } SEAM(pb + 1); \
        if (TP_PHASE == 1 && (l) == 0) { PB(); phase_inproj(F, (l)); XBAR(); PB(); phase_attention(F, (l)); XBAR(); } \
        if (IN(pb + 2)) { PB(); phase_branch(F, (l)); } SEAM(pb + 2); \
        if (TP_PHASE == 2 && (l) == 0) { PB(); phase_branch(F, (l)); XBAR(); } \
        if (IN(pb + 3)) { PB(); phase_wo(F, (l)); } SEAM(pb + 3); \
        if (TP_PHASE == 3 && (l) == 0) { PB(); phase_wo(F, (l)); XBAR(); } \
        if (IN(pb + 4)) { PB(); phase_ln1_route(F, (l)); } SEAM(pb + 4); \
        if (IN(pb + 5)) { PB(); phase_moe_up(F, (l)); } SEAM(pb + 5); \
        if (TP_PHASE == 5 && (l) == 0) { PB(); phase_moe_up(F, (l)); XBAR(); } \
        if (IN(pb + 6)) { PB(); phase_moe_down(F, (l)); } SEAM(pb + 6); \
        if (TP_PHASE == 6 && (l) == 0) { PB(); phase_moe_down(F, (l)); XBAR(); } \
        if (IN(pb + 7)) { PB(); phase_ln2(F, (l)); } SEAM(pb + 7); \
    } while (0)
    LAYER(0);
    LAYER(1);
#undef LAYER
#undef IN
#undef SEAM
}

extern "C" void kernel_launch(void* const* d_in, const int* in_sizes, int n_in, void* d_out, int out_size, void* d_ws, size_t ws_size, hipStream_t stream) {
    static int grid = 0;
    if (grid == 0) {
        if (n_in != 16 || out_size != T * D || ws_size < WS_END) { fprintf(stderr, "kernel_launch: unexpected shapes (n_in %d out %d ws %zu)\n", n_in, out_size, ws_size); grid = -1; return; }
        int dev = 0, cus = 0, per_cu = 0;
        if (hipGetDevice(&dev) != hipSuccess || hipDeviceGetAttribute(&cus, hipDeviceAttributeMultiprocessorCount, dev) != hipSuccess) { grid = -1; return; }
        if (hipFuncSetAttribute((const void*)fwd_kernel, hipFuncAttributeMaxDynamicSharedMemorySize, LDS_BYTES) != hipSuccess) { fprintf(stderr, "kernel_launch: hipFuncSetAttribute failed\n"); grid = -1; return; }
        if (hipOccupancyMaxActiveBlocksPerMultiprocessor(&per_cu, (const void*)fwd_kernel, NTHR, LDS_BYTES) != hipSuccess || per_cu < 1) { fprintf(stderr, "kernel_launch: occupancy query says %d\n", per_cu); }
        (void)hipGetLastError();
        grid = cus;
    }
    if (grid < 0) return;
    (void)hipMemsetAsync((char*)d_ws + WS_CTL, 0, CTL_ZERO_BYTES, stream);
    Args a{};
    for (int i = 0; i < 16; ++i) a.in[i] = (const float*)d_in[i];
    a.out = (float*)d_out; a.ws = (unsigned char*)d_ws; a.ph_lo = 0; a.ph_hi = 1000;
    hipLaunchKernelGGL(fwd_kernel, dim3(grid), dim3(NTHR), LDS_BYTES, stream, a);
}
```

```cpp
#include <hip/hip_runtime.h>
#include <cstdio>
#include <cstdint>

#define GAS __attribute__((address_space(1)))
#define LAS __attribute__((address_space(3)))
typedef unsigned short bf16;
typedef unsigned short u16;
typedef unsigned v4u __attribute__((ext_vector_type(4)));
typedef unsigned v2u __attribute__((ext_vector_type(2)));
typedef float f32x4 __attribute__((ext_vector_type(4)));
typedef float f32x2 __attribute__((ext_vector_type(2)));
typedef float f32x16 __attribute__((ext_vector_type(16)));
typedef short bf16x8 __attribute__((ext_vector_type(8)));
typedef _Float16 f16x8 __attribute__((ext_vector_type(8)));
typedef _Float16 f16x2 __attribute__((ext_vector_type(2)));
typedef short s16x4 __attribute__((ext_vector_type(4)));
typedef GAS unsigned gu32;
#define RLX_AGENT __ATOMIC_RELAXED, __HIP_MEMORY_SCOPE_AGENT
#define LDS_WAIT() asm volatile("s_waitcnt lgkmcnt(0)" ::: "memory")
#define VM_WAIT() asm volatile("s_waitcnt vmcnt(0)" ::: "memory")

constexpr int T = 32768, SEQ = 8192, NB = 4, D = 1024, DEPTH = 2;
constexpr int N_IN = 5316, N_INP = 5376;
constexpr int C_AQ = 0, C_AC = 256, C_IQ = 384, C_IK = 640, C_IW = 704, C_BQ = 708, C_BK = 964, C_BV = 1220, C_CQ = 1476, C_CK = 1988, C_CV = 2116, C_G = 2244;
constexpr int NEXP = 16, DE = 512, NPAIR = 24;
constexpr float LN_EPS = 1e-5f;
constexpr float DN_ALPHA = 1.41421356237309515f;
constexpr float LOG2E = 1.4426950408889634f;
constexpr float SM_C = 0.125f * LOG2E;
constexpr int NWAVES = 8, NTHR = 512;

constexpr size_t MiB = 1u << 20;
constexpr size_t WS_CTL = 0, CTL_ZERO_BYTES = 1 * MiB;
constexpr size_t WS_ROPE = 1 * MiB;
constexpr size_t WS_WIN = 3 * MiB;
constexpr size_t WS_WBR = 24 * MiB;
constexpr size_t WS_WO = 28 * MiB;
constexpr size_t WS_XB = 32 * MiB;
constexpr size_t WS_ATT = 96 * MiB;
constexpr size_t WS_AQ = WS_ATT, WS_BQ = WS_AQ + 16 * MiB, WS_CQ = WS_BQ + 16 * MiB;
constexpr size_t WS_IQ = WS_CQ + 32 * MiB;
constexpr size_t WS_KAVA = WS_IQ + 16 * MiB;
constexpr size_t WS_IK = WS_KAVA + 8 * MiB;
constexpr size_t WS_BK = WS_IK + 4 * MiB, WS_BV = WS_BK + 16 * MiB;
constexpr size_t WS_CKV = WS_BV + 16 * MiB;
constexpr size_t WS_MERGED = WS_IQ;
constexpr size_t WS_H = WS_ATT;
constexpr size_t WS_GATES = 236 * MiB;
constexpr size_t WS_Y = WS_GATES;
constexpr size_t WS_MISC = 428 * MiB;
constexpr size_t WS_IW = WS_MISC;
constexpr size_t WS_KMP = WS_MISC + 1 * MiB;
constexpr size_t WS_LIST = WS_MISC + 2 * MiB;
constexpr size_t WS_CW = WS_MISC + 5 * MiB;
constexpr size_t WS_WF = WS_MISC + 11 * MiB;
constexpr size_t WS_WGU = 440 * MiB;
constexpr size_t WS_WD = 472 * MiB;
constexpr size_t WS_END = 488 * MiB;
static_assert(WS_CKV + 16 * MiB == WS_GATES && WS_MERGED + 64 * MiB <= WS_CKV + 16 * MiB && WS_CW + 6 * MiB <= WS_WGU, "ws map");
constexpr int CW_TMO = 0;
constexpr int CW_BAR = 4096;
constexpr int CW_CNT = 16384;

constexpr int RING_BYTES = 131072;
constexpr int LDS_MISC_OFF = 155648 - 512;
constexpr int LDS_BYTES = 155648;

__device__ __forceinline__ unsigned f2bf(float f) { unsigned u = __builtin_bit_cast(unsigned, f); return (u + 0x7fffu + ((u >> 16) & 1u)) >> 16; }
__device__ __forceinline__ unsigned pk2(float lo, float hi) { return f2bf(lo) | (f2bf(hi) << 16); }
typedef __bf16 bf16x2_t __attribute__((ext_vector_type(2)));
__device__ __forceinline__ unsigned cvt_pk_bf16(float lo, float hi) { f32x2 v = {lo, hi}; bf16x2_t b = __builtin_convertvector(v, bf16x2_t); return __builtin_bit_cast(unsigned, b); }
__device__ __forceinline__ unsigned pk2h(float lo, float hi) { f16x2 v; v.x = (_Float16)lo; v.y = (_Float16)hi; return __builtin_bit_cast(unsigned, v); }
__device__ __forceinline__ float bf2f(unsigned short b) { return __builtin_bit_cast(float, (unsigned)b << 16); }
__device__ __forceinline__ float bflo(unsigned w) { return __builtin_bit_cast(float, w << 16); }
__device__ __forceinline__ float bfhi(unsigned w) { return __builtin_bit_cast(float, w & 0xffff0000u); }
template <int M> __device__ __forceinline__ float xor_f(float v) { return __builtin_bit_cast(float, __builtin_amdgcn_ds_swizzle(__builtin_bit_cast(int, v), (M << 10) | 0x1f)); }
template <int M> __device__ __forceinline__ unsigned xor_u(unsigned v) { return (unsigned)__builtin_amdgcn_ds_swizzle((int)v, (M << 10) | 0x1f); }
__device__ __forceinline__ void half_swap(unsigned& a, unsigned& b) { asm volatile("v_nop\n\tv_nop\n\tv_permlane32_swap_b32 %0, %1\n\tv_nop" : "+v"(a), "+v"(b)); }
__device__ __forceinline__ float half_sum(float v) { unsigned a = __builtin_bit_cast(unsigned, v), b = a; half_swap(a, b); return __builtin_bit_cast(float, a) + __builtin_bit_cast(float, b); }
__device__ __forceinline__ float half_max(float v) { unsigned a = __builtin_bit_cast(unsigned, v), b = a; half_swap(a, b); return fmaxf(__builtin_bit_cast(float, a), __builtin_bit_cast(float, b)); }
template <int CTRL> __device__ __forceinline__ float dpp_f(float v) { return __builtin_bit_cast(float, __builtin_amdgcn_update_dpp(0, __builtin_bit_cast(int, v), CTRL, 0xf, 0xf, false)); }
__device__ __forceinline__ float row_sum(float v) { v += dpp_f<0xB1>(v); v += dpp_f<0x4E>(v); v += dpp_f<0x141>(v); v += dpp_f<0x140>(v); return v; }
__device__ __forceinline__ float row_max(float v) { v = fmaxf(v, dpp_f<0xB1>(v)); v = fmaxf(v, dpp_f<0x4E>(v)); v = fmaxf(v, dpp_f<0x141>(v)); v = fmaxf(v, dpp_f<0x140>(v)); return v; }
__device__ __forceinline__ float wave_sum(float v) { v = row_sum(v); v += xor_f<16>(v); return half_sum(v); }
__device__ __forceinline__ float wave_max(float v) { v = row_max(v); v = fmaxf(v, xor_f<16>(v)); return half_max(v); }
__device__ __forceinline__ long ik_off(int key, int piece) { return ((long)(key >> 5) * 8 + piece) * 256 + (key & 31) * 8; }
__device__ __forceinline__ long bk_off(int h, long row, int piece) { return (((long)h * (T / 32) + (row >> 5)) * 8 + piece) * 256 + (row & 31) * 8; }
__device__ __forceinline__ int lane_id() { int r; asm volatile("v_mbcnt_lo_u32_b32 %0, -1, 0\n\tv_mbcnt_hi_u32_b32 %0, -1, %0" : "=v"(r)); return r; }
__device__ __forceinline__ float sigmoidf_(float x) { return __builtin_amdgcn_rcpf(1.0f + __builtin_amdgcn_exp2f(-LOG2E * x)); }

namespace pg8 {
constexpr int BM = 256, BK = 64, HALF = 128, HTB = HALF * BK * 2, STAGE_BYTES = 8 * HTB;
__host__ __device__ __forceinline__ int lds_byte(int r, int c) { const int st = (r >> 4) * 2 + (c >> 5), rr = r & 15, cc = c & 31, ob = rr * 64 + cc * 2; return st * 1024 + (ob ^ (((ob >> 9) & 1) << 5)); }
__host__ __device__ __forceinline__ void stage_rc(int b, int& R, int& C) { const int st = b / 1024, sb = b % 1024, swz = sb ^ (((sb >> 9) & 1) << 5); R = (st >> 1) * 16 + swz / 64; C = (st & 1) * 32 + (swz % 64) / 2; }
__host__ __device__ __forceinline__ int perm32(int rho) { const int n = rho >> 4, i = rho & 15; return 8 * (i >> 2) + 4 * n + (i & 3); }

struct Unit { const char* A; const char* B; const int* rowlist; int nvalid; int lda; int nt; int ksplit; long bdelta; int p0, p1, p2, p3; int half, chalf; };

template <class Epi, class Sched, bool ALIGN_EPI>
__device__ __forceinline__ void gemm_phase(LAS unsigned char* lds, int tid, int ldb, const Sched& S, const Epi& E) {
    const int wid = __builtin_amdgcn_readfirstlane(tid >> 6), lane = tid & 63, wr = wid >> 2, wc = wid & 3, fr = lane & 15, fq = lane >> 4;
    int R0, C0; stage_rc(tid * 16, R0, C0);
    const int Rb0 = Epi::PERM ? ((R0 & ~31) + perm32(R0 & 31)) : R0;
    unsigned voffB[2];
    voffB[0] = (unsigned)(Rb0 * ldb + C0) * 2u; voffB[1] = (unsigned)((Rb0 + 64) * ldb + C0) * 2u;
    const size_t kstep = (size_t)(BK * 2);
    const size_t hstepB = (size_t)HALF * ldb * 2;
    const unsigned ldsw = (unsigned)wid * 1024u;
    const int aoff = lds_byte(wr * 64 + fr, fq * 8), boff = lds_byte(wc * 32 + fr, fq * 8);
#define PG8_SA(b, h) (((b) * 2 + (h)) * HTB)
#define PG8_SB(b, h) ((4 + (b) * 2 + (h)) * HTB)
#define PG8_STAGEB(bufoff, gbase) do { _Pragma("unroll") for (int _i = 0; _i < 2; ++_i) \
        __builtin_amdgcn_global_load_lds((const unsigned*)((const char*)(gbase) + voffB[_i]), (LAS unsigned*)(lds + (bufoff) + ldsw + _i * 8192), 16, 0, 0); } while (0)
#define PG8_STAGEA(bufoff, gbase, vo, h) do { \
        __builtin_amdgcn_global_load_lds((const unsigned*)((const char*)(gbase) + vo##h##0), (LAS unsigned*)(lds + (bufoff) + ldsw), 16, 0, 0); \
        __builtin_amdgcn_global_load_lds((const unsigned*)((const char*)(gbase) + vo##h##1), (LAS unsigned*)(lds + (bufoff) + ldsw + 8192), 16, 0, 0); } while (0)
#define PG8_LDA(dst, b, h) do { _Pragma("unroll") for (int m = 0; m < 4; ++m) _Pragma("unroll") for (int k = 0; k < 2; ++k) dst[m][k] = *(const LAS bf16x8*)(lds + PG8_SA(b, h) + aoff + m * 2048 + k * 1024); } while (0)
#define PG8_LDB(dst, b, h) do { _Pragma("unroll") for (int n = 0; n < 2; ++n) _Pragma("unroll") for (int k = 0; k < 2; ++k) dst[n][k] = *(const LAS bf16x8*)(lds + PG8_SB(b, h) + boff + n * 2048 + k * 1024); } while (0)
#define PG8_MMA(ai, bj, At, Bt) do { __builtin_amdgcn_s_setprio(1); _Pragma("unroll") for (int m = 0; m < 4; ++m) _Pragma("unroll") for (int n = 0; n < 2; ++n) _Pragma("unroll") for (int k = 0; k < 2; ++k) \
        acc[ai][bj][m][n] = __builtin_amdgcn_mfma_f32_16x16x32_bf16(Bt[n][k], At[m][k], acc[ai][bj][m][n], 0, 0, 0); __builtin_amdgcn_s_setprio(0); } while (0)
#define PG8_WAIT_V(n) asm volatile("s_waitcnt vmcnt(" #n ")" ::: "memory")
#define PG8_WAIT_L(n) asm volatile("s_waitcnt lgkmcnt(" #n ")" ::: "memory")
#define PG8_BAR __builtin_amdgcn_s_barrier()
#define PG8_SCHED __builtin_amdgcn_sched_barrier(0)
#define PG8_BK(u, tt) ((u).B + (size_t)(tt) * kstep + (((tt) >= (u).ksplit) ? (u).bdelta : 0))
#define PG8_VOFF1(u, dst, rr) do { const int _r = (rr) + R0; int _g = _r; if ((u).rowlist) { _g = (u).rowlist[(_r < (u).nvalid) ? _r : 0]; } dst = (unsigned)(_g * (u).lda + C0) * 2u; } while (0)
#define PG8_VOFFA(u, vo) do { PG8_VOFF1(u, vo##00, 0); PG8_VOFF1(u, vo##01, 64); PG8_VOFF1(u, vo##10, 128); PG8_VOFF1(u, vo##11, 192); } while (0)
    Unit cur, nxt; int ui = 0;
    if (!S.next(0, cur)) return;
    f32x4 acc[2][2][4][2];
#pragma unroll
    for (int a = 0; a < 2; ++a)
#pragma unroll
        for (int b = 0; b < 2; ++b)
#pragma unroll
            for (int m = 0; m < 4; ++m)
#pragma unroll
                for (int n = 0; n < 2; ++n) acc[a][b][m][n] = (f32x4){0.f, 0.f, 0.f, 0.f};
    bf16x8 At[4][2], B0[2][2], B1[2][2];
    unsigned cvo00, cvo01, cvo10, cvo11;
    LAS v4u* park = (LAS v4u*)(lds + STAGE_BYTES) + tid;
    PG8_VOFFA(cur, cvo);
    {
        const char* cA = cur.A; const char* b0 = PG8_BK(cur, 0); const char* b1 = PG8_BK(cur, 1);
        PG8_STAGEB(PG8_SB(0, 0), b0); PG8_STAGEB(PG8_SB(0, 1), b0 + hstepB); PG8_STAGEA(PG8_SA(0, 0), cA, cvo, 0); PG8_STAGEA(PG8_SA(0, 1), cA, cvo, 1);
        if (wr == 1) PG8_BAR;
        PG8_WAIT_V(2); PG8_BAR;
        PG8_STAGEB(PG8_SB(1, 0), b1); PG8_STAGEA(PG8_SA(1, 0), cA + kstep, cvo, 0); PG8_STAGEB(PG8_SB(1, 1), b1 + hstepB);
        PG8_WAIT_V(6); PG8_BAR;
    }
    for (;;) {
        const bool has_next = S.next(ui + 1, nxt);
        if (!has_next) nxt = cur;
        { unsigned nvo00, nvo01, nvo10, nvo11; PG8_VOFFA(nxt, nvo); *park = (v4u){nvo00, nvo01, nvo10, nvo11}; }
        const int nt = cur.nt;
        const char* cA = cur.A;
        const bool full = !Sched::HALF_UNITS || (cur.half == 0);
        for (int t = 0; t < nt; t += 2) {
            const bool last = (t == nt - 2);
            const char* a1 = cA + (size_t)(t + 1) * kstep;
            const char* a2 = last ? nxt.A : cA + (size_t)(t + 2) * kstep;
            const char* a3 = a2 + kstep;
            const char* b2 = last ? PG8_BK(nxt, 0) : PG8_BK(cur, t + 2);
            const char* b3 = last ? PG8_BK(nxt, 1) : PG8_BK(cur, t + 3);
            unsigned vo200 = cvo00, vo201 = cvo01, vo210 = cvo10, vo211 = cvo11;
            if (last) { const v4u nv = *park; vo200 = nv.x; vo201 = nv.y; vo210 = nv.z; vo211 = nv.w; }
            PG8_LDB(B0, 0, 0); PG8_LDB(B1, 0, 1); PG8_SCHED; PG8_LDA(At, 0, 0); PG8_STAGEA(PG8_SA(1, 1), a1, cvo, 1);
            PG8_WAIT_V(8); PG8_WAIT_L(0); PG8_BAR; PG8_MMA(0, 0, At, B0); if (full) PG8_MMA(0, 1, At, B1); PG8_BAR; PG8_SCHED;
            PG8_LDA(At, 0, 1); PG8_STAGEB(PG8_SB(0, 0), b2); PG8_STAGEB(PG8_SB(0, 1), b2 + hstepB); PG8_STAGEA(PG8_SA(0, 0), a2, vo2, 0);
            PG8_WAIT_V(8); PG8_WAIT_L(0); PG8_BAR; PG8_MMA(1, 0, At, B0); if (full) PG8_MMA(1, 1, At, B1); PG8_BAR; PG8_SCHED;
            PG8_LDB(B0, 1, 0); PG8_LDB(B1, 1, 1); PG8_SCHED; PG8_LDA(At, 1, 0); PG8_STAGEA(PG8_SA(0, 1), a2, vo2, 1);
            PG8_WAIT_V(8); PG8_WAIT_L(0); PG8_BAR; PG8_MMA(0, 0, At, B0); if (full) PG8_MMA(0, 1, At, B1); PG8_BAR; PG8_SCHED;
            PG8_LDA(At, 1, 1); PG8_STAGEB(PG8_SB(1, 0), b3); PG8_STAGEB(PG8_SB(1, 1), b3 + hstepB); PG8_STAGEA(PG8_SA(1, 0), a3, vo2, 0);
            PG8_WAIT_V(8); PG8_WAIT_L(0); PG8_BAR; PG8_MMA(1, 0, At, B0); if (full) PG8_MMA(1, 1, At, B1); PG8_BAR; PG8_SCHED;
        }
        if constexpr (ALIGN_EPI) { if (wr == 0) PG8_BAR; }
        E(acc, cur, wr, wc, fr, fq);
        if (!has_next) break;
        if (!Epi::keep_acc(cur))
#pragma unroll
        for (int a = 0; a < 2; ++a)
#pragma unroll
            for (int b = 0; b < 2; ++b)
#pragma unroll
                for (int m = 0; m < 4; ++m)
#pragma unroll
                    for (int n = 0; n < 2; ++n) acc[a][b][m][n] = (f32x4){0.f, 0.f, 0.f, 0.f};
        cur = nxt; ++ui;
        { const v4u nv = *park; cvo00 = nv.x; cvo01 = nv.y; cvo10 = nv.z; cvo11 = nv.w; }
        if constexpr (ALIGN_EPI) { if (wr == 1) PG8_BAR; }
    }
    PG8_WAIT_V(0);
    if constexpr (!ALIGN_EPI) { if (wr == 0) PG8_BAR; }
    PG8_BAR;
#undef PG8_SA
#undef PG8_SB
#undef PG8_STAGEA
#undef PG8_STAGEB
#undef PG8_LDA
#undef PG8_LDB
#undef PG8_MMA
#undef PG8_WAIT_V
#undef PG8_WAIT_L
#undef PG8_BAR
#undef PG8_SCHED
#undef PG8_BK
#undef PG8_VOFFA
}
}

#define XB_TMO      128
#define XB_XCNT(j)  (256  + 64 * (j))
#define XB_XSUB(j)  (1280 + 64 * (j))
#define XB_XGEN(j)  (2304 + 64 * (j))
#define XB_TOP      3328
#define XB_TOPGEN   3392
#define XCD_BAR_WORDS 3456
#define XB_SPIN_CAP (1u << 20)
__device__ __forceinline__ unsigned xb_ld(gu32* p)              { return __hip_atomic_load(p, __ATOMIC_RELAXED, __HIP_MEMORY_SCOPE_AGENT); }
__device__ __forceinline__ unsigned xb_add(gu32* p, unsigned v) { return __hip_atomic_fetch_add(p, v, __ATOMIC_RELAXED, __HIP_MEMORY_SCOPE_AGENT); }
__device__ __forceinline__ unsigned xb_xcc_id() { return (unsigned)__builtin_amdgcn_s_getreg((3 << 11) | 20) & 0xFu; }
#define XB_SPIN(cond, bar) do { unsigned _sp = 0; while (cond) { __builtin_amdgcn_s_sleep(1); \
    if ((++_sp & 255u) == 0u) { if (xb_ld(&(bar)[XB_TMO])) break; if (_sp > XB_SPIN_CAP) { (void)xb_add(&(bar)[XB_TMO], 1u); break; } } } } while (0)
struct XcdBarrier { gu32* bar; unsigned x; volatile LAS unsigned* st; };
__device__ __forceinline__ XcdBarrier xcd_barrier_post(gu32* bar, volatile LAS unsigned* st, bool leader) {
    XcdBarrier b; b.bar = bar; b.x = xb_xcc_id(); b.st = st;
    if (leader) (void)xb_add(&bar[XB_XCNT(b.x)], 1u);
    return b;
}
__device__ __forceinline__ void xcd_barrier_complete(gu32* bar, unsigned x, unsigned& nloc, unsigned& nx) {
    const unsigned G = gridDim.x * gridDim.y * gridDim.z;
    unsigned sum, cnt, mine, sp = 0u;
    for (;;) {
        sum = 0u; cnt = 0u; mine = 0u;
#pragma unroll
        for (unsigned j = 0; j < 16; ++j) { const unsigned c = xb_ld(&bar[XB_XCNT(j)]); sum += c; cnt += (c > 0u) ? 1u : 0u; mine = (j == x) ? c : mine; }
        if (sum == G) break;
        __builtin_amdgcn_s_sleep(1);
        if ((++sp & 255u) == 0u) { if (xb_ld(&bar[XB_TMO])) break; if (sp > XB_SPIN_CAP) { (void)xb_add(&bar[XB_TMO], 1u); break; } }
    }
    nloc = mine > 0u ? mine : 1u; nx = cnt > 0u ? cnt : 1u;
}
__device__ __forceinline__ void xcd_barrier(const XcdBarrier& b, bool leader) {
    asm volatile("s_waitcnt vmcnt(0)" ::: "memory");
    __syncthreads();
    if (leader) {
        gu32* bar = b.bar; asm volatile("" : "+s"(bar));
        __builtin_amdgcn_s_waitcnt(0);
        unsigned nloc = b.st[0], nx = b.st[1];
        if (nloc == 0u) { xcd_barrier_complete(bar, b.x, nloc, nx); b.st[0] = nloc; b.st[1] = nx; }
        const unsigned old = xb_add(&bar[XB_XSUB(b.x)], 1u);
        const unsigned gen = old / nloc;
        if (old + 1u == (gen + 1u) * nloc) {
            __builtin_amdgcn_fence(__ATOMIC_RELEASE, "agent");
            asm volatile("s_waitcnt vmcnt(0)" ::: "memory");
            const unsigned og = xb_add(&bar[XB_TOP], 1u);
            const unsigned tg = og / nx;
            if (og + 1u == (tg + 1u) * nx) xb_add(&bar[XB_TOPGEN], 1u);
            else XB_SPIN(xb_ld(&bar[XB_TOPGEN]) == tg, bar);
            __builtin_amdgcn_fence(__ATOMIC_ACQUIRE, "agent");
            xb_add(&bar[XB_XGEN(b.x)], 1u);
            asm volatile("s_waitcnt vmcnt(0)" ::: "memory");
        } else {
            XB_SPIN(xb_ld(&bar[XB_XGEN(b.x)]) == gen, bar);
            __builtin_amdgcn_fence(__ATOMIC_ACQUIRE, "agent");
            asm volatile("s_waitcnt vmcnt(0)" ::: "memory");
        }
    }
    __syncthreads();
}

struct Args { const float* in[16]; float* out; unsigned char* ws; int ph_lo, ph_hi; };
enum { I_X = 0, I_WIN, I_UK, I_UV, I_SINK, I_WBR, I_WO, I_LN1G, I_LN1B, I_RW, I_RB, I_MG, I_MU, I_MD, I_LN2G, I_LN2B };

typedef GAS unsigned char gbyte;
struct Frame {
    LAS unsigned char* lds;
    gbyte* wsg;
    GAS const float* ing[16];
    GAS float* outg;
    int tid, lane, wave, vcu, G;
};
#define F_WS ((unsigned char*)F.wsg)
#define F_IN(i) ((const float*)F.ing[i])
#define F_OUT ((float*)F.outg)

template <class F>
__device__ __forceinline__ void transpose_item(bf16* WT, int ldk, int row0, int k0, LAS float* scr, int lane, const F& val) {
    float tv[32];
#pragma unroll
    for (int i = 0; i < 32; ++i) tv[i] = val(k0 + 2 * i + (lane >> 5), row0 + (lane & 31));
#pragma unroll
    for (int i = 0; i < 32; ++i) scr[(2 * i + (lane >> 5)) * 33 + (lane & 31)] = tv[i];
    LDS_WAIT(); asm volatile("" ::: "memory");
    const int c = lane & 7;
#pragma unroll
    for (int j = 0; j < 4; ++j) { const int n = (lane >> 3) + 8 * j; const LAS float* s = scr + (8 * c) * 33 + n;
        v4u o; o.x = pk2(s[0 * 33], s[1 * 33]); o.y = pk2(s[2 * 33], s[3 * 33]); o.z = pk2(s[4 * 33], s[5 * 33]); o.w = pk2(s[6 * 33], s[7 * 33]);
        *(GAS v4u*)(WT + (size_t)(row0 + n) * ldk + k0 + 8 * c) = o; }
    LDS_WAIT(); asm volatile("" ::: "memory");
}
__device__ __forceinline__ int rope_dim(int p) { return (p >> 1) + 32 * (p & 1); }

__device__ __forceinline__ int win_src(int s) {
    const int tile = s >> 8, u = s & 255;
    switch (tile) {
        case 0: return C_AQ + (u & ~63) + rope_dim(u & 63);
        case 1: return C_IQ + (u & ~63) + rope_dim(u & 63);
        case 2: if (u < 64) return -2 - rope_dim(u); if (u < 128) return -100 - (u - 64); if (u < 192) return C_IK + rope_dim(u - 128); if (u < 196) return C_IW + (u - 192); return -1;
        case 3: return C_BQ + (u & ~63) + rope_dim(u & 63);
        case 4: return C_BK + (u & ~63) + rope_dim(u & 63);
        case 5: return C_BV + u;
        case 6: return C_CQ + (u & ~63) + rope_dim(u & 63);
        case 7: return C_CQ + 256 + (u & ~63) + rope_dim(u & 63);
        case 8: if (u < 128) return C_CK + (u & ~63) + rope_dim(u & 63); return C_CV + (u - 128);
        default: return C_G + (s - 2304);
    }
}

__device__ __forceinline__ void phase_prologue_a(Frame& F) {
    const int gw = F.vcu * NWAVES + F.wave, NGW = F.G * NWAVES;
    {
        float* WFp = (float*)(F_WS + WS_WF);
        for (int i = gw * 64 + F.lane; i < DEPTH * 1024 * 128; i += NGW * 64) {
            const int l = i >> 17, k = (i >> 7) & 1023, c = i & 127;
            const float* W = F_IN(I_WIN) + (size_t)l * D * N_IN + (size_t)k * N_IN + C_AC;
            const float* U = (c < 64 ? F_IN(I_UK) : F_IN(I_UV)) + (size_t)l * 128 * 64 + (c & 63);
            float a = 0.f;
#pragma unroll 32
            for (int r = 0; r < 128; ++r) a = fmaf(W[r], U[r * 64], a);
            WFp[i] = a;
        }
    }
    {
        float* COS = (float*)(F_WS + WS_ROPE); float* SIN = COS + SEQ * 32;
        const float inv = 1.0f / (float)pow(10000.0, (double)(2 * (F.lane & 31)) / 64.0);
        for (int i = gw * 64 + F.lane; i < SEQ * 32; i += NGW * 64) {
            const int pos = i >> 5;
            const float ang = (float)pos * inv;
            COS[i] = (float)cos((double)ang); SIN[i] = (float)sin((double)ang);
        }
    }
    {
        const f32x4* x4 = (const f32x4*)F_IN(I_X); v2u* xb = (v2u*)(F_WS + WS_XB);
        const size_t n4 = (size_t)T * D / 4, st = (size_t)NGW * 64; size_t i = (size_t)gw * 64 + F.lane;
        for (; i + 7 * st < n4; i += 8 * st) {
            f32x4 v[8];
#pragma unroll
            for (int u = 0; u < 8; ++u) v[u] = x4[i + u * st];
#pragma unroll
            for (int u = 0; u < 8; ++u) { v2u o; o.x = pk2(v[u].x, v[u].y); o.y = pk2(v[u].z, v[u].w); xb[i + u * st] = o; }
        }
        for (; i < n4; i += st) { const f32x4 v = x4[i]; v2u o; o.x = pk2(v.x, v.y); o.y = pk2(v.z, v.w); xb[i] = o; }
    }
}
__device__ __forceinline__ void phase_prologue(Frame& F) {
    LAS float* scr = (LAS float*)(F.lds + F.wave * 16384);
    const int gw = F.vcu * NWAVES + F.wave, NGW = F.G * NWAVES;
    constexpr int I_WINL = (N_INP / 32) * (D / 64);
    constexpr int I_BRL = (1024 / 32) * (1024 / 64);
    constexpr int I_WOL = (1024 / 32) * (1024 / 64);
    constexpr int NITEMS = DEPTH * (I_WINL + I_BRL + I_WOL);
    for (int it = gw; it < NITEMS; it += NGW) {
        int r = it; const int l = r / (I_WINL + I_BRL + I_WOL); r -= l * (I_WINL + I_BRL + I_WOL);
        if (r < I_WINL) {
            const float* W = F_IN(I_WIN) + (size_t)l * D * N_IN; const float* WFp = (const float*)(F_WS + WS_WF);
            bf16* WT = (bf16*)(F_WS + WS_WIN) + (size_t)l * N_INP * D;
            const int rg = r / 16, kc = r % 16;
            const int c = win_src(rg * 32 + (F.lane & 31));
            const int cc = (c > -100) ? (-2 - c) : (64 + (-100 - c));
            const float* sb = (c >= 0) ? (W + c) : (WFp + (size_t)l * 1024 * 128 + (c == -1 ? 0 : cc));
            const long sst = (c >= 0) ? (long)N_IN : 128L; const float sm = (c == -1) ? 0.f : 1.f;
            transpose_item(WT, D, rg * 32, kc * 64, scr, F.lane, [&](int k, int row) -> float { return sb[(size_t)k * sst] * sm; });
            continue; }
        r -= I_WINL;
        if (r < I_BRL) {
            const float* W = F_IN(I_WBR) + (size_t)l * 1024 * 1024; bf16* WT = (bf16*)(F_WS + WS_WBR) + (size_t)l * 1024 * 1024;
            const int rg = r / 16, kc = r % 16;
            transpose_item(WT, 1024, rg * 32, kc * 64, scr, F.lane, [&](int k, int row) -> float { return W[(size_t)k * 1024 + row]; });
            continue; }
        r -= I_BRL;
        {
            const float* W = F_IN(I_WO) + (size_t)l * 1024 * 1024; bf16* WT = (bf16*)(F_WS + WS_WO) + (size_t)l * 1024 * 1024;
            const int rg = r / 16, kc = r % 16;
            transpose_item(WT, 1024, rg * 32, kc * 64, scr, F.lane, [&](int k, int row) -> float { return W[(size_t)k * 1024 + row]; });
        }
    }
}

constexpr int MOE_CVT_ITEMS = NEXP * (1024 / 32) * (1024 / 64) + NEXP * (1024 / 32) * (512 / 64);
__device__ __forceinline__ void convert_moe_item(Frame& F, int l, int it, LAS float* scr) {
    constexpr int I_GU = NEXP * (1024 / 32) * (1024 / 64);
    const float* WG = F_IN(I_MG) + (size_t)l * NEXP * D * DE; const float* WU = F_IN(I_MU) + (size_t)l * NEXP * D * DE; const float* WD = F_IN(I_MD) + (size_t)l * NEXP * DE * D;
    if (it < I_GU) {
        const int e = it / 512, r = it % 512, rg = r / 16, kc = r % 16;
        bf16* WT = (bf16*)(F_WS + WS_WGU) + (size_t)e * 1024 * 1024;
        const float* g = WG + (size_t)e * D * DE; const float* u = WU + (size_t)e * D * DE;
        transpose_item(WT, 1024, rg * 32, kc * 64, scr, F.lane, [&](int k, int row) -> float { const int j = 4 * (row >> 3) + (row & 3); return (row & 4) ? u[(size_t)k * DE + j] : g[(size_t)k * DE + j]; });
    } else {
        const int r0 = it - I_GU, e = r0 / 256, r = r0 % 256, rg = r / 8, kc = r % 8;
        bf16* WT = (bf16*)(F_WS + WS_WD) + (size_t)e * DE;
        const float* w = WD + (size_t)e * DE * D;
        transpose_item(WT, NEXP * DE, rg * 32, kc * 64, scr, F.lane, [&](int k, int row) -> float { return w[(size_t)k * D + row]; });
    }
}
__device__ __forceinline__ void convert_moe_weights(Frame& F, int l) {
    LAS float* scr = (LAS float*)(F.lds + F.wave * 16384);
    const int gw = F.vcu * NWAVES + F.wave, NGW = F.G * NWAVES;
    for (int it = gw; it < MOE_CVT_ITEMS; it += NGW) convert_moe_item(F, l, it, scr);
}

struct SchedDense {
    static constexpr bool HALF_UNITS = false;
    const char* A; const char* B; int lda, lda_b, ldb_b, nN, nt, G, vcu, ntiles;
    __device__ __forceinline__ bool next(int i, pg8::Unit& u) const {
        const int L = i * G + vcu; constexpr int hf = 0, ch = 0; if (L >= ntiles) return false;
        const int per_grp = 8 * nN, grp = L / per_grp, w = L % per_grp, pn = w / 8, pm = grp * 8 + (w % 8);
        u.A = A + (size_t)pm * lda_b; u.B = B + (size_t)pn * ldb_b + (size_t)ch * (ldb_b >> 1); u.rowlist = nullptr; u.nvalid = 256; u.lda = lda; u.nt = nt; u.ksplit = 1 << 30; u.bdelta = 0; u.p0 = pm; u.p1 = pn; u.p2 = 0; u.p3 = 0; u.half = hf; u.chalf = ch; return true;
    }
};

template <int EMODE = 0> struct EpiInProjT {
    static constexpr bool PERM = true;
    static __device__ __forceinline__ bool keep_acc(const pg8::Unit&) { return false; }
    unsigned char* ws;
    __device__ __forceinline__ void operator()(const f32x4 (&acc)[2][2][4][2], const pg8::Unit& u, int wr, int wc, int fr, int fq) const {
        const int pm = u.p0, pn = u.p1;
        const float* COS = (const float*)(ws + WS_ROPE); const float* SIN = COS + SEQ * 32;
        const int row0 = pm * 256 + wr * 64 + fr;
        float ksum[2][8];
#pragma unroll
        for (int bj = 0; bj < 2; ++bj)
#pragma unroll
            for (int e = 0; e < 8; ++e) ksum[bj][e] = 0.f;
        f32x4 rcs[2][4], rsn[2][4];
        if (pn <= 8) {
            const int j0 = ((wc * 32 + 8 * fq) & 63) >> 1;
#pragma unroll
            for (int ai = 0; ai < 2; ++ai)
#pragma unroll
                for (int m = 0; m < 4; ++m) { const int pos = (row0 + ai * 128 + m * 16) & (SEQ - 1); rcs[ai][m] = *(const f32x4*)(COS + pos * 32 + j0); rsn[ai][m] = *(const f32x4*)(SIN + pos * 32 + j0); }
        }
#pragma unroll
        for (int ai = 0; ai < 2; ++ai)
#pragma unroll
            for (int m = 0; m < 4; ++m) {
                const int row = row0 + ai * 128 + m * 16; const int pos = row & (SEQ - 1);
#pragma unroll
                for (int bj = 0; bj < 2; ++bj) {
                    const int cl = bj * 128 + wc * 32 + 8 * fq;
                    float v[8];
#pragma unroll
                    for (int e = 0; e < 4; ++e) { v[e] = acc[ai][bj][m][0][e]; v[4 + e] = acc[ai][bj][m][1][e]; }
                    int kind;
                    unsigned char* obase; int pitch, ocol;
                    if (pn == 0) { kind = 1; obase = ws + WS_AQ; pitch = 256; ocol = cl; }
                    else if (pn == 1) { kind = 2; obase = ws + WS_IQ; pitch = 256; ocol = cl; }
                    else if (pn == 2) {
                        if (cl < 64) { kind = 1; obase = ws + WS_KAVA; pitch = 128; ocol = cl; }
                        else if (cl < 128) { kind = 0; obase = ws + WS_KAVA; pitch = 128; ocol = cl; }
                        else if (cl < 192) { kind = 2; obase = ws + WS_IK; pitch = 64; ocol = cl - 128; }
                        else if (cl == 192) { kind = 4; obase = ws + WS_IW; pitch = 4; ocol = 0; }
                        else { kind = 5; obase = ws; pitch = 0; ocol = 0; }
                    }
                    else if (pn == 3) { kind = 1; obase = ws + WS_BQ; pitch = 256; ocol = cl; }
                    else if (pn == 4) { kind = 1; obase = ws + WS_BK; pitch = 256; ocol = cl; }
                    else if (pn == 5) { kind = 0; obase = ws + WS_BV; pitch = 256; ocol = cl; }
                    else if (pn == 6) { kind = 1; obase = ws + WS_CQ; pitch = 512; ocol = cl; }
                    else if (pn == 7) { kind = 1; obase = ws + WS_CQ; pitch = 512; ocol = 256 + cl; }
                    else if (pn == 8) { kind = (cl < 128) ? 1 : 0; obase = ws + WS_CKV; pitch = 256; ocol = cl; }
                    else { kind = 3; obase = ws + WS_GATES; pitch = 3072; ocol = (pn - 9) * 256 + cl; }
                    if ((kind == 1 || kind == 2) && !(EMODE & 1)) {
                        const f32x4 cs = rcs[ai][m], sn = rsn[ai][m];
#pragma unroll
                        for (int e = 0; e < 4; ++e) { const float t1 = v[2 * e], t2 = v[2 * e + 1]; v[2 * e] = t1 * cs[e] - t2 * sn[e]; v[2 * e + 1] = t2 * cs[e] + t1 * sn[e]; }
                    }
                    if (kind == 3) {
                        unsigned q0 = 0u, q1 = 0u;
#pragma unroll
                        for (int e = 0; e < 4; ++e) {
                            q0 = __builtin_amdgcn_cvt_pk_u8_f32(__builtin_amdgcn_fmed3f(sigmoidf_(v[e]) * 255.0f, 1.0f, 255.0f), e, q0);
                            q1 = __builtin_amdgcn_cvt_pk_u8_f32(__builtin_amdgcn_fmed3f(sigmoidf_(v[4 + e]) * 255.0f, 1.0f, 255.0f), e, q1); }
                        *(v2u*)(obase + (size_t)row * pitch + ocol) = (v2u){q0, q1};
                    }
                    if (pn == 4) {
#pragma unroll
                        for (int e = 0; e < 8; ++e) ksum[bj][e] += v[e];
                    }
                    if (kind == 0 || kind == 1) {
                        v4u w; w.x = cvt_pk_bf16(v[0], v[1]); w.y = cvt_pk_bf16(v[2], v[3]); w.z = cvt_pk_bf16(v[4], v[5]); w.w = cvt_pk_bf16(v[6], v[7]);
                        if (pn == 4) *(v4u*)((bf16*)obase + bk_off(cl >> 6, row, (cl & 63) >> 3)) = w;
                        else *(v4u*)((bf16*)obase + (size_t)row * pitch + ocol) = w;
                    } else if (kind == 2) {
                        v4u w; w.x = pk2h(v[0], v[1]); w.y = pk2h(v[2], v[3]); w.z = pk2h(v[4], v[5]); w.w = pk2h(v[6], v[7]);
                        if (pn == 2) *(v4u*)((u16*)obase + ik_off(row, ocol >> 3)) = w;
                        else *(v4u*)((u16*)obase + (size_t)row * pitch + ocol) = w;
                    } else if (kind == 4) {
                        *(f32x4*)((float*)obase + (size_t)row * 4) = (f32x4){v[0], v[1], v[2], v[3]};
                    }
                }
            }
        if (pn == 4) {
            float* KMP = (float*)(ws + WS_KMP) + (size_t)(pm * 2 + wr) * 256;
#pragma unroll
            for (int bj = 0; bj < 2; ++bj)
#pragma unroll
                for (int e = 0; e < 8; ++e) { float s = ksum[bj][e]; s += xor_f<1>(s); s += xor_f<2>(s); s += xor_f<4>(s); s += xor_f<8>(s); ksum[bj][e] = s; }
            if (fr == 0) {
#pragma unroll
                for (int bj = 0; bj < 2; ++bj) { float* o = KMP + bj * 128 + wc * 32 + 8 * fq;
                    *(f32x4*)o = (f32x4){ksum[bj][0], ksum[bj][1], ksum[bj][2], ksum[bj][3]}; *(f32x4*)(o + 4) = (f32x4){ksum[bj][4], ksum[bj][5], ksum[bj][6], ksum[bj][7]}; }
            }
        }
    }
};

typedef EpiInProjT<0> EpiInProj;
struct EpiNone { static constexpr bool PERM = true; static __device__ __forceinline__ bool keep_acc(const pg8::Unit&) { return false; }
    float* sink; __device__ __forceinline__ void operator()(const f32x4 (&acc)[2][2][4][2], const pg8::Unit& u, int wr, int wc, int fr, int fq) const { float s = 0.f;
#pragma unroll
        for (int a = 0; a < 2; ++a)
#pragma unroll
            for (int b = 0; b < 2; ++b)
#pragma unroll
                for (int m = 0; m < 4; ++m)
#pragma unroll
                    for (int n = 0; n < 2; ++n) s += (acc[a][b][m][n][0] + acc[a][b][m][n][1]) + (acc[a][b][m][n][2] + acc[a][b][m][n][3]);
        if (s == 1.2345e-30f) sink[0] = 1.f; } };
__device__ __forceinline__ void phase_inproj_probe(Frame& F, int l) {
    SchedDense S; S.A = (const char*)(F_WS + WS_XB); S.B = (const char*)(F_WS + WS_WIN) + (size_t)l * N_INP * D * 2; S.lda = D; S.lda_b = 256 * D * 2; S.ldb_b = 256 * D * 2; S.nN = N_INP / 256; S.nt = D / 64; S.G = F.G; S.vcu = F.vcu; S.ntiles = (T / 256) * (N_INP / 256);
    EpiNone E{(float*)(F_WS + WS_CTL) + 8};
    pg8::gemm_phase<EpiNone, SchedDense, true>(F.lds, F.tid, D, S, E);
}
template <int EMODE> __device__ __forceinline__ void phase_inproj_mode(Frame& F, int l) {
    SchedDense S; S.A = (const char*)(F_WS + WS_XB); S.B = (const char*)(F_WS + WS_WIN) + (size_t)l * N_INP * D * 2; S.lda = D; S.lda_b = 256 * D * 2; S.ldb_b = 256 * D * 2; S.nN = N_INP / 256; S.nt = D / 64; S.G = F.G; S.vcu = F.vcu; S.ntiles = (T / 256) * (N_INP / 256);
    EpiInProjT<EMODE> E{F_WS};
    pg8::gemm_phase<EpiInProjT<EMODE>, SchedDense, true>(F.lds, F.tid, D, S, E);
}
__device__ __forceinline__ void phase_inproj(Frame& F, int l) {
    SchedDense S; S.A = (const char*)(F_WS + WS_XB); S.B = (const char*)(F_WS + WS_WIN) + (size_t)l * N_INP * D * 2; S.lda = D; S.lda_b = 256 * D * 2; S.ldb_b = 256 * D * 2; S.nN = N_INP / 256; S.nt = D / 64; S.G = F.G; S.vcu = F.vcu; S.ntiles = (T / 256) * (N_INP / 256);
    EpiInProj E{F_WS};
    pg8::gemm_phase<EpiInProj, SchedDense, true>(F.lds, F.tid, D, S, E);
}

constexpr int KROW = 144;
struct FlashState { float m, l; f32x16 o0, o1; };
__device__ __forceinline__ s16x4 tr_read(unsigned addr) { s16x4 r; asm volatile("ds_read_b64_tr_b16 %0, %1" : "=v"(r) : "v"(addr) : "memory"); return r; }
__device__ __forceinline__ void flash_core(FlashState& st, const bf16x8 (&qf)[4], const bf16x8 (&kfr)[4], unsigned Vt, unsigned vmask, int lane);
__device__ __forceinline__ void flash_tile(FlashState& st, const bf16x8 (&qf)[4], unsigned Kt, unsigned Vt, unsigned vmask, int lane) {
    const int r32 = lane & 31, half = lane >> 5;
    bf16x8 kfr[4];
#pragma unroll
    for (int ks = 0; ks < 4; ++ks) kfr[ks] = *(const LAS bf16x8*)(uintptr_t)(Kt + r32 * KROW + (16 * ks + 8 * half) * 2);
    flash_core(st, qf, kfr, Vt, vmask, lane);
}
__device__ __forceinline__ void flash_core(FlashState& st, const bf16x8 (&qf)[4], const bf16x8 (&kfr)[4], unsigned Vt, unsigned vmask, int lane) {
    const int half = lane >> 5;
    s16x4 vlo[2][2], vhi[2][2];
    { const int g = lane >> 4, i16 = lane & 15, q_ = i16 >> 2, pp = i16 & 3;
#pragma unroll
      for (int sx = 0; sx < 2; ++sx)
#pragma unroll
        for (int dt = 0; dt < 2; ++dt) { const unsigned a0 = Vt + (16 * sx + 4 * (g >> 1) + q_) * KROW + (32 * dt + 16 * (g & 1) + 4 * pp) * 2; vlo[sx][dt] = tr_read(a0); vhi[sx][dt] = tr_read(a0 + 8 * KROW); } }
    f32x16 s = {};
#pragma unroll
    for (int ks = 0; ks < 4; ++ks) s = __builtin_amdgcn_mfma_f32_32x32x16_bf16(kfr[ks], qf[ks], s, 0, 0, 0);
    const bool full = __ballot(vmask != 0xffffu) == 0ull;
    float mx = -1e30f;
    if (full) {
#pragma unroll
        for (int i = 0; i < 16; ++i) mx = fmaxf(mx, s[i]);
        mx *= SM_C;
    } else {
#pragma unroll
        for (int i = 0; i < 16; ++i) { const float v = ((vmask >> i) & 1u) ? s[i] : -1e30f; mx = fmaxf(mx, v); }
        mx = fmaxf(mx * SM_C, -1e30f);
    }
    mx = half_max(mx);
    const float mn = fmaxf(st.m, mx), alpha = __builtin_amdgcn_exp2f(st.m - mn);
    float ls = 0.f; float p[16];
    if (full) {
#pragma unroll
        for (int i = 0; i < 16; ++i) { p[i] = __builtin_amdgcn_exp2f(fmaf(s[i], SM_C, -mn)); ls += p[i]; }
    } else {
#pragma unroll
        for (int i = 0; i < 16; ++i) { p[i] = ((vmask >> i) & 1u) ? __builtin_amdgcn_exp2f(fmaf(s[i], SM_C, -mn)) : 0.f; ls += p[i]; }
    }
    st.l = st.l * alpha + ls; st.m = mn;
    if (__ballot(alpha != 1.0f) != 0ull) {
#pragma unroll
        for (int i = 0; i < 16; ++i) { st.o0[i] *= alpha; st.o1[i] *= alpha; }
    }
    asm volatile("s_waitcnt lgkmcnt(0)" : "+v"(vlo[0][0]), "+v"(vlo[0][1]), "+v"(vlo[1][0]), "+v"(vlo[1][1]), "+v"(vhi[0][0]), "+v"(vhi[0][1]), "+v"(vhi[1][0]), "+v"(vhi[1][1]) :: "memory");
#pragma unroll
    for (int sx = 0; sx < 2; ++sx) {
        v4u pw; pw.x = cvt_pk_bf16(p[8 * sx + 0], p[8 * sx + 1]); pw.y = cvt_pk_bf16(p[8 * sx + 2], p[8 * sx + 3]); pw.z = cvt_pk_bf16(p[8 * sx + 4], p[8 * sx + 5]); pw.w = cvt_pk_bf16(p[8 * sx + 6], p[8 * sx + 7]);
        const bf16x8 pf = __builtin_bit_cast(bf16x8, pw);
#pragma unroll
        for (int dt = 0; dt < 2; ++dt) {
            const s16x4 lo = vlo[sx][dt], hi = vhi[sx][dt];
            const bf16x8 vf = (bf16x8){lo[0], lo[1], lo[2], lo[3], hi[0], hi[1], hi[2], hi[3]};
            if (dt == 0) st.o0 = __builtin_amdgcn_mfma_f32_32x32x16_bf16(vf, pf, st.o0, 0, 0, 0);
            else st.o1 = __builtin_amdgcn_mfma_f32_32x32x16_bf16(vf, pf, st.o1, 0, 0, 0);
        }
    }
}
__device__ __forceinline__ void flash_store(const FlashState& st, float scale, bf16* orow, int lane) {
    const int half = lane >> 5;
#pragma unroll
    for (int dt = 0; dt < 2; ++dt)
#pragma unroll
        for (int g = 0; g < 4; ++g) {
            const f32x16& o = dt ? st.o1 : st.o0;
            v2u w; w.x = cvt_pk_bf16(o[4 * g] * scale, o[4 * g + 1] * scale); w.y = cvt_pk_bf16(o[4 * g + 2] * scale, o[4 * g + 3] * scale);
            *(v2u*)(orow + 32 * dt + 8 * g + 4 * half) = w;
        }
}
__device__ __forceinline__ void stage_rows(LAS unsigned char* dst, const bf16* src, long pitch, int first_valid, int tid) {
#pragma unroll
    for (int i = 0; i < 4; ++i) { const int pid = tid + 512 * i, r = pid >> 3, pc = pid & 7;
        v4u v = (v4u){0u, 0u, 0u, 0u};
        if (r >= first_valid) v = *(const v4u*)(src + (long)r * pitch + pc * 8);
        *(LAS v4u*)(dst + r * KROW + pc * 16) = v; }
}
__device__ __forceinline__ void stage_rows2(LAS unsigned char* dstk, const bf16* srck, LAS unsigned char* dstv, const bf16* srcv, long pitch, int first_valid, int tid) {
    v4u vk[4], vv[4];
#pragma unroll
    for (int i = 0; i < 4; ++i) { const int pid = tid + 512 * i, r = max(pid >> 3, first_valid), pc = pid & 7;
        vk[i] = *(const v4u*)(srck + (long)r * pitch + pc * 8); vv[i] = *(const v4u*)(srcv + (long)r * pitch + pc * 8); }
#pragma unroll
    for (int i = 0; i < 4; ++i) { const int pid = tid + 512 * i, r = pid >> 3, pc = pid & 7; const bool z = r < first_valid;
        *(LAS v4u*)(dstk + r * KROW + pc * 16) = z ? (v4u){0u, 0u, 0u, 0u} : vk[i]; *(LAS v4u*)(dstv + r * KROW + pc * 16) = z ? (v4u){0u, 0u, 0u, 0u} : vv[i]; }
}

__device__ __forceinline__ void moba_unit(Frame& F, int b, int h, int c) {
    LAS unsigned char* KS = F.lds; LAS unsigned char* VS = F.lds + 256 * KROW; LAS float* KM = (LAS float*)(F.lds + 2 * 256 * KROW);
    const int lane = F.lane, w = F.wave, r32 = lane & 31, half = lane >> 5;
    const long rowbase = (long)b * SEQ;
    bf16* BQ = (bf16*)(F_WS + WS_BQ); const bf16* BKp = (const bf16*)(F_WS + WS_BK); const bf16* BVp = (const bf16*)(F_WS + WS_BV);
    const float* KMP = (const float*)(F_WS + WS_KMP);
    __syncthreads();
    for (int i = F.tid; i < c * 64; i += NTHR) { const int n = i >> 6, d = i & 63; const float* p0 = KMP + (size_t)((b * 32 + n) * 2) * 256 + h * 64 + d; KM[i] = (p0[0] + p0[256]) * (1.0f / 256.0f); }
    const int tq = 256 * c + 32 * w + r32;
    const bf16* qrow = BQ + (rowbase + tq) * 256 + h * 64;
    bf16x8 qf[4];
#pragma unroll
    for (int ks = 0; ks < 4; ++ks) qf[ks] = *(const bf16x8*)(qrow + 16 * ks + 8 * half);
    __syncthreads();
    unsigned selmask = 0u;
    {
        v4u qp[8];
#pragma unroll
        for (int i = 0; i < 8; ++i) qp[i] = *(const v4u*)(qrow + 8 * i);
        float v1 = -INFINITY, v2 = -INFINITY, v3 = -INFINITY; int i1 = -1, i2 = -1, i3 = -1;
        for (int n = 0; n < c; ++n) {
            float a = 0.f;
#pragma unroll
            for (int i = 0; i < 8; ++i) {
                const f32x4 k0 = *(const LAS f32x4*)(KM + n * 64 + 8 * i), k1 = *(const LAS f32x4*)(KM + n * 64 + 8 * i + 4);
                a = fmaf(bflo(qp[i].x), k0[0], a); a = fmaf(bfhi(qp[i].x), k0[1], a); a = fmaf(bflo(qp[i].y), k0[2], a); a = fmaf(bfhi(qp[i].y), k0[3], a);
                a = fmaf(bflo(qp[i].z), k1[0], a); a = fmaf(bfhi(qp[i].z), k1[1], a); a = fmaf(bflo(qp[i].w), k1[2], a); a = fmaf(bfhi(qp[i].w), k1[3], a);
            }
            if (a > v1) { v3 = v2; i3 = i2; v2 = v1; i2 = i1; v1 = a; i1 = n; }
            else if (a > v2) { v3 = v2; i3 = i2; v2 = a; i2 = n; }
            else if (a > v3) { v3 = a; i3 = n; }
        }
        if (i1 >= 0) selmask |= 1u << i1; if (i2 >= 0) selmask |= 1u << i2; if (i3 >= 0) selmask |= 1u << i3;
    }
    FlashState st; st.m = -1e30f; st.l = 0.f; st.o0 = (f32x16){}; st.o1 = (f32x16){};
    const unsigned KSa = (unsigned)(uintptr_t)KS, VSa = (unsigned)(uintptr_t)VS;
    for (int n = 0; n <= c; ++n) {
        __syncthreads();
        stage_rows(KS, BKp + (rowbase + 256 * n) * 256 + h * 64, 256, 0, F.tid);
        stage_rows(VS, BVp + (rowbase + 256 * n) * 256 + h * 64, 256, 0, F.tid);
        __syncthreads();
        const bool own = (n == c);
        const bool mine = own || ((selmask >> n) & 1u);
        if (__ballot(mine) == 0ull) continue;
        const int ktmax = own ? w : 7;
        for (int kt = 0; kt <= ktmax; ++kt) {
            unsigned vm = 0u;
            if (mine) {
                if (!own || kt < w) vm = 0xffffu;
                else {
#pragma unroll
                    for (int i = 0; i < 16; ++i) { const int kl = (i & 3) + 8 * (i >> 2) + 4 * half; if (kl <= r32) vm |= 1u << i; }
                }
            }
            flash_tile(st, qf, KSa + kt * 32 * KROW, VSa + kt * 32 * KROW, vm, lane);
        }
    }
    const float lt = half_sum(st.l);
    flash_store(st, 1.0f / lt, BQ + (rowbase + tq) * 256 + h * 64, lane);
}


constexpr int MB_ST = 0, MB_VST = 73728, MB_KM = 110592, MB_SELB = 118784, MB_ITQ = 119808  , MB_ITB = 126720  , MB_NIT = 126944;
constexpr int MB_STW = 36;
__device__ __forceinline__ void moba_item(Frame& F, FlashState& st, const bf16x8 (&qf)[4], const bf16* Kt, int hh, long krow0, const bf16* Vg, int ktiles, int lane, int w, unsigned vm_full, bool causal, int qloc) {
    const int r32 = lane & 31, half = lane >> 5;
    LAS unsigned char* VT = F.lds + MB_VST + w * (32 * KROW);
    const unsigned VTa = (unsigned)(uintptr_t)VT;
    bf16x8 kc[4], kn[4], kf2[4]; v4u vc[4], vn[4], vf2[4];
    const bf16* kp = Kt + bk_off(hh, krow0 + r32, half);
    const bf16* vpa = Vg + (long)((lane >> 3) + 8) * 256 + 8 * (lane & 7); const bf16* vpb = vpa + 16 * 256;
#define MB_LD(kd, vd, kt_) do { const int kq_ = min((kt_), ktiles - 1); const bf16* kq = kp + (long)kq_ * 2048; \
        _Pragma("unroll") for (int ks = 0; ks < 4; ++ks) kd[ks] = *(const bf16x8*)(kq + ks * 512); \
        const bf16* va_ = vpa + (long)kq_ * 8192; const bf16* vb_ = vpb + (long)kq_ * 8192; \
        vd[0] = *(const v4u*)(va_ - 2048); vd[1] = *(const v4u*)va_; vd[2] = *(const v4u*)(vb_ - 2048); vd[3] = *(const v4u*)vb_; } while (0)
#define MB_PIN() asm volatile("" ::: "memory")
#define MB_STEP(kd, vd, kt_) do { \
        _Pragma("unroll") for (int i = 0; i < 4; ++i) { const int p = lane + 64 * i; *(LAS v4u*)(VT + (p >> 3) * KROW + 16 * (p & 7)) = vd[i]; } \
        LDS_WAIT(); \
        unsigned vm = vm_full; \
        if (causal && (kt_) == ktiles - 1) { vm = 0u;                  \
            _Pragma("unroll") for (int g = 0; g < 4; ++g) { const int nb = min(max(qloc - 4 * half - 8 * g + 1, 0), 4); vm |= ((1u << nb) - 1u) << (4 * g); } \
            vm &= vm_full; } \
        flash_core(st, qf, kd, VTa, vm, lane); } while (0)
    MB_LD(kc, vc, 0); MB_PIN(); MB_LD(kn, vn, 1); MB_PIN(); MB_LD(kf2, vf2, 2); MB_PIN();
    for (int kt = 0; kt < ktiles; kt += 3) {
        MB_STEP(kc, vc, kt);
        MB_PIN(); MB_LD(kc, vc, kt + 3); MB_PIN();
        if (kt + 1 < ktiles) MB_STEP(kn, vn, kt + 1);
        MB_PIN(); MB_LD(kn, vn, kt + 4); MB_PIN();
        if (kt + 2 < ktiles) MB_STEP(kf2, vf2, kt + 2);
        MB_PIN(); MB_LD(kf2, vf2, kt + 5); MB_PIN();
    }
#undef MB_STEP
#undef MB_PIN
#undef MB_LD
}
__device__ __forceinline__ void moba_unit2(Frame& F, int b, int h, int c) {
    int lane_ = F.lane; asm volatile("" : "+v"(lane_));
    const int lane = lane_, w = F.wave, r32 = lane & 31, half = lane >> 5;
    const long rowbase = (long)b * SEQ;
    bf16* BQ = (bf16*)(F_WS + WS_BQ); const bf16* BKt = (const bf16*)(F_WS + WS_BK); const bf16* BVp = (const bf16*)(F_WS + WS_BV) + rowbase * 256 + h * 64;
    const float* KMP = (const float*)(F_WS + WS_KMP);
    LAS float* ST = (LAS float*)(F.lds + MB_ST); LAS float* KM = (LAS float*)(F.lds + MB_KM);
    LAS unsigned char* SELB = F.lds + MB_SELB; LAS unsigned char* ITQ = F.lds + MB_ITQ; LAS unsigned char* ITB = F.lds + MB_ITB; LAS int* NIT = (LAS int*)(F.lds + MB_NIT);
    __syncthreads();
    { float ka[4], kb[4];
#pragma unroll
      for (int u = 0; u < 4; ++u) { const int i = min(F.tid + NTHR * u, 31 * 64 - 1); const float* p0 = KMP + (size_t)((b * 32 + (i >> 6)) * 2) * 256 + h * 64 + (i & 63); ka[u] = p0[0]; kb[u] = p0[256]; }
#pragma unroll
      for (int u = 0; u < 4; ++u) { const int i = F.tid + NTHR * u; if (i < c * 64) KM[i] = (ka[u] + kb[u]) * (1.0f / 256.0f); } }
    for (int i = F.tid; i < 256 * 2 * MB_STW; i += NTHR) { const int f = i % MB_STW; ST[i] = (f == 32) ? -1e30f : 0.f; }
    __syncthreads();
    {
        const int tq = 256 * c + 32 * w + r32;
        const bf16* qrow = BQ + (rowbase + tq) * 256 + h * 64;
        v4u qp[8];
#pragma unroll
        for (int i = 0; i < 8; ++i) qp[i] = *(const v4u*)(qrow + 8 * i);
        float v1 = -INFINITY, v2 = -INFINITY, v3 = -INFINITY; int i1 = -1, i2 = -1, i3 = -1;
        for (int n = 0; n < c; ++n) {
            float a = 0.f;
#pragma unroll
            for (int i = 0; i < 8; ++i) {
                const f32x4 k0 = *(const LAS f32x4*)(KM + n * 64 + 8 * i), k1 = *(const LAS f32x4*)(KM + n * 64 + 8 * i + 4);
                a = fmaf(bflo(qp[i].x), k0[0], a); a = fmaf(bfhi(qp[i].x), k0[1], a); a = fmaf(bflo(qp[i].y), k0[2], a); a = fmaf(bfhi(qp[i].y), k0[3], a);
                a = fmaf(bflo(qp[i].z), k1[0], a); a = fmaf(bfhi(qp[i].z), k1[1], a); a = fmaf(bflo(qp[i].w), k1[2], a); a = fmaf(bfhi(qp[i].w), k1[3], a);
            }
            if (a > v1) { v3 = v2; i3 = i2; v2 = v1; i2 = i1; v1 = a; i1 = n; }
            else if (a > v2) { v3 = v2; i3 = i2; v2 = a; i2 = n; }
            else if (a > v3) { v3 = a; i3 = n; }
        }
        unsigned selmask = 0u;
        if (i1 >= 0) selmask |= 1u << i1; if (i2 >= 0) selmask |= 1u << i2; if (i3 >= 0) selmask |= 1u << i3;
        if (half == 0) { unsigned m = selmask; unsigned rec = 0u; int cnt = 0;
#pragma unroll
            for (int r = 0; r < 3; ++r) if (m) { const int n = __builtin_ctz(m); m &= m - 1u; rec |= (unsigned)n << (8 * r); ++cnt; }
            rec |= (unsigned)cnt << 24;
            *(LAS unsigned*)(SELB + 4 * (32 * w + r32)) = rec; }
    }
    __syncthreads();
    const unsigned long long lt_mask = (1ull << lane) - 1ull;
    if (w < 3) {
        const int r = w; LAS unsigned char* itq = ITQ + r * 2304; LAS unsigned char* itb = ITB + r * 72;
        unsigned rec[4];
#pragma unroll
        for (int ch = 0; ch < 4; ++ch) rec[ch] = *(const LAS unsigned*)(SELB + 4 * (64 * ch + lane));
        int nit = 0;
        for (int n = 0; n < c; ++n) {
            int pos = 0;
#pragma unroll
            for (int ch = 0; ch < 4; ++ch) {
                const bool hit = ((int)(rec[ch] >> 24) > r) && ((int)((rec[ch] >> (8 * r)) & 0xffu) == n);
                const unsigned long long bm = __ballot(hit);
                if (hit) { const int p = pos + __popcll(bm & lt_mask); itq[(nit + (p >> 5)) * 32 + (p & 31)] = (unsigned char)(64 * ch + lane); }
                pos += __popcll(bm);
            }
            const int ni = (pos + 31) >> 5;
            if (ni > 0) { const int tail = pos & 31; if (tail && lane >= tail && lane < 32) itq[(nit + ni - 1) * 32 + lane] = 0xffu;
                if (lane < ni) itb[nit + lane] = (unsigned char)n; }
            nit += ni;
        }
        if (lane == 0) NIT[r] = nit;
    }
    __syncthreads();
    for (int r = 0; r < 3; ++r) {
        LAS unsigned char* itq = ITQ + r * 2304; LAS unsigned char* itb = ITB + r * 72;
        const int nit = NIT[r];
        for (int it = w; it < nit; it += NWAVES) {
            const int n = itb[it]; const int q = itq[it * 32 + r32]; const bool valid = q != 0xff; const int qq = valid ? q : 0;
            const bf16* qrow = BQ + (rowbase + 256 * c + qq) * 256 + h * 64;
            bf16x8 qf[4];
#pragma unroll
            for (int ks = 0; ks < 4; ++ks) qf[ks] = *(const bf16x8*)(qrow + 16 * ks + 8 * half);
            FlashState st; LAS float* sp = ST + (qq * 2 + half) * MB_STW;
#pragma unroll
            for (int i = 0; i < 16; i += 4) { const f32x4 a = *(const LAS f32x4*)(sp + i), bq = *(const LAS f32x4*)(sp + 16 + i); st.o0[i] = a.x; st.o0[i + 1] = a.y; st.o0[i + 2] = a.z; st.o0[i + 3] = a.w; st.o1[i] = bq.x; st.o1[i + 1] = bq.y; st.o1[i + 2] = bq.z; st.o1[i + 3] = bq.w; }
            { const f32x2 ml = *(const LAS f32x2*)(sp + 32); st.m = ml.x; st.l = ml.y; }
            moba_item(F, st, qf, BKt, h, rowbase + 256 * n, BVp + (long)(256 * n) * 256, 8, lane, w, valid ? 0xffffu : 0u, false, 0);
            if (valid) {
#pragma unroll
                for (int i = 0; i < 16; i += 4) { *(LAS f32x4*)(sp + i) = (f32x4){st.o0[i], st.o0[i + 1], st.o0[i + 2], st.o0[i + 3]}; *(LAS f32x4*)(sp + 16 + i) = (f32x4){st.o1[i], st.o1[i + 1], st.o1[i + 2], st.o1[i + 3]}; }
                *(LAS f32x2*)(sp + 32) = (f32x2){st.m, st.l}; }
        }
        __syncthreads();
    }
    {
        const int qloc = 32 * w + r32; const int tq = 256 * c + qloc;
        bf16* qrow = BQ + (rowbase + tq) * 256 + h * 64;
        bf16x8 qf[4];
#pragma unroll
        for (int ks = 0; ks < 4; ++ks) qf[ks] = *(const bf16x8*)(qrow + 16 * ks + 8 * half);
        FlashState st; LAS float* sp = ST + (qloc * 2 + half) * MB_STW;
#pragma unroll
        for (int i = 0; i < 16; i += 4) { const f32x4 a = *(const LAS f32x4*)(sp + i), bq = *(const LAS f32x4*)(sp + 16 + i); st.o0[i] = a.x; st.o0[i + 1] = a.y; st.o0[i + 2] = a.z; st.o0[i + 3] = a.w; st.o1[i] = bq.x; st.o1[i + 1] = bq.y; st.o1[i + 2] = bq.z; st.o1[i + 3] = bq.w; }
        { const f32x2 ml = *(const LAS f32x2*)(sp + 32); st.m = ml.x; st.l = ml.y; }
        moba_item(F, st, qf, BKt, h, rowbase + 256 * c, BVp + (long)(256 * c) * 256, w + 1, lane, w, 0xffffu, true, r32);
        const float lt = half_sum(st.l);
        flash_store(st, 1.0f / lt, qrow, lane);
    }
}

__device__ __forceinline__ void swa_unit(Frame& F, int l, int b, int kvh, int nb) {
    LAS unsigned char* KS = F.lds; LAS unsigned char* VS = F.lds + 256 * KROW;
    const int lane = F.lane, w = F.wave, r32 = lane & 31, half = lane >> 5;
    const long rowbase = (long)b * SEQ;
    bf16* CQ = (bf16*)(F_WS + WS_CQ); const bf16* CKV = (const bf16*)(F_WS + WS_CKV);
    __syncthreads();
    const long band0 = rowbase + 128 * nb - 128;
    stage_rows2(KS, CKV + band0 * 256 + kvh * 64, VS, CKV + band0 * 256 + 128 + kvh * 64, 256, nb == 0 ? 128 : 0, F.tid);
    __syncthreads();
    const int hq = kvh * 4 + (w >> 1);
    const float zs = F_IN(I_SINK)[l * 8 + hq] * LOG2E;
    const unsigned KSa = (unsigned)(uintptr_t)KS, VSa = (unsigned)(uintptr_t)VS;
    for (int gi = 0; gi < 2; ++gi) {
        const int i0 = (w & 1) * 64 + 32 * gi, iq = i0 + r32;
        bf16* qrow = CQ + (rowbase + 128 * nb + iq) * 512 + hq * 64;
        bf16x8 qf[4];
#pragma unroll
        for (int ks = 0; ks < 4; ++ks) qf[ks] = *(const bf16x8*)(qrow + 16 * ks + 8 * half);
        FlashState st; st.m = -1e30f; st.l = 0.f; st.o0 = (f32x16){}; st.o1 = (f32x16){};
        const int kt0 = (i0 + 1) >> 5, kt1 = (i0 + 159) >> 5;
        for (int kt = kt0; kt <= kt1; ++kt) {
            unsigned vm = 0u;
#pragma unroll
            for (int i = 0; i < 16; ++i) { const int kk = kt * 32 + (i & 3) + 8 * (i >> 2) + 4 * half; const bool ok = (kk > iq) && (kk <= iq + 128) && (nb > 0 || kk >= 128); if (ok) vm |= 1u << i; }
            flash_tile(st, qf, KSa + kt * 32 * KROW, VSa + kt * 32 * KROW, vm, lane);
        }
        const float lt = half_sum(st.l);
        const float m2 = fmaxf(st.m, zs), f = __builtin_amdgcn_exp2f(st.m - m2);
        const float lf = lt * f + __builtin_amdgcn_exp2f(zs - m2);
        flash_store(st, f / lf, qrow, lane);
    }
}

constexpr int DSA_KEYS = 0, DSA_HIST = 131072, DSA_SEL = 139264, DSA_BIDX = 143360, DSA_BSC = 145408, DSA_IQ = 149504;
constexpr int DSA_TOPK = 256, DSA_BCAP = 128;
constexpr int DSA_ZC = 153600;
constexpr int DSA_NXT = 153632;
constexpr int CW_DSAQ = 200000;
constexpr int DSA_IWL = 153664;
constexpr int DSA_VROW = 144;
__device__ __forceinline__ unsigned sortable16(float s) { const short b = __builtin_bit_cast(short, (_Float16)s); return (unsigned)(unsigned short)(b ^ (short)((short)(b >> 15) | (short)0x8000)); }
__device__ __forceinline__ float key_float(unsigned k16) { const unsigned b = (k16 & 0x8000u) ? (k16 ^ 0x8000u) : (~k16 & 0xffffu); return (float)__builtin_bit_cast(_Float16, (unsigned short)b); }
__device__ __forceinline__ int lin_bin(float sT, float inv, float c0) { return (int)__builtin_amdgcn_fmed3f(fmaf(sT, inv, c0), 0.f, 255.f); }
__device__ __forceinline__ int wave_prefix_incl(int v, int lane) {
    v += __builtin_amdgcn_update_dpp(0, v, 0x111, 0xf, 0xf, true); v += __builtin_amdgcn_update_dpp(0, v, 0x112, 0xf, 0xf, true);
    v += __builtin_amdgcn_update_dpp(0, v, 0x114, 0xf, 0xf, true); v += __builtin_amdgcn_update_dpp(0, v, 0x118, 0xf, 0xf, true);
    const int t0 = __builtin_amdgcn_readlane(v, 15), t1 = __builtin_amdgcn_readlane(v, 31), t2 = __builtin_amdgcn_readlane(v, 47);
    return v + (lane >= 48 ? t0 + t1 + t2 : (lane >= 32 ? t0 + t1 : (lane >= 16 ? t0 : 0)));
}
__device__ __forceinline__ unsigned pk_gt_flags(unsigned keys, unsigned t2, unsigned one2) { unsigned r; asm("v_pk_sub_u16 %0, %1, %2 clamp\n\tv_pk_min_u16 %0, %0, %3" : "=&v"(r) : "v"(keys), "v"(t2), "v"(one2)); return r; }
__device__ __forceinline__ unsigned pk_add16(unsigned a, unsigned b) { unsigned r; asm("v_pk_add_u16 %0, %1, %2" : "=v"(r) : "v"(a), "v"(b)); return r; }
__device__ __forceinline__ void find_bin(const LAS unsigned* hist, unsigned target, int lane, unsigned& bin, unsigned& above, unsigned& cnt) {
    const v4u hv = *(const LAS v4u*)(hist + 4 * lane);
    const unsigned tl = hv.x + hv.y + hv.z + hv.w;
    const int pin = wave_prefix_incl((int)tl, lane);
    const unsigned suf = (unsigned)(__builtin_amdgcn_readlane(pin, 63) - pin) + tl;
    const unsigned s4 = suf - tl;
    const unsigned S3 = s4 + hv.w, S2 = S3 + hv.z, S1 = S2 + hv.y, S0 = S1 + hv.x;
    int which = -1; unsigned ab = 0, cn = 0;
    if (S3 >= target && s4 < target) { which = 3; ab = s4; cn = hv.w; }
    else if (S2 >= target && S3 < target) { which = 2; ab = S3; cn = hv.z; }
    else if (S1 >= target && S2 < target) { which = 1; ab = S2; cn = hv.y; }
    else if (S0 >= target && S1 < target) { which = 0; ab = S1; cn = hv.x; }
    const unsigned long long bm = __ballot(which >= 0);
    const int src = bm ? (int)__builtin_ctzll(bm) : 0;
    bin = (unsigned)__builtin_amdgcn_readlane(4 * lane + which, src); above = __builtin_amdgcn_readlane(ab, src); cnt = __builtin_amdgcn_readlane(cn, src);
}
__device__ __forceinline__ void dsa_exact_boundary(const LAS u16* IQL, const u16* IKb, f32x4 wq, LAS u16* bidx, LAS float* bsc, LAS u16* sel, int nsel, int E, int need, int lane, unsigned long long lt_mask) {
    float sc[2]; int ki[2];
#pragma unroll
    for (int r = 0; r < 2; ++r) { const int e = lane + 64 * r; sc[r] = -INFINITY; ki[r] = 0x7fffffff;
        if (e < E) { const int key = bidx[e]; ki[r] = key; float s = 0.f;
            for (int hd = 0; hd < 4; ++hd) { float a = 0.f;
                for (int d = 0; d < 64; d += 8) { const f16x8 kv = *(const f16x8*)(IKb + ik_off(key, d >> 3)); const f16x8 qv = *(const LAS f16x8*)(IQL + hd * 64 + d);
#pragma unroll
                    for (int x = 0; x < 8; ++x) a = fmaf((float)qv[x], (float)kv[x], a); }
                s = fmaf(wq[hd], fmaxf(a, 0.f), s); }
            sc[r] = s; bsc[e] = s; } }
    LDS_WAIT();
#pragma unroll
    for (int r = 0; r < 2; ++r) { const int e = lane + 64 * r; int rank = 0;
        if (e < E) { for (int o = 0; o < E; ++o) { const float so = bsc[o]; const int io = bidx[o]; rank += (so > sc[r] || (so == sc[r] && io < ki[r])) ? 1 : 0; } }
        const bool take = (e < E) && rank < need;
        const unsigned long long tm = __ballot(take);
        if (take) sel[nsel + __popcll(tm & lt_mask)] = (u16)ki[r];
        nsel += __popcll(tm); }
}
__device__ __forceinline__ int dsa_rescore_select(LAS unsigned char* lds, const u16* IKb, f32x4 wq, LAS u16* bidx, LAS float* bsc, LAS u16* sel, int nsel, int En, int need_eq, int lane, int w, unsigned long long lt_mask, int dpe) {
    const int r32 = lane & 31, half = lane >> 5;
    f16x8 aop[4];
    { const int q = r32 >> 2, hd = r32 & 3; const LAS u16* pl = (const LAS u16*)(lds + DSA_IQ) + q * 256 + hd * 64 + 8 * half;
#pragma unroll
      for (int ks = 0; ks < 4; ++ks) aop[ks] = *(const LAS f16x8*)(pl + 16 * ks); }
    for (int r0 = 0; r0 < En; r0 += 32) {
        const int c = r0 + r32; const int key = (c < En) ? (int)bidx[c] : 0;
        f32x16 dacc = {};
#pragma unroll
        for (int ks = 0; ks < 4; ++ks) { const f16x8 bop = *(const f16x8*)(IKb + ik_off(key, 2 * ks + half)); dacc = __builtin_amdgcn_mfma_f32_32x32x16_f16(aop[ks], bop, dacc, 0, 0, 0); }
        const int g = w >> 1; float s = 0.f;
#pragma unroll
        for (int hd = 0; hd < 4; ++hd) { const float dv = g == 0 ? dacc[hd] : (g == 1 ? dacc[4 + hd] : (g == 2 ? dacc[8 + hd] : dacc[12 + hd])); s = fmaf(wq[hd], fmaxf(dv, 0.f), s); }
        if (half == (w & 1) && c < En) bsc[c] = s;
    }
    LDS_WAIT();
    {
        const bool v0 = lane < En, v1 = lane + 64 < En;
        unsigned k0 = 0u, k1 = 0u; int i0 = 0, i1 = 0;
        { const int e0 = v0 ? lane : 0, e1 = v1 ? lane + 64 : 0;
          unsigned u0 = __builtin_bit_cast(unsigned, bsc[e0]), u1 = __builtin_bit_cast(unsigned, bsc[e1]); i0 = (int)bidx[e0]; i1 = (int)bidx[e1];
          u0 ^= (unsigned)((int)u0 >> 31) | 0x80000000u; u1 ^= (unsigned)((int)u1 >> 31) | 0x80000000u; k0 = u0; k1 = u1; }
        unsigned prefix = 0u; int remaining = need_eq;
#pragma unroll 4
        for (int bit = 31; bit >= 0; --bit) {
            const unsigned test = prefix | (1u << bit), hm = ~((1u << bit) - 1u);
            const int c = __popcll(__ballot(v0 && (k0 & hm) == test)) + __popcll(__ballot(v1 && (k1 & hm) == test));
            if (c >= remaining) prefix = test; else remaining -= c;
        }
        const bool t0 = v0 && k0 == prefix, t1 = v1 && k1 == prefix;
        bool take0 = v0 && k0 > prefix, take1 = v1 && k1 > prefix;
        const unsigned long long tm0 = __ballot(t0), tm1 = __ballot(t1);
        if (__popcll(tm0) + __popcll(tm1) == remaining) { take0 = take0 || t0; take1 = take1 || t1; }
        else {
            int r0 = 0, r1 = 0;
            for (unsigned long long m = tm0; m; m &= m - 1ull) { const int ib = __builtin_amdgcn_readlane(i0, (int)__builtin_ctzll(m)); r0 += (ib < i0) ? 1 : 0; r1 += (ib < i1) ? 1 : 0; }
            for (unsigned long long m = tm1; m; m &= m - 1ull) { const int ib = __builtin_amdgcn_readlane(i1, (int)__builtin_ctzll(m)); r0 += (ib < i0) ? 1 : 0; r1 += (ib < i1) ? 1 : 0; }
            take0 = take0 || (t0 && r0 < remaining); take1 = take1 || (t1 && r1 < remaining);
        }
        const unsigned long long w0 = __ballot(take0);
        if (take0) sel[nsel + __popcll(w0 & lt_mask)] = (u16)i0;
        nsel += __popcll(w0);
        const unsigned long long w1 = __ballot(take1);
        if (take1) sel[nsel + __popcll(w1 & lt_mask)] = (u16)i1;
        nsel += __popcll(w1);
    }
    return nsel;
}
__device__ __forceinline__ void dsa_select_slow(LAS unsigned char* lds, int w, const LAS u16* myk, LAS unsigned* hist, LAS u16* sel, LAS u16* bidx, LAS float* bsc, const u16* IKb, f32x4 wq, int npad, int lane, unsigned long long lt_mask) {
    const LAS unsigned* k2 = (const LAS unsigned*)myk;
    for (int i = lane; i < npad / 2; i += 64) { const unsigned kk = k2[i]; __hip_atomic_fetch_add(hist + ((kk >> 8) & 0xffu), 1u, __ATOMIC_RELAXED, __HIP_MEMORY_SCOPE_WORKGROUP); __hip_atomic_fetch_add(hist + (kk >> 24), 1u, __ATOMIC_RELAXED, __HIP_MEMORY_SCOPE_WORKGROUP); }
    LDS_WAIT();
    unsigned B1, above1, c1; find_bin(hist, DSA_TOPK, lane, B1, above1, c1);
    LDS_WAIT();
    *(LAS v4u*)(hist + 4 * lane) = (v4u){0u, 0u, 0u, 0u};
    LDS_WAIT();
    for (int i = lane; i < npad / 2; i += 64) { const unsigned kk = k2[i];
        if (((kk >> 8) & 0xffu) == B1) __hip_atomic_fetch_add(hist + (kk & 0xffu), 1u, __ATOMIC_RELAXED, __HIP_MEMORY_SCOPE_WORKGROUP);
        if ((kk >> 24) == B1) __hip_atomic_fetch_add(hist + ((kk >> 16) & 0xffu), 1u, __ATOMIC_RELAXED, __HIP_MEMORY_SCOPE_WORKGROUP); }
    LDS_WAIT();
    unsigned B2, above2, E; find_bin(hist, DSA_TOPK - above1, lane, B2, above2, E);
    const unsigned bstar = (B1 << 8) | B2; const int need = DSA_TOPK - (int)(above1 + above2);
    const bool index_mode = ((int)E == need) || (E > (unsigned)DSA_BCAP) || (bstar == 0x8000u);
    int nsel = 0, neq = 0;
    for (int c0 = 0; c0 < npad; c0 += 64) {
        const int j = c0 + lane; const unsigned kk = (j < npad) ? myk[j] : 0u;
        const bool gt = kk > bstar, eq = (kk == bstar);
        const unsigned long long em = __ballot(eq);
        const int epos = neq + __popcll(em & lt_mask);
        const bool take = gt || (index_mode && eq && epos < need);
        const unsigned long long tm = __ballot(take);
        if (take) sel[nsel + __popcll(tm & lt_mask)] = (u16)j;
        if (!index_mode && eq) bidx[epos] = (u16)j;
        nsel += __popcll(tm); neq += __popcll(em);
    }
    if (!index_mode) { LDS_WAIT(); dsa_rescore_select(lds, IKb, wq, bidx, bsc, sel, nsel, (int)E, need, lane, w, lt_mask, 7); }
}

template <int DP = 7> __device__ __forceinline__ void dsa_unit(Frame& F, int b, int t0, int& nb, int& nt0, int grp, int ngrp, v2u& iqn, float& iwn, int dpr = 7) {
    const int dpe = DP & dpr;
    LAS u16* KEYS = (LAS u16*)(F.lds + DSA_KEYS);
    int lane_ = F.lane; asm volatile("" : "+v"(lane_));
    const int lane = lane_, w = F.wave, r32 = lane & 31, half = lane >> 5;
    const long rowbase = (long)b * SEQ;
    const u16* IQ = (const u16*)(F_WS + WS_IQ); const u16* IKb = (const u16*)(F_WS + WS_IK) + rowbase * 64; const float* IW = (const float*)(F_WS + WS_IW);
    const bf16* KAVAb = (const bf16*)(F_WS + WS_KAVA) + rowbase * 128; bf16* AQ = (bf16*)(F_WS + WS_AQ);
    const int nkeys = t0 + 8, ntiles = (nkeys + 31) >> 5, npad = ntiles * 32;
    LAS unsigned* HISTALL = (LAS unsigned*)(F.lds + DSA_HIST);
    __syncthreads();
    { const int nk = *(const LAS int*)(F.lds + DSA_NXT); const int per = (T / 8) / ngrp;
      if (nk >= per) { nb = 0; nt0 = -1; } else if (ngrp == 4) { nb = grp; nt0 = 8 * (per - 1 - nk); } else { nb = nk & 3; nt0 = 8 * ((T / 32) - 1 - (nk >> 2)); } }
    { LAS u16* IQLw = (LAS u16*)(F.lds + DSA_IQ); *(LAS v2u*)(IQLw + 4 * F.tid) = iqn; if (F.tid < 32) ((LAS float*)(F.lds + DSA_IWL))[F.tid] = iwn; }
#define DSA_PREFETCH_NEXT() do { if (nt0 >= 0) { iqn = *(const v2u*)(IQ + ((long)nb * SEQ + nt0) * 256 + 4 * F.tid); if (F.tid < 32) iwn = IW[((long)nb * SEQ + nt0) * 4 + F.tid]; } } while (0)
    float minv, mc0;
    {
        float binv[4], bc0[4];
        f16x8 bt0[4];
        f16x8 b0[4], b1[4], b2[4];
#define DSA_LDT(dst, ktile) do { const int kb_ = min((ktile), ntiles - 1) * 32 + r32; _Pragma("unroll") for (int ks = 0; ks < 4; ++ks) dst[ks] = *(const f16x8*)(IKb + ik_off(kb_, 2 * ks + half)); } while (0)
#define DSA_PIN() asm volatile("" ::: "memory")
#pragma unroll
        for (int ks = 0; ks < 4; ++ks) bt0[ks] = *(const f16x8*)(IKb + ik_off(r32, 2 * ks + half));
        DSA_PIN(); DSA_LDT(b0, w); DSA_PIN(); DSA_LDT(b1, w + NWAVES); DSA_PIN(); DSA_LDT(b2, w + 2 * NWAVES); DSA_PIN();
        __syncthreads();
        f16x8 aop[4];
        { const int q = r32 >> 2, hd = r32 & 3; const LAS u16* pl = (const LAS u16*)(F.lds + DSA_IQ) + q * 256 + hd * 64 + 8 * half;
#pragma unroll
          for (int ks = 0; ks < 4; ++ks) aop[ks] = *(const LAS f16x8*)(pl + 16 * ks); }
        f32x4 wv[4];
#pragma unroll
        for (int g = 0; g < 4; ++g) wv[g] = *(const LAS f32x4*)((const LAS float*)(F.lds + DSA_IWL) + (2 * g + half) * 4);
        float finf = INFINITY; asm volatile("" : "+s"(finf));
        {
            f32x16 dacc = {};
#pragma unroll
            for (int ks = 0; ks < 4; ++ks) dacc = __builtin_amdgcn_mfma_f32_32x32x16_f16(aop[ks], bt0[ks], dacc, 0, 0, 0);
#pragma unroll
            for (int g = 0; g < 4; ++g) {
                float s = 0.f;
#pragma unroll
                for (int hd = 0; hd < 4; ++hd) s = fmaf(wv[g][hd], fmaxf(dacc[4 * g + hd], 0.f), s);
                float m = row_sum(s); m += xor_f<16>(m); m *= (1.0f / 32.0f);
                float v = row_sum((s - m) * (s - m)); v += xor_f<16>(v);
                const float sg = sqrtf(v * (1.0f / 32.0f));
                const bool okf = (sg > 1e-20f) && (sg < 1e20f);
                binv[g] = okf ? 25.6f / sg : 0.f; bc0[g] = okf ? -(m - 1.5f * sg) * binv[g] : 0.f;
            }
        }
        { const int g = w >> 1; const float a = g == 0 ? binv[0] : (g == 1 ? binv[1] : (g == 2 ? binv[2] : binv[3])), c = g == 0 ? bc0[0] : (g == 1 ? bc0[1] : (g == 2 ? bc0[2] : bc0[3]));
          minv = __builtin_bit_cast(float, __builtin_amdgcn_readlane(__builtin_bit_cast(int, a), (w & 1) * 32)); mc0 = __builtin_bit_cast(float, __builtin_amdgcn_readlane(__builtin_bit_cast(int, c), (w & 1) * 32)); }
#define DSA_SCORE(g_) (fmaf(wv[g_][3], __builtin_amdgcn_fmed3f(dacc[4 * (g_) + 3], 0.f, finf), fmaf(wv[g_][2], __builtin_amdgcn_fmed3f(dacc[4 * (g_) + 2], 0.f, finf), \
            fmaf(wv[g_][1], __builtin_amdgcn_fmed3f(dacc[4 * (g_) + 1], 0.f, finf), fmaf(wv[g_][0], __builtin_amdgcn_fmed3f(dacc[4 * (g_)], 0.f, finf), 0.f)))))
#define DSA_PROC(bb, ktile) do { const int key = (ktile) * 32 + r32; \
            f32x16 dacc = {}; \
            _Pragma("unroll") for (int ks = 0; ks < 4; ++ks) dacc = __builtin_amdgcn_mfma_f32_32x32x16_f16(aop[ks], bb[ks], dacc, 0, 0, 0); \
            if ((ktile) * 32 + 31 <= t0) {                         \
                _Pragma("unroll") for (int g = 0; g < 4; ++g) { \
                    const float s = DSA_SCORE(g); const int q = 2 * g + half; const unsigned k16 = sortable16(s); \
                    if (!(dpe & 128)) KEYS[q * 8192 + key] = (u16)k16; \
                    if (!(dpe & 64)) { const float sT = (float)(_Float16)s;                         \
                          \
                        LAS unsigned* cnt = (k16 == 0x8000u) ? ((LAS unsigned*)(F.lds + DSA_ZC) + q) : (HISTALL + q * 256 + lin_bin(sT, binv[g], bc0[g])); \
                        __hip_atomic_fetch_add(cnt, 1u, __ATOMIC_RELAXED, __HIP_MEMORY_SCOPE_WORKGROUP); } \
                } \
            } else { \
                _Pragma("unroll") for (int g = 0; g < 4; ++g) { \
                    const float s = DSA_SCORE(g); const int q = 2 * g + half; \
                    const bool valid = key <= t0 + q; \
                    const unsigned k16 = valid ? sortable16(s) : 0u; \
                    if (!(dpe & 128)) KEYS[q * 8192 + key] = (u16)k16; \
                    if (!(dpe & 64)) if (valid) { const float sT = (float)(_Float16)s;                         \
                        LAS unsigned* cnt = (k16 == 0x8000u) ? ((LAS unsigned*)(F.lds + DSA_ZC) + q) : (HISTALL + q * 256 + lin_bin(sT, binv[g], bc0[g])); \
                        __hip_atomic_fetch_add(cnt, 1u, __ATOMIC_RELAXED, __HIP_MEMORY_SCOPE_WORKGROUP); } \
                } \
            } } while (0)
        for (int kt = (dpe & 256) ? ntiles : w; kt < ntiles; kt += 3 * NWAVES) {
            DSA_PROC(b0, kt);
            DSA_PIN(); DSA_LDT(b0, kt + 3 * NWAVES); DSA_PIN();
            if (kt + NWAVES < ntiles) DSA_PROC(b1, kt + NWAVES);
            DSA_PIN(); DSA_LDT(b1, kt + 4 * NWAVES); DSA_PIN();
            if (kt + 2 * NWAVES < ntiles) DSA_PROC(b2, kt + 2 * NWAVES);
            DSA_PIN(); DSA_LDT(b2, kt + 5 * NWAVES); DSA_PIN();
        }
#undef DSA_PROC
#undef DSA_SCORE
#undef DSA_LDT
#undef DSA_PIN
    }
#ifdef TP_DSA_RT
    DSA_PREFETCH_NEXT();
#endif
    __syncthreads();
    if (!(dpe & 2)) { *(LAS v4u*)(HISTALL + F.wave * 256 + 4 * lane) = (v4u){0u, 0u, 0u, 0u}; if (lane == 0) ((LAS unsigned*)(F.lds + DSA_ZC))[F.wave] = 0u; return; }
    const int t = t0 + w, n = t + 1;
    LAS u16* myk = KEYS + w * 8192; LAS unsigned* hist = HISTALL + w * 256; LAS u16* sel = (LAS u16*)(F.lds + DSA_SEL) + w * 256;
    LAS u16* bidx = (LAS u16*)(F.lds + DSA_BIDX) + w * DSA_BCAP; LAS float* bsc = (LAS float*)(F.lds + DSA_BSC) + w * DSA_BCAP;
    const LAS u16* IQL = (const LAS u16*)(F.lds + DSA_IQ) + w * 256;
    const unsigned long long lt_mask = (1ull << lane) - 1ull;
    int count;
    if (n <= DSA_TOPK) {
        count = n;
        for (int j = lane; j < DSA_TOPK; j += 64) sel[j] = (u16)(j < n ? j : 0);
        *(LAS v4u*)(hist + 4 * lane) = (v4u){0u, 0u, 0u, 0u};
        if (lane == 0) ((LAS unsigned*)(F.lds + DSA_ZC))[w] = 0u;
    } else {
        count = DSA_TOPK;
        const f32x4 wq = *(const LAS f32x4*)((const LAS float*)(F.lds + DSA_IWL) + w * 4);
        typedef unsigned short us2 __attribute__((ext_vector_type(2)));
        const LAS v4u* k8 = (const LAS v4u*)myk;
        LAS unsigned* ZC = (LAS unsigned*)(F.lds + DSA_ZC);
        const int Z = (int)ZC[w]; const int bz = lin_bin(0.f, minv, mc0);
        if (lane == (bz >> 2)) hist[bz] += (unsigned)Z;
        LDS_WAIT();
        if (lane == 0) ZC[w] = 0u;
        unsigned B, above, E; find_bin(hist, DSA_TOPK, lane, B, above, E);
        LDS_WAIT();
        *(LAS v4u*)(hist + 4 * lane) = (v4u){0u, 0u, 0u, 0u};
        LDS_WAIT();
        const int need = DSA_TOPK - (int)above;
        if (dpe & 16) return;
        const int nch = (npad + 511) >> 9;
        auto count_ge = [&](unsigned thr) -> int {
            const unsigned t1 = thr - 1u, t2 = t1 | (t1 << 16); unsigned one2 = 0x00010001u; asm volatile("" : "+v"(one2)); unsigned acc = 0u;
            for (int ch = 0; ch < nch; ch += 2) {
                v4u kv[2];
#pragma unroll
                for (int u2 = 0; u2 < 2; ++u2) kv[u2] = k8[min(ch + u2, nch - 1) * 64 + lane];
#pragma unroll
                for (int u2 = 0; u2 < 2; ++u2) {
                    const bool live = (ch + u2 < nch) && ((ch + u2) * 512 + 8 * lane < npad);
                    unsigned c4 = pk_gt_flags(kv[u2].x, t2, one2);
                    c4 = pk_add16(c4, pk_gt_flags(kv[u2].y, t2, one2)); c4 = pk_add16(c4, pk_gt_flags(kv[u2].z, t2, one2)); c4 = pk_add16(c4, pk_gt_flags(kv[u2].w, t2, one2));
                    acc = pk_add16(acc, live ? c4 : 0u); }
            }
            return (int)(acc & 0xffffu) + (int)(acc >> 16); };
        bool done = false;
        if (minv > 0.f) {
            unsigned kLo, kHi;
            {
                auto first_ge = [&](int tb) -> unsigned {
                    const float bnd = ((float)tb - mc0) / minv; unsigned k = sortable16(bnd); k = k < 0x0404u ? 0x0404u : (k > 0xfbfbu ? 0xfbfbu : k);
                    unsigned r = 0u;
#pragma unroll
                    for (int d = 4; d >= -3; --d) { const unsigned kk = k + (unsigned)d; if (lin_bin(key_float(kk), minv, mc0) >= tb) r = kk; }
                    const bool okw = (r != 0u) && (lin_bin(key_float(r), minv, mc0) >= tb) && (lin_bin(key_float(r - 1u), minv, mc0) < tb) && (r > 0x0400u);
                    if (okw) return r;
                    unsigned lo = 0x0400u, hi = 0xfc00u;
                    while (lo < hi) { const unsigned mid = (lo + hi) >> 1; if (lin_bin(key_float(mid), minv, mc0) >= tb) hi = mid; else lo = mid + 1; }
                    return lo; };
                kLo = first_ge((int)B);
                kHi = (B == 255u) ? 0xffffu : first_ge((int)B + 1) - 1u;
            }
            unsigned cLo = kLo, cHi = kHi; int need_eq = need, extra_zero = 0; bool ok = (E <= (unsigned)DSA_BCAP);
            if ((int)B == bz && Z > 0) {
                const int mine = count_ge(0x8001u); const int P = (int)wave_sum((float)mine) - (int)above;
                if (need <= P) { cLo = 0x8001u; ok = (P <= DSA_BCAP); }
                else if (need <= P + Z) { cLo = 0x8001u; cHi = 0x8000u; need_eq = 0; extra_zero = need - P; ok = true; }
                else { cHi = 0x7fffu; need_eq = need - P - Z; ok = ((int)E - P - Z <= DSA_BCAP) && ((int)above + (int)E <= 512); }
            }
            if (ok) {
                done = true;
                const unsigned lo1 = cLo - 1u, tl2 = lo1 | (lo1 << 16);
                LAS u16* cand = (LAS u16*)hist;
                const int mycnt = count_ge(cLo);
                const int pre = wave_prefix_incl(mycnt, lane);
                const int C = min(__builtin_amdgcn_readlane(pre, 63), 512);
                int pos = pre - mycnt;
                unsigned one2 = 0x00010001u; asm volatile("" : "+v"(one2));
                for (int ch = 0; ch < nch; ch += 2) {
                    v4u kv[2];
#pragma unroll
                    for (int u2 = 0; u2 < 2; ++u2) kv[u2] = k8[min(ch + u2, nch - 1) * 64 + lane];
#pragma unroll
                    for (int u2 = 0; u2 < 2; ++u2) {
                        const int j0 = (ch + u2) * 512 + 8 * lane;
                        const bool live = (ch + u2 < nch) && (j0 < npad);
                        unsigned m = 0u;
#pragma unroll
                        for (int d = 0; d < 4; ++d) { const unsigned wd = d == 0 ? kv[u2].x : (d == 1 ? kv[u2].y : (d == 2 ? kv[u2].z : kv[u2].w));
                            m |= pk_gt_flags(wd, tl2, one2) << d; }
                        if (!live) m = 0u;
                        while (m) { const int x = __builtin_ctz(m); m &= m - 1u; if (pos < 512) cand[pos] = (u16)(j0 + 2 * (x & 15) + (x >> 4)); ++pos; }
                    }
                }
                LDS_WAIT();
                if (dpe & 32) { *(LAS v4u*)(hist + 4 * lane) = (v4u){0u, 0u, 0u, 0u}; return; }
                int nsel = 0, neq = 0;
                {
                    int idx5[5]; unsigned kk5[5];
#pragma unroll
                    for (int r = 0; r < 5; ++r) { const int e = lane + 64 * r; const int v = (int)cand[e]; idx5[r] = (e < C) ? v : 0; }
#pragma unroll
                    for (int r = 0; r < 5; ++r) kk5[r] = (unsigned)myk[idx5[r]];
#pragma unroll
                    for (int r = 0; r < 5; ++r) {
                        const int e = lane + 64 * r; const bool in = e < C; const int idx = idx5[r]; const unsigned kk = in ? kk5[r] : 0u;
                        const bool gt = in && kk > cHi, eq = in && !gt;
                        const unsigned long long tm = __ballot(gt), em = __ballot(eq);
                        if (gt) sel[nsel + __popcll(tm & lt_mask)] = (u16)idx;
                        if (eq) { const int ep = neq + __popcll(em & lt_mask); if (ep < DSA_BCAP) bidx[ep] = (u16)idx; }
                        nsel += __popcll(tm); neq += __popcll(em);
                    }
                }
                for (int r = 5; r * 64 < C; ++r) {
                    const int e = lane + 64 * r; const bool in = e < C; const int idx = in ? (int)cand[e] : 0; const unsigned kk = in ? (unsigned)myk[idx] : 0u;
                    const bool gt = in && kk > cHi, eq = in && !gt;
                    const unsigned long long tm = __ballot(gt), em = __ballot(eq);
                    if (gt) sel[nsel + __popcll(tm & lt_mask)] = (u16)idx;
                    if (eq) { const int ep = neq + __popcll(em & lt_mask); if (ep < DSA_BCAP) bidx[ep] = (u16)idx; }
                    nsel += __popcll(tm); neq += __popcll(em);
                }
                LDS_WAIT();
                *(LAS v4u*)(hist + 4 * lane) = (v4u){0u, 0u, 0u, 0u};
                if (neq == need_eq) { for (int e = lane; e < neq; e += 64) sel[nsel + e] = bidx[e]; nsel += neq; }
                else if (need_eq > 0) {
                    nsel = dsa_rescore_select(F.lds, IKb, wq, bidx, bsc, sel, nsel, min(neq, DSA_BCAP), need_eq, lane, w, lt_mask, dpe);
                }
                if (extra_zero > 0) {
                    int base = 0;
                    for (int c0 = 0; c0 < npad && base < extra_zero; c0 += 512) {
                        const int j0 = c0 + 8 * lane; v4u kv = (v4u){0u, 0u, 0u, 0u}; if (j0 < npad) kv = k8[j0 >> 3];
                        unsigned m8 = 0u;
#pragma unroll
                        for (int x = 0; x < 8; ++x) { const unsigned wd = x < 2 ? kv.x : (x < 4 ? kv.y : (x < 6 ? kv.z : kv.w)); const unsigned kk = (x & 1) ? (wd >> 16) : (wd & 0xffffu); m8 |= (kk == 0x8000u ? 1u : 0u) << x; }
                        const int c = __builtin_popcount(m8);
                        int ex = 0;
#pragma unroll
                        for (int bit = 0; bit < 4; ++bit) ex += __popcll(__ballot((c >> bit) & 1) & lt_mask) << bit;
                        int tot = 0;
#pragma unroll
                        for (int bit = 0; bit < 4; ++bit) tot += __popcll(__ballot((c >> bit) & 1)) << bit;
                        int rk = base + ex;
#pragma unroll
                        for (int x = 0; x < 8; ++x) if ((m8 >> x) & 1u) { if (rk < extra_zero) sel[nsel + rk] = (u16)(j0 + x); ++rk; }
                        base += tot;
                    }
                    nsel += extra_zero;
                }
            }
        }
        if (!done) {
            dsa_select_slow(F.lds, w, myk, hist, sel, bidx, bsc, IKb, wq, npad, lane, lt_mask);
            LDS_WAIT();
            *(LAS v4u*)(hist + 4 * lane) = (v4u){0u, 0u, 0u, 0u};
        }
    }
    LDS_WAIT();
    if (!(dpe & 4)) return;
    {
        LAS float* PF = (LAS float*)myk;
        LAS u16* PB = (LAS u16*)(PF + 1024);
        LAS unsigned char* VS = (LAS unsigned char*)(PB + 1024);
        const int l16 = lane & 15, qt = lane >> 4, r8 = lane >> 3;
        const bf16* gb = KAVAb + 8 * (lane & 7);
        LAS unsigned char* stw = VS + r8 * DSA_VROW + 16 * (lane & 7);
        v4u kk[32];
#pragma unroll
        for (int i = 0; i < 32; ++i) { const int idx = (int)sel[r8 + 8 * i]; kk[i] = *(const v4u*)(gb + (long)idx * 128); }
        v4u vq[4][8];
#pragma unroll
        for (int i = 0; i < 8; ++i) { const int idx = (int)sel[r8 + 8 * i]; vq[0][i] = *(const v4u*)(gb + (long)idx * 128 + 64); }
        bf16x8 aq[2];
#pragma unroll
        for (int ks = 0; ks < 2; ++ks) { v4u z = (v4u){0u, 0u, 0u, 0u}; if (l16 < 4) z = *(const v4u*)(AQ + (rowbase + t) * 256 + l16 * 64 + 32 * ks + 8 * qt); aq[ks] = __builtin_bit_cast(bf16x8, z); }
#pragma unroll
        for (int c = 0; c < 4; ++c) {
#pragma unroll
            for (int i = 0; i < 8; ++i) *(LAS v4u*)(stw + 8 * i * DSA_VROW) = kk[8 * c + i];
            bf16x8 kA[4], kB[4];
#pragma unroll
            for (int t4 = 0; t4 < 4; ++t4) { const LAS unsigned char* rp = VS + (16 * t4 + l16) * DSA_VROW + 16 * qt; kA[t4] = *(const LAS bf16x8*)rp; kB[t4] = *(const LAS bf16x8*)(rp + 64); }
            f32x4 sacc[4];
#pragma unroll
            for (int t4 = 0; t4 < 4; ++t4) { sacc[t4] = (f32x4){0.f, 0.f, 0.f, 0.f};
                sacc[t4] = __builtin_amdgcn_mfma_f32_16x16x32_bf16(aq[0], kA[t4], sacc[t4], 0, 0, 0);
                sacc[t4] = __builtin_amdgcn_mfma_f32_16x16x32_bf16(aq[1], kB[t4], sacc[t4], 0, 0, 0); }
#pragma unroll
            for (int t4 = 0; t4 < 4; ++t4) { const int j = 64 * c + 16 * t4 + l16;
                if (qt == 0) *(LAS f32x4*)(PF + j * 4) = (j < count) ? sacc[t4] * SM_C : (f32x4){-1e30f, -1e30f, -1e30f, -1e30f}; }
        }
#ifndef TP_DSA_RT
        DSA_PREFETCH_NEXT();
#endif
#pragma unroll
        for (int c = 1; c < 4; ++c)
#pragma unroll
            for (int i = 0; i < 8; ++i) { const int idx = (int)sel[64 * c + r8 + 8 * i]; vq[c][i] = *(const v4u*)(gb + (long)idx * 128 + 64); }
        LDS_WAIT();
        {
            f32x4 z4[4];
#pragma unroll
            for (int jj = 0; jj < 4; ++jj) z4[jj] = *(const LAS f32x4*)(PF + (lane + 64 * jj) * 4);
#pragma unroll
            for (int hd = 0; hd < 4; ++hd) {
                const float m = wave_max(fmaxf(fmaxf(z4[0][hd], z4[1][hd]), fmaxf(z4[2][hd], z4[3][hd])));
                float s = 0.f;
#pragma unroll
                for (int jj = 0; jj < 4; ++jj) { const float p = (lane + 64 * jj < count) ? __builtin_amdgcn_exp2f(z4[jj][hd] - m) : 0.f; z4[jj][hd] = p; s += p; }
                const float inv = 1.0f / wave_sum(s);
#pragma unroll
                for (int jj = 0; jj < 4; ++jj) PB[hd * 256 + lane + 64 * jj] = (u16)f2bf(z4[jj][hd] * inv);
            }
        }
        LDS_WAIT();
        f32x4 o[4];
#pragma unroll
        for (int nt = 0; nt < 4; ++nt) o[nt] = (f32x4){0.f, 0.f, 0.f, 0.f};
        const unsigned VSa = (unsigned)(uintptr_t)VS;
#pragma unroll
        for (int c = 0; c < 4; ++c) {
#pragma unroll
            for (int i = 0; i < 8; ++i) *(LAS v4u*)(stw + 8 * i * DSA_VROW) = vq[c][i];
            LDS_WAIT();
            s16x4 tlo[2][4], thi[2][4];
            v4u pzz[2];
#pragma unroll
            for (int kk2 = 0; kk2 < 2; ++kk2) {
                pzz[kk2] = (v4u){0u, 0u, 0u, 0u}; if (l16 < 4) pzz[kk2] = *(const LAS v4u*)(PB + l16 * 256 + 64 * c + 32 * kk2 + 8 * qt);
#pragma unroll
                for (int nt = 0; nt < 4; ++nt) { const unsigned a0 = VSa + (32 * kk2 + 8 * qt + (l16 >> 2)) * DSA_VROW + (16 * nt + 4 * (l16 & 3)) * 2; tlo[kk2][nt] = tr_read(a0); thi[kk2][nt] = tr_read(a0 + 4 * DSA_VROW); }
            }
            asm volatile("s_waitcnt lgkmcnt(0)" : "+v"(tlo[0][0]), "+v"(tlo[0][1]), "+v"(tlo[0][2]), "+v"(tlo[0][3]), "+v"(tlo[1][0]), "+v"(tlo[1][1]), "+v"(tlo[1][2]), "+v"(tlo[1][3]),
                         "+v"(thi[0][0]), "+v"(thi[0][1]), "+v"(thi[0][2]), "+v"(thi[0][3]), "+v"(thi[1][0]), "+v"(thi[1][1]), "+v"(thi[1][2]), "+v"(thi[1][3]), "+v"(pzz[0]), "+v"(pzz[1]) :: "memory");
#pragma unroll
            for (int kk2 = 0; kk2 < 2; ++kk2) {
                const bf16x8 pf = __builtin_bit_cast(bf16x8, pzz[kk2]);
#pragma unroll
                for (int nt = 0; nt < 4; ++nt) {
                    const s16x4 lo = tlo[kk2][nt], hi = thi[kk2][nt];
                    const bf16x8 vf = (bf16x8){lo[0], lo[1], lo[2], lo[3], hi[0], hi[1], hi[2], hi[3]};
                    o[nt] = __builtin_amdgcn_mfma_f32_16x16x32_bf16(pf, vf, o[nt], 0, 0, 0);
                }
            }
            LDS_WAIT();
        }
        if (qt == 0 && !(dpe & 512)) { bf16* orow = AQ + (rowbase + t) * 256 + l16;
#pragma unroll
            for (int hd = 0; hd < 4; ++hd)
#pragma unroll
                for (int nt = 0; nt < 4; ++nt) orow[hd * 64 + 16 * nt] = (bf16)f2bf(o[nt][hd]); }
    }
#undef DSA_PREFETCH_NEXT
}

template <int PART = 7, int DSAP = 7> __device__ __forceinline__ void phase_attention(Frame& F, int l) {
    if (PART & 2) for (int L = F.vcu; L < 256; L += F.G) { const int b = L >> 6, h = (L >> 4) & 3, p = L & 15; moba_unit2(F, b, h, p); moba_unit2(F, b, h, 31 - p); }
    if (PART & 4) for (int L = F.vcu; L < 512; L += F.G) swa_unit(F, l, L >> 7, (L >> 6) & 1, L & 63);
    if (PART & 1) { __syncthreads(); for (int i = F.tid; i < 2048; i += NTHR) ((LAS unsigned*)(F.lds + DSA_HIST))[i] = 0u; if (F.tid < 8) ((LAS unsigned*)(F.lds + DSA_ZC))[F.tid] = 0u; }
#ifdef TP_DSA_RT
    int npass = 2; asm volatile("" : "+s"(npass));
    for (int pass = 0; pass < npass; ++pass) { int dpr = (pass + 1 < npass) ? (TP_DSA_RT) : 7; asm volatile("" : "+s"(dpr));
#else
    { constexpr int dpr = 7;
#endif
    if (PART & 1) {
        const int ngrp = (F.G == 256) ? 4 : 1, grp = (F.G == 256) ? (F.vcu >> 6) : 0, per = (T / 8) / ngrp;
#ifdef TP_DSA_RT
        gu32* qc = (gu32*)(F_WS + WS_CTL) + CW_DSAQ + 64 * l + 16 * pass + grp;
#else
        gu32* qc = (gu32*)(F_WS + WS_CTL) + CW_DSAQ + 64 * l + grp;
#endif
        LAS int* NXT = (LAS int*)(F.lds + DSA_NXT);
        int pend = 0;
        if (F.tid == 0) { NXT[0] = (int)__hip_atomic_fetch_add(qc, 1u, RLX_AGENT); pend = (int)__hip_atomic_fetch_add(qc, 1u, RLX_AGENT); }
        __syncthreads();
        int b, t0;
        { const int k0 = NXT[0]; if (k0 >= per) { b = 0; t0 = -1; } else if (ngrp == 4) { b = grp; t0 = 8 * (per - 1 - k0); } else { b = k0 & 3; t0 = 8 * ((T / 32) - 1 - (k0 >> 2)); } }
        __syncthreads();
        v2u iqn = (v2u){0u, 0u}; float iwn = 0.f;
        if (t0 >= 0) { const u16* IQ = (const u16*)(F_WS + WS_IQ); const float* IW = (const float*)(F_WS + WS_IW);
            iqn = *(const v2u*)(IQ + ((long)b * SEQ + t0) * 256 + 4 * F.tid); if (F.tid < 32) iwn = IW[((long)b * SEQ + t0) * 4 + F.tid]; }
        while (t0 >= 0) { int nb = 0, nt0 = -1;
            if (F.tid == 0) { NXT[0] = pend; pend = (int)__hip_atomic_fetch_add(qc, 1u, RLX_AGENT); }
#ifdef TP_DSA_RT
            dsa_unit<0x7fffffff>(F, b, t0, nb, nt0, grp, ngrp, iqn, iwn, dpr);
#else
            dsa_unit<DSAP>(F, b, t0, nb, nt0, grp, ngrp, iqn, iwn, dpr);
#endif
            b = nb; t0 = nt0; }
    }
    }
    __syncthreads();
}

struct SchedBranch {
    static constexpr bool HALF_UNITS = false;
    unsigned char* ws; const char* Bw; int G, vcu;
    __device__ __forceinline__ bool next(int i, pg8::Unit& u) const {
        const int tau = (i / 3) * G + vcu, br = i % 3; if (tau >= 512) return false;
        const int pm = tau >> 2, pn = tau & 3;
        const size_t aoff = br == 0 ? WS_AQ : (br == 1 ? WS_BQ : WS_CQ); const int lda = br == 2 ? 512 : 256; const int kb = br == 0 ? 0 : (br == 1 ? 256 : 512);
        u.A = (const char*)(ws + aoff) + (size_t)pm * 256 * lda * 2; u.B = Bw + (size_t)pn * 256 * 1024 * 2 + kb * 2; u.rowlist = nullptr; u.nvalid = 256; u.lda = lda; u.nt = lda / 64;
        u.ksplit = 1 << 30; u.bdelta = 0; u.p0 = pm; u.p1 = pn; u.p2 = br; u.p3 = 0; u.half = 0; u.chalf = 0; return true;
    }
};
struct EpiBranch {
    static constexpr bool PERM = true;
    static __device__ __forceinline__ bool keep_acc(const pg8::Unit& u) { return u.p2 < 2; }
    unsigned char* ws;
    __device__ __forceinline__ void operator()(f32x4 (&acc)[2][2][4][2], const pg8::Unit& u, int wr, int wc, int fr, int fq) const {
        const int pm = u.p0, pn = u.p1, br = u.p2;
        bf16* MG = (bf16*)(ws + WS_MERGED);
        const int row0 = pm * 256 + wr * 64 + fr, col0 = pn * 256 + wc * 32 + 8 * fq;
        const unsigned char* GATES8 = (const unsigned char*)(ws + WS_GATES);
        const unsigned char* gp = GATES8 + (size_t)row0 * 3072 + br * 1024 + col0;
#define GQ(vv_, ee_) ((float)(((ee_) < 4 ? (vv_)[0] >> (8 * ((ee_) & 3)) : (vv_)[1] >> (8 * ((ee_) & 3))) & 0xffu))
        if (br < 2) {
#pragma unroll
            for (int ai = 0; ai < 2; ++ai) {
                v2u g[4][2], gn[4][2];
#pragma unroll
                for (int m = 0; m < 4; ++m)
#pragma unroll
                    for (int bj = 0; bj < 2; ++bj) { const unsigned char* q = gp + (size_t)(ai * 128 + m * 16) * 3072 + bj * 128; g[m][bj] = *(const v2u*)q; gn[m][bj] = *(const v2u*)(q + 1024); }
#pragma unroll
                for (int m = 0; m < 4; ++m)
#pragma unroll
                    for (int bj = 0; bj < 2; ++bj) {
                        const v2u a = g[m][bj], d = gn[m][bj];
#pragma unroll
                        for (int e = 0; e < 4; ++e) { acc[ai][bj][m][0][e] *= GQ(a, e) * __builtin_amdgcn_rcpf(GQ(d, e)); acc[ai][bj][m][1][e] *= GQ(a, 4 + e) * __builtin_amdgcn_rcpf(GQ(d, 4 + e)); }
                    }
            }
        } else {
#pragma unroll
            for (int ai = 0; ai < 2; ++ai) {
                v2u g[4][2];
#pragma unroll
                for (int m = 0; m < 4; ++m)
#pragma unroll
                    for (int bj = 0; bj < 2; ++bj) g[m][bj] = *(const v2u*)(gp + (size_t)(ai * 128 + m * 16) * 3072 + bj * 128);
#pragma unroll
                for (int m = 0; m < 4; ++m)
#pragma unroll
                    for (int bj = 0; bj < 2; ++bj) {
                        const v2u a = g[m][bj];
                        f32x4 x0 = acc[ai][bj][m][0], x1 = acc[ai][bj][m][1];
#pragma unroll
                        for (int e = 0; e < 4; ++e) { x0[e] *= GQ(a, e) * (1.0f / 255.0f); x1[e] *= GQ(a, 4 + e) * (1.0f / 255.0f); }
                        v4u w; w.x = cvt_pk_bf16(x0[0], x0[1]); w.y = cvt_pk_bf16(x0[2], x0[3]); w.z = cvt_pk_bf16(x1[0], x1[1]); w.w = cvt_pk_bf16(x1[2], x1[3]);
                        *(v4u*)(MG + (size_t)(row0 + ai * 128 + m * 16) * 1024 + col0 + bj * 128) = w;
                    }
            }
        }
#undef GQ
    }
};
__device__ __forceinline__ void phase_branch(Frame& F, int l) {
    SchedBranch S{F_WS, (const char*)(F_WS + WS_WBR) + (size_t)l * 1024 * 1024 * 2, F.G, F.vcu};
    EpiBranch E{F_WS};
    pg8::gemm_phase<EpiBranch, SchedBranch, true>(F.lds, F.tid, 1024, S, E);
}

struct EpiY {
    static constexpr bool PERM = true;
    static __device__ __forceinline__ bool keep_acc(const pg8::Unit&) { return false; }
    bf16* Y;
    __device__ __forceinline__ void operator()(const f32x4 (&acc)[2][2][4][2], const pg8::Unit& u, int wr, int wc, int fr, int fq) const {
        const int row0 = u.p0 * 256 + wr * 64 + fr, col0 = u.p1 * 256 + wc * 32 + 8 * fq;
#pragma unroll
        for (int ai = 0; ai < 2; ++ai)
#pragma unroll
            for (int m = 0; m < 4; ++m) { bf16* rp = Y + (size_t)(row0 + ai * 128 + m * 16) * 1024 + col0;
#pragma unroll
                for (int bj = 0; bj < 2; ++bj) { const f32x4 a = acc[ai][bj][m][0], b = acc[ai][bj][m][1];
                    v4u w; w.x = cvt_pk_bf16(a[0], a[1]); w.y = cvt_pk_bf16(a[2], a[3]); w.z = cvt_pk_bf16(b[0], b[1]); w.w = cvt_pk_bf16(b[2], b[3]);
                    *(v4u*)(rp + bj * 128) = w; } }
    }
};
__device__ __forceinline__ void phase_wo(Frame& F, int l) {
    SchedDense S; S.A = (const char*)(F_WS + WS_MERGED); S.B = (const char*)(F_WS + WS_WO) + (size_t)l * 1024 * 1024 * 2; S.lda = 1024; S.lda_b = 256 * 1024 * 2; S.ldb_b = 256 * 1024 * 2; S.nN = 4; S.nt = 16; S.G = F.G; S.vcu = F.vcu; S.ntiles = 512;
    EpiY E{(bf16*)(F_WS + WS_Y)};
    pg8::gemm_phase<EpiY, SchedDense, true>(F.lds, F.tid, 1024, S, E);
}

struct LnIn { v2u a[4]; v2u b[4]; };
__device__ __forceinline__ void ln_load(LnIn& R, const bf16* xin, const bf16* y, int lane) {
#pragma unroll
    for (int j = 0; j < 4; ++j) { R.a[j] = *(const v2u*)(xin + 4 * lane + 256 * j); R.b[j] = *(const v2u*)(y + 4 * lane + 256 * j); }
}
template <bool WF32>
__device__ __forceinline__ void ln_finish(const LnIn& R, const f32x4 (&gg)[4], const f32x4 (&bb)[4], float* xout, bf16* xb, int lane, f32x4 (&o)[4]) {
    f32x4 v[4]; float s = 0.f;
#pragma unroll
    for (int j = 0; j < 4; ++j) { const f32x4 xv = (f32x4){bflo(R.a[j].x), bfhi(R.a[j].x), bflo(R.a[j].y), bfhi(R.a[j].y)}; const f32x4 yv = (f32x4){bflo(R.b[j].x), bfhi(R.b[j].x), bflo(R.b[j].y), bfhi(R.b[j].y)};
        v[j] = xv * DN_ALPHA + yv; s += (v[j].x + v[j].y) + (v[j].z + v[j].w); }
    const float mean = wave_sum(s) * (1.f / D); float s2 = 0.f;
#pragma unroll
    for (int j = 0; j < 4; ++j) { v[j] = v[j] - mean; s2 += (v[j].x * v[j].x + v[j].y * v[j].y) + (v[j].z * v[j].z + v[j].w * v[j].w); }
    const float rstd = 1.0f / sqrtf(wave_sum(s2) * (1.f / D) + LN_EPS);
#pragma unroll
    for (int j = 0; j < 4; ++j) { o[j] = v[j] * rstd * gg[j] + bb[j];
        if (WF32) *(f32x4*)(xout + 4 * lane + 256 * j) = o[j];
        else { v2u w; w.x = pk2(o[j].x, o[j].y); w.y = pk2(o[j].z, o[j].w); *(v2u*)(xb + 4 * lane + 256 * j) = w; } }
}
__device__ __forceinline__ void phase_ln1_route(Frame& F, int l) {
    LAS float* cscr = (LAS float*)(F.lds + 65536 + F.wave * 8704);
    int cvt_it = F.vcu * NWAVES + F.wave; const int cvt_step = F.G * NWAVES;
    const int cvt_n = (MOE_CVT_ITEMS - cvt_it + cvt_step - 1) / cvt_step; int cvt_done = 0, cvt_rows = 0;
    LAS float* RWL = (LAS float*)F.lds;
    LAS int* lcnt = (LAS int*)(F.lds + 140000);
    LAS int* lbase = lcnt + 32;
    LAS int* ent = lcnt + 64;
    LAS float* entw = (LAS float*)(ent + 1024);
    const bf16* xin = (const bf16*)(F_WS + WS_XB); const bf16* Y = (const bf16*)(F_WS + WS_Y);
    const float* g = F_IN(I_LN1G) + l * D; const float* bt = F_IN(I_LN1B) + l * D; const float* RW = F_IN(I_RW); const float* RB = F_IN(I_RB);
    bf16* XB = (bf16*)(F_WS + WS_XB);
    unsigned* gcnt = (unsigned*)(F_WS + WS_CTL) + CW_CNT + l * 24 * 64;
    int* LIST = (int*)(F_WS + WS_LIST); f32x2* CWp = (f32x2*)(F_WS + WS_CW);
    for (int i = F.tid; i < 16384; i += NTHR) RWL[(i & 15) * 1024 + (i >> 4)] = RW[i];
    f32x4 gg[4], bb[4];
#pragma unroll
    for (int j = 0; j < 4; ++j) { gg[j] = *(const f32x4*)(g + 4 * F.lane + 256 * j); bb[j] = *(const f32x4*)(bt + 4 * F.lane + 256 * j); }
    const float rbv = RB[F.lane & 15];
    const int rows_per = (T + F.G - 1) / F.G;
    for (int chunk = 0; chunk < rows_per; chunk += 512) {
        if (F.tid < 24) lcnt[F.tid] = 0;
        __syncthreads();
        const int r_lo = F.vcu * rows_per + chunk, r_hi = min(min(r_lo + 512, (F.vcu + 1) * rows_per), T);
        LnIn c0, c1, n0, n1;
        int row = r_lo + F.wave;
        if (row < r_hi) ln_load(c0, xin + (size_t)row * D, Y + (size_t)row * D, F.lane);
        if (row + NWAVES < r_hi) ln_load(c1, xin + (size_t)(row + NWAVES) * D, Y + (size_t)(row + NWAVES) * D, F.lane);
        for (; row < r_hi; row += 2 * NWAVES) {
            const bool has1 = row + NWAVES < r_hi;
            if (row + 2 * NWAVES < r_hi) ln_load(n0, xin + (size_t)(row + 2 * NWAVES) * D, Y + (size_t)(row + 2 * NWAVES) * D, F.lane);
            if (row + 3 * NWAVES < r_hi) ln_load(n1, xin + (size_t)(row + 3 * NWAVES) * D, Y + (size_t)(row + 3 * NWAVES) * D, F.lane);
            f32x4 o0[4], o1[4];
            ln_finish<false>(c0, gg, bb, nullptr, XB + (size_t)row * D, F.lane, o0);
            if (has1) ln_finish<false>(c1, gg, bb, nullptr, XB + (size_t)(row + NWAVES) * D, F.lane, o1);
            else {
#pragma unroll
                for (int j = 0; j < 4; ++j) o1[j] = (f32x4){0.f, 0.f, 0.f, 0.f}; }
            float lg0[16], lg1[16];
#pragma unroll
            for (int e = 0; e < 16; ++e) { float a0 = 0.f, a1 = 0.f;
#pragma unroll
                for (int j = 0; j < 4; ++j) { const f32x4 w4 = *(const LAS f32x4*)(RWL + e * 1024 + 4 * F.lane + 256 * j);
                    a0 = fmaf(o0[j].x, w4.x, a0); a0 = fmaf(o0[j].y, w4.y, a0); a0 = fmaf(o0[j].z, w4.z, a0); a0 = fmaf(o0[j].w, w4.w, a0);
                    a1 = fmaf(o1[j].x, w4.x, a1); a1 = fmaf(o1[j].y, w4.y, a1); a1 = fmaf(o1[j].z, w4.z, a1); a1 = fmaf(o1[j].w, w4.w, a1); }
                lg0[e] = a0; lg1[e] = a1; }
#pragma unroll
            for (int e = 0; e < 16; ++e) { lg0[e] = row_sum(lg0[e]); lg1[e] = row_sum(lg1[e]); }
#pragma unroll 1
            for (int rr = 0; rr < (has1 ? 2 : 1); ++rr) {
                float lgc[16];
#pragma unroll
                for (int e = 0; e < 16; ++e) lgc[e] = rr ? lg1[e] : lg0[e];
            float aff[16], ss[16];
            { float mylg = lgc[0];
#pragma unroll
              for (int e = 1; e < 16; ++e) mylg = ((F.lane & 15) == e) ? lgc[e] : mylg;
              mylg += xor_f<16>(mylg); mylg = half_sum(mylg);
              const float myaff = 1.0f / (1.0f + expf(-mylg)); const float myss = myaff + rbv;
#pragma unroll
              for (int e = 0; e < 16; ++e) { aff[e] = __builtin_bit_cast(float, __builtin_amdgcn_readlane(__builtin_bit_cast(int, myaff), e)); ss[e] = __builtin_bit_cast(float, __builtin_amdgcn_readlane(__builtin_bit_cast(int, myss), e)); } }
            {
                int gbest = 0; float gs = -INFINITY;
#pragma unroll
                for (int gq = 0; gq < 4; ++gq) { float m1 = -INFINITY, m2 = -INFINITY;
#pragma unroll
                    for (int i = 0; i < 4; ++i) { const float v = ss[4 * gq + i]; if (v > m1) { m2 = m1; m1 = v; } else if (v > m2) m2 = v; }
                    const float sc = m1 + m2; if (sc > gs) { gs = sc; gbest = gq; } }
                float m1 = -INFINITY, m2 = -INFINITY; int i1 = 0, i2 = 0;
#pragma unroll
                for (int gq = 0; gq < 4; ++gq) if (gq == gbest) {
#pragma unroll
                    for (int i = 0; i < 4; ++i) { const float v = ss[4 * gq + i]; if (v > m1) { m2 = m1; i2 = i1; m1 = v; i1 = i; } else if (v > m2) { m2 = v; i2 = i; } } }
                float a1 = 0.f, a2 = 0.f;
#pragma unroll
                for (int e = 0; e < 16; ++e) { if (e == 4 * gbest + i1) a1 = aff[e]; if (e == 4 * gbest + i2) a2 = aff[e]; }
                const float inv = 1.0f / (a1 + a2);
                const int lo_i = min(i1, i2), hi_i = max(i1, i2);
                const float c_lo = (i1 < i2 ? a1 : a2) * inv, c_hi = (i1 < i2 ? a2 : a1) * inv;
                const int pidx = (lo_i == 0) ? (hi_i - 1) : (lo_i == 1 ? 1 + hi_i : 5);
                const int pair = min(max(gbest * 6 + pidx, 0), NPAIR - 1);
                if (F.lane == 0) {
                    const int lp = __hip_atomic_fetch_add(lcnt + pair, 1, __ATOMIC_RELAXED, __HIP_MEMORY_SCOPE_WORKGROUP);
                    const int k = row + rr * NWAVES - r_lo; ent[2 * k] = pair; ent[2 * k + 1] = lp; entw[2 * k] = c_lo; entw[2 * k + 1] = c_hi; }
            }
            }
#pragma unroll
            for (int j = 0; j < 4; ++j) { c0.a[j] = n0.a[j]; c0.b[j] = n0.b[j]; c1.a[j] = n1.a[j]; c1.b[j] = n1.b[j]; }
            cvt_rows += 2;
            if (cvt_done < cvt_n && cvt_done * (rows_per / NWAVES) < cvt_rows * cvt_n) { convert_moe_item(F, l, cvt_it, cscr); cvt_it += cvt_step; ++cvt_done; }
        }
        __syncthreads();
        if (F.tid < 24) lbase[F.tid] = (int)__hip_atomic_fetch_add(gcnt + F.tid * 64, (unsigned)lcnt[F.tid], __ATOMIC_RELAXED, __HIP_MEMORY_SCOPE_AGENT);
        __syncthreads();
        for (int k = F.tid; k < r_hi - r_lo; k += NTHR) { const int pair = ent[2 * k], pos = lbase[pair] + ent[2 * k + 1];
            LIST[(size_t)pair * T + pos] = r_lo + k; CWp[(size_t)pair * T + pos] = (f32x2){entw[2 * k], entw[2 * k + 1]}; }
        __syncthreads();
    }
    for (; cvt_done < cvt_n; ++cvt_done) { convert_moe_item(F, l, cvt_it, cscr); cvt_it += cvt_step; }
}
__device__ __forceinline__ void phase_ln2(Frame& F, int l) {
    const bf16* Y = (const bf16*)(F_WS + WS_Y); const float* g = F_IN(I_LN2G) + l * D; const float* bt = F_IN(I_LN2B) + l * D; bf16* XB = (bf16*)(F_WS + WS_XB);
    const int gw = F.vcu * NWAVES + F.wave, NGW = F.G * NWAVES;
    f32x4 gg[4], bb[4];
#pragma unroll
    for (int j = 0; j < 4; ++j) { gg[j] = *(const f32x4*)(g + 4 * F.lane + 256 * j); bb[j] = *(const f32x4*)(bt + 4 * F.lane + 256 * j); }
    LnIn cur, nxt;
    int row = gw;
    if (row < T) ln_load(cur, XB + (size_t)row * D, Y + (size_t)row * D, F.lane);
    for (; row < T; row += NGW) {
        if (row + NGW < T) ln_load(nxt, XB + (size_t)(row + NGW) * D, Y + (size_t)(row + NGW) * D, F.lane);
        f32x4 o[4];
        if (l == DEPTH - 1) ln_finish<true>(cur, gg, bb, F_OUT + (size_t)row * D, nullptr, F.lane, o); else ln_finish<false>(cur, gg, bb, nullptr, XB + (size_t)row * D, F.lane, o);
#pragma unroll
        for (int j = 0; j < 4; ++j) { cur.a[j] = nxt.a[j]; cur.b[j] = nxt.b[j]; }
    }
}

__device__ __forceinline__ void moe_table(Frame& F, int l, LAS int* tp, LAS int* cn) {
    const unsigned* gcnt = (const unsigned*)(F_WS + WS_CTL) + CW_CNT + l * 24 * 64;
    if (F.tid < 64) {
        int c = 0; if (F.lane < 24) c = (int)__hip_atomic_load(gcnt + F.lane * 64, __ATOMIC_RELAXED, __HIP_MEMORY_SCOPE_AGENT);
        const int tiles = (c + 255) >> 8; const int incl = wave_prefix_incl(tiles, F.lane);
        if (F.lane < 24) { cn[F.lane] = c; tp[F.lane] = incl - tiles; }
        if (F.lane == 23) tp[24] = incl;
    }
    __syncthreads();
}
__device__ __forceinline__ void pair_experts(int p, int& e0, int& e1) { const int gq = p / 6, k = p % 6; const int lo = k < 3 ? 0 : (k < 5 ? 1 : 2); const int hi = k < 3 ? k + 1 : (k < 5 ? k - 1 : 3); e0 = 4 * gq + lo; e1 = 4 * gq + hi; }
struct SchedMoeUp {
    static constexpr bool HALF_UNITS = true;
    unsigned char* ws; const LAS int* tp; const LAS int* cn; int G, vcu, RT;
    __device__ __forceinline__ bool next(int i, pg8::Unit& u) const {
        int L = i * G + vcu, hf = 0, ch = 0;
        { const int nu = RT * 8, R = nu / G, tail = nu - R * G;
          if (tail > 0 && 2 * tail <= G && i >= R) { if (i > R || vcu >= 2 * tail) return false; L = R * G + (vcu >> 1); hf = 1; ch = vcu & 1; } }
        if (L >= RT * 8) return false;
        const int rt = L >> 3, ct = L & 7; int p = 0;
        for (int q = 1; q < 24; ++q) if (tp[q] <= rt) p = q;
        int e0, e1; pair_experts(p, e0, e1); const int e = ct < 4 ? e0 : e1; const int lr0 = (rt - tp[p]) * 256;
        u.A = (const char*)(ws + WS_XB); u.B = (const char*)(ws + WS_WGU) + ((size_t)e * 1024 + (ct & 3) * 256 + ch * 128) * 1024 * 2;
        u.rowlist = (const int*)(ws + WS_LIST) + (size_t)p * T + lr0; u.nvalid = min(256, cn[p] - lr0); u.lda = 1024; u.nt = 16; u.ksplit = 1 << 30; u.bdelta = 0;
        u.p0 = rt; u.p1 = ct; u.p2 = p; u.p3 = lr0; u.half = hf; u.chalf = ch; return true;
    }
};
struct EpiMoeUp {
    static constexpr bool PERM = true;
    static __device__ __forceinline__ bool keep_acc(const pg8::Unit&) { return false; }
    unsigned char* ws;
    __device__ __forceinline__ void operator()(const f32x4 (&acc)[2][2][4][2], const pg8::Unit& u, int wr, int wc, int fr, int fq) const {
        const int rt = u.p0, ct = u.p1, p = u.p2, lr0 = u.p3;
        bf16* H = (bf16*)(ws + WS_H); const f32x2* CWp = (const f32x2*)(ws + WS_CW) + (size_t)p * T + lr0;
        const int slot = ct >> 2;
        float cw1[2][4];
#pragma unroll
        for (int ai = 0; ai < 2; ++ai)
#pragma unroll
            for (int m = 0; m < 4; ++m) cw1[ai][m] = ((const float*)CWp)[2 * min(ai * 128 + wr * 64 + m * 16 + fr, u.nvalid - 1) + slot];
#pragma unroll
        for (int ai = 0; ai < 2; ++ai)
#pragma unroll
            for (int m = 0; m < 4; ++m) { const int r = ai * 128 + wr * 64 + m * 16 + fr; const bool ok = r < u.nvalid;
                const float cw = ok ? cw1[ai][m] : 0.f;
#pragma unroll
                for (int bj = 0; bj < 2; ++bj) { if (u.half && bj == 1) continue; const f32x4 gv = acc[ai][bj][m][0], uv = acc[ai][bj][m][1];
                    float hh[4];
#pragma unroll
                    for (int x = 0; x < 4; ++x) { const float gx = gv[x]; hh[x] = ok ? gx * sigmoidf_(gx) * uv[x] * cw : 0.f; }
                    v2u w; w.x = cvt_pk_bf16(hh[0], hh[1]); w.y = cvt_pk_bf16(hh[2], hh[3]);
                    *(v2u*)(H + (size_t)(rt * 256 + r) * 1024 + slot * 512 + (ct & 3) * 128 + (bj + u.chalf) * 64 + wc * 16 + 4 * fq) = w; } }
    }
};
struct SchedMoeDown {
    static constexpr bool HALF_UNITS = true;
    unsigned char* ws; const LAS int* tp; const LAS int* cn; int G, vcu, RT;
    __device__ __forceinline__ bool next(int i, pg8::Unit& u) const {
        int L = i * G + vcu, hf = 0, ch = 0;
        { const int nu = RT * 4, R = nu / G, tail = nu - R * G;
          if (tail > 0 && 2 * tail <= G && i >= R) { if (i > R || vcu >= 2 * tail) return false; L = R * G + (vcu >> 1); hf = 1; ch = vcu & 1; } }
        if (L >= RT * 4) return false;
        const int rt = L >> 2, ct = L & 3; int p = 0;
        for (int q = 1; q < 24; ++q) if (tp[q] <= rt) p = q;
        int e0, e1; pair_experts(p, e0, e1); const int lr0 = (rt - tp[p]) * 256;
        u.A = (const char*)(ws + WS_H) + (size_t)rt * 256 * 1024 * 2; u.B = (const char*)(ws + WS_WD) + ((size_t)(ct * 256 + ch * 128) * (NEXP * DE) + e0 * DE) * 2;
        u.rowlist = nullptr; u.nvalid = min(256, cn[p] - lr0); u.lda = 1024; u.nt = 16; u.ksplit = 8; u.bdelta = (long)(e1 - e0 - 1) * DE * 2;
        u.p0 = rt; u.p1 = ct; u.p2 = p; u.p3 = lr0; u.half = hf; u.chalf = ch; return true;
    }
};
struct EpiMoeDown {
    static constexpr bool PERM = true;
    static __device__ __forceinline__ bool keep_acc(const pg8::Unit&) { return false; }
    unsigned char* ws;
    __device__ __forceinline__ void operator()(const f32x4 (&acc)[2][2][4][2], const pg8::Unit& u, int wr, int wc, int fr, int fq) const {
        const int ct = u.p1, p = u.p2, lr0 = u.p3;
        bf16* Y = (bf16*)(ws + WS_Y); const int* LIST = (const int*)(ws + WS_LIST) + (size_t)p * T + lr0;
        const int col0 = ct * 256 + wc * 32 + 8 * fq;
#pragma unroll
        for (int ai = 0; ai < 2; ++ai)
#pragma unroll
            for (int m = 0; m < 4; ++m) { const int r = ai * 128 + wr * 64 + m * 16 + fr;
                if (r < u.nvalid) { const int tok = LIST[r]; bf16* rp = Y + (size_t)tok * 1024 + col0;
#pragma unroll
                    for (int bj = 0; bj < 2; ++bj) { if (u.half && bj == 1) continue; const f32x4 a = acc[ai][bj][m][0], b = acc[ai][bj][m][1];
                        v4u w; w.x = cvt_pk_bf16(a[0], a[1]); w.y = cvt_pk_bf16(a[2], a[3]); w.z = cvt_pk_bf16(b[0], b[1]); w.w = cvt_pk_bf16(b[2], b[3]);
                        *(v4u*)(rp + (bj + u.chalf) * 128) = w; } } }
    }
};
__device__ __forceinline__ void phase_moe_up(Frame& F, int l) {
    LAS int* tp = (LAS int*)(F.lds + LDS_MISC_OFF + 64); LAS int* cn = tp + 32;
    moe_table(F, l, tp, cn);
    SchedMoeUp S{F_WS, tp, cn, F.G, F.vcu, __builtin_amdgcn_readfirstlane(tp[24])}; EpiMoeUp E{F_WS};
    pg8::gemm_phase<EpiMoeUp, SchedMoeUp, true>(F.lds, F.tid, 1024, S, E);
}
__device__ __forceinline__ void phase_moe_down(Frame& F, int l) {
    LAS int* tp = (LAS int*)(F.lds + LDS_MISC_OFF + 64); LAS int* cn = tp + 32;
    moe_table(F, l, tp, cn);
    SchedMoeDown S{F_WS, tp, cn, F.G, F.vcu, __builtin_amdgcn_readfirstlane(tp[24])}; EpiMoeDown E{F_WS};
    pg8::gemm_phase<EpiMoeDown, SchedMoeDown, true>(F.lds, F.tid, NEXP * DE, S, E);
}


#ifndef TP_DSAP
#define TP_DSAP 7
#endif
#ifndef TP_PHASE
#define TP_PHASE -1
#endif
__global__ void __launch_bounds__(NTHR, 2) fwd_kernel(Args args) {
    extern __shared__ __attribute__((aligned(16))) unsigned char lds[];
    Frame F;
    F.lds = (LAS unsigned char*)lds; F.wsg = (gbyte*)args.ws; F.outg = (GAS float*)args.out;
#pragma unroll
    for (int i = 0; i < 16; ++i) F.ing[i] = (GAS const float*)args.in[i];
    const int wave0 = __builtin_amdgcn_readfirstlane((int)threadIdx.x >> 6);
    F.lane = lane_id(); F.tid = wave0 * 64 + F.lane; F.wave = wave0;
    F.G = gridDim.x; { const int bx = blockIdx.x; F.vcu = (F.G % 8 == 0) ? (bx % 8) * (F.G / 8) + bx / 8 : bx; }
    volatile LAS unsigned* MISC = (volatile LAS unsigned*)(F.lds + LDS_MISC_OFF);
    for (int u = F.tid; u < 128; u += NTHR) MISC[u] = 0u;
    __syncthreads();
    XcdBarrier bar = xcd_barrier_post((gu32*)(F.wsg + WS_CTL) + CW_BAR, MISC + 8, F.tid == 0);
    const int lo = args.ph_lo, hi = args.ph_hi;
#define IN(k) (lo <= (k) && (k) < hi)
#define PB() do { gbyte* w_ = (gbyte*)args.ws; asm volatile("" : "+s"(w_)); F.wsg = w_; int t_ = wave0 * 64 + lane_id(); asm volatile("" : "+v"(t_)); F.tid = t_; F.lane = t_ & 63; F.wave = wave0; } while (0)
#define XBAR() xcd_barrier(bar, wave0 == 0 && lane_id() == 0)
#define SEAM(k) do { if (IN(k) && IN((k) + 1)) xcd_barrier(bar, wave0 == 0 && lane_id() == 0); } while (0)
    if (IN(0)) { PB(); phase_prologue_a(F); XBAR(); PB(); phase_prologue(F); } SEAM(0);
    if (TP_PHASE == 20) { PB(); phase_prologue_a(F); XBAR(); PB(); phase_prologue(F); XBAR(); }
    if (TP_PHASE == 21) { PB(); convert_moe_weights(F, 0); XBAR(); }
    if (TP_PHASE == 40) { XBAR(); XBAR(); XBAR(); XBAR(); XBAR(); XBAR(); XBAR(); XBAR(); XBAR(); XBAR(); XBAR(); XBAR(); XBAR(); XBAR(); XBAR(); XBAR(); }
#define LAYER(l) do { const int pb = 1 + 8 * (l); \
        if (IN(pb + 0)) { PB(); phase_inproj(F, (l)); } SEAM(pb + 0); \
        if (TP_PHASE == 0 && (l) == 0) { PB(); phase_inproj(F, (l)); XBAR(); } \
        if (TP_PHASE == 30 && (l) == 0) { PB(); phase_inproj_probe(F, (l)); XBAR(); } \
        if (TP_PHASE == 31 && (l) == 0) { PB(); phase_inproj_mode<1>(F, (l)); XBAR(); PB(); phase_inproj(F, (l)); XBAR(); } \
        if (TP_PHASE == 32 && (l) == 0) { PB(); phase_inproj_mode<2>(F, (l)); XBAR(); PB(); phase_inproj(F, (l)); XBAR(); } \
        if (TP_PHASE >= 11 && TP_PHASE <= 13 && (l) == 0) { PB(); phase_attention<((TP_PHASE >= 11 && TP_PHASE <= 13) ? (1 << ((TP_PHASE >= 11 ? TP_PHASE : 11) - 11)) : 7), TP_DSAP>(F, (l)); XBAR(); PB(); phase_inproj(F, (l)); XBAR(); } \
        if (IN(pb + 1)) { PB(); phase_attention(F, (l)); } SEAM(pb + 1); \
        if (TP_PHASE == 1 && (l) == 0) { PB(); phase_inproj(F, (l)); XBAR(); PB(); phase_attention(F, (l)); XBAR(); } \
        if (IN(pb + 2)) { PB(); phase_branch(F, (l)); } SEAM(pb + 2); \
        if (TP_PHASE == 2 && (l) == 0) { PB(); phase_branch(F, (l)); XBAR(); } \
        if (IN(pb + 3)) { PB(); phase_wo(F, (l)); } SEAM(pb + 3); \
        if (TP_PHASE == 3 && (l) == 0) { PB(); phase_wo(F, (l)); XBAR(); } \
        if (IN(pb + 4)) { PB(); phase_ln1_route(F, (l)); } SEAM(pb + 4); \
        if (IN(pb + 5)) { PB(); phase_moe_up(F, (l)); } SEAM(pb + 5); \
        if (TP_PHASE == 5 && (l) == 0) { PB(); phase_moe_up(F, (l)); XBAR(); } \
        if (IN(pb + 6)) { PB(); phase_moe_down(F, (l)); } SEAM(pb + 6); \
        if (TP_PHASE == 6 && (l) == 0) { PB(); phase_moe_down(F, (l)); XBAR(); } \
        if (IN(pb + 7)) { PB(); phase_ln2(F, (l)); } SEAM(pb + 7); \
    } while (0)
    LAYER(0);
    LAYER(1);
#undef LAYER
#undef IN
#undef SEAM
}

extern "C" void kernel_launch(void* const* d_in, const int* in_sizes, int n_in, void* d_out, int out_size, void* d_ws, size_t ws_size, hipStream_t stream) {
    static int grid = 0;
    if (grid == 0) {
        if (n_in != 16 || out_size != T * D || ws_size < WS_END) { fprintf(stderr, "kernel_launch: unexpected shapes (n_in %d out %d ws %zu)\n", n_in, out_size, ws_size); grid = -1; return; }
        int dev = 0, cus = 0, per_cu = 0;
        if (hipGetDevice(&dev) != hipSuccess || hipDeviceGetAttribute(&cus, hipDeviceAttributeMultiprocessorCount, dev) != hipSuccess) { grid = -1; return; }
        if (hipFuncSetAttribute((const void*)fwd_kernel, hipFuncAttributeMaxDynamicSharedMemorySize, LDS_BYTES) != hipSuccess) { fprintf(stderr, "kernel_launch: hipFuncSetAttribute failed\n"); grid = -1; return; }
        if (hipOccupancyMaxActiveBlocksPerMultiprocessor(&per_cu, (const void*)fwd_kernel, NTHR, LDS_BYTES) != hipSuccess || per_cu < 1) { fprintf(stderr, "kernel_launch: occupancy query says %d\n", per_cu); }
        (void)hipGetLastError();
        grid = cus;
    }
    if (grid < 0) return;
    (void)hipMemsetAsync((char*)d_ws + WS_CTL, 0, CTL_ZERO_BYTES, stream);
    Args a{};
    for (int i = 0; i < 16; ++i) a.in[i] = (const float*)d_in[i];
    a.out = (float*)d_out; a.ws = (unsigned char*)d_ws; a.ph_lo = 0; a.ph_hi = 1000;
    hipLaunchKernelGGL(fwd_kernel, dim3(grid), dim3(NTHR), LDS_BYTES, stream, a);
}
```
